# Optimizing an MI355X kernel written in HIP

```python
import math
import jax, jax.numpy as jnp
from jax import lax
import numpy as np

D_MODEL = 1024
BATCH = 4
SEQ = 4096
DEPTH = 4

N_A_LAYERS = DEPTH // 2
N_B_LAYERS = DEPTH - N_A_LAYERS

GLA_HEADS = 4
GLA_KEY_DIM = D_MODEL // 2
GLA_VAL_DIM = D_MODEL
GLA_HK = GLA_KEY_DIM // GLA_HEADS
GLA_HV = GLA_VAL_DIM // GLA_HEADS
GLA_GATE_RANK = 16
GLA_GATE_NORM = 16.0
GLA_CHUNK = 64
A_PROJ = 2 * GLA_KEY_DIM + 2 * GLA_VAL_DIM + GLA_GATE_RANK

SWA_HEAD_DIM = 64
SWA_Q_HEADS = D_MODEL // SWA_HEAD_DIM
SWA_GROUP = 8
SWA_KV_HEADS = SWA_Q_HEADS // SWA_GROUP
WINDOW = 128
BLOCK = 128
KV_PROJ = 2 * SWA_KV_HEADS * SWA_HEAD_DIM

REL_BUCKETS = 32
REL_MAX_DIST = 128

D_FF = 4 * D_MODEL
EPS = 1e-6
NEG = -1e30

kernel_name = "yoco_gla_swa_sink_hybrid"


def rmsnorm(x, g):
    xf = x.astype(jnp.float32)
    y = xf * lax.rsqrt(jnp.mean(xf * xf, axis=-1, keepdims=True) + EPS) * g.astype(jnp.float32)
    return y.astype(x.dtype)


def sq_relu_mlp(h, w_up, w_down):
    u = jax.nn.relu(h @ w_up)
    return (u * u) @ w_down


def gla_mixer(h, w_in, w_gk2, b_gk, g_onorm, w_out):
    B, T, _ = h.shape
    C = GLA_CHUNK
    NC = T // C
    f32 = jnp.float32
    proj = h @ w_in
    q, k, v, gate, glr = jnp.split(
        proj, [GLA_KEY_DIM, 2 * GLA_KEY_DIM, 2 * GLA_KEY_DIM + GLA_VAL_DIM,
               2 * GLA_KEY_DIM + 2 * GLA_VAL_DIM], axis=-1)
    gk = jax.nn.log_sigmoid((glr @ w_gk2 + b_gk).astype(f32)) / GLA_GATE_NORM

    def heads(t, d):
        return t.astype(f32).reshape(B, NC, C, GLA_HEADS, d).transpose(1, 0, 3, 2, 4)

    qf = heads(q, GLA_HK) * (GLA_HK ** -0.5)
    kf = heads(k, GLA_HK)
    vf = heads(v, GLA_HV)
    bcum = jnp.cumsum(heads(gk, GLA_HK), axis=-2)
    q_t = qf * jnp.exp(bcum)
    k_t = kf * jnp.exp(-bcum)
    causal = jnp.asarray(np.tril(np.ones((C, C), dtype=bool)))
    attn = jnp.where(causal, jnp.einsum('nbhik,nbhjk->nbhij', q_t, k_t), 0.0)
    o_intra = jnp.einsum('nbhij,nbhjv->nbhiv', attn, vf)
    b_last = bcum[..., -1:, :]
    k_dec = kf * jnp.exp(b_last - bcum)

    def step(S, xs):
        q_c, k_c, v_c, bl = xs
        o = jnp.einsum('bhik,bhkv->bhiv', q_c, S)
        S = S * jnp.exp(bl)[..., 0, :, None] + jnp.einsum('bhjk,bhjv->bhkv', k_c, v_c)
        return S, o

    S0 = jnp.zeros((B, GLA_HEADS, GLA_HK, GLA_HV), f32)
    _, o_inter = lax.scan(step, S0, (q_t, k_dec, vf, b_last))
    o = (o_intra + o_inter).transpose(1, 0, 3, 2, 4).reshape(B, T, GLA_HEADS, GLA_HV)
    o = o * lax.rsqrt(jnp.mean(o * o, axis=-1, keepdims=True) + EPS) * g_onorm.astype(f32)
    o = o * jax.nn.silu(gate.astype(f32).reshape(B, T, GLA_HEADS, GLA_HV))
    return o.reshape(B, T, GLA_VAL_DIM).astype(h.dtype) @ w_out


def rel_bucket_band():
    i = np.arange(BLOCK)[:, None]
    j = np.arange(2 * BLOCK)[None, :]
    dist = i + BLOCK - j
    n = np.maximum(dist, 0)
    max_exact = REL_BUCKETS // 2
    large = max_exact + (np.log(np.maximum(n, 1) / max_exact)
                         / np.log(REL_MAX_DIST / max_exact)
                         * (REL_BUCKETS - max_exact)).astype(np.int32)
    large = np.minimum(large, REL_BUCKETS - 1)
    bucket = np.where(n < max_exact, n, large).astype(np.int32)
    valid = (dist >= 0) & (dist < WINDOW)
    return bucket, valid


def shared_kv(h, w_kv):
    B, T, _ = h.shape
    NB = T // BLOCK
    k, v = jnp.split(h @ w_kv, 2, axis=-1)

    def band(t):
        t = t.reshape(B, NB, BLOCK, SWA_KV_HEADS, SWA_HEAD_DIM)
        prev = jnp.concatenate([jnp.zeros_like(t[:, :1]), t[:, :-1]], axis=1)
        return jnp.concatenate([prev, t], axis=2)

    return band(k), band(v)


def swa_mixer(h, kb, vb, w_q, sinks, rel_table, w_out):
    B, T, _ = h.shape
    NB = T // BLOCK
    q = (h @ w_q).reshape(B, NB, BLOCK, SWA_KV_HEADS, SWA_GROUP, SWA_HEAD_DIM)
    s = jnp.einsum('bnqhgd,bnkhd->bnhgqk', q, kb).astype(jnp.float32) * (SWA_HEAD_DIM ** -0.5)
    bucket, valid = rel_bucket_band()
    bias = rel_table.astype(jnp.float32)[bucket]
    bias = bias.transpose(2, 0, 1).reshape(SWA_KV_HEADS, SWA_GROUP, BLOCK, 2 * BLOCK)
    first = (np.arange(NB)[:, None] == 0) & (np.arange(2 * BLOCK)[None, :] < BLOCK)
    mask = jnp.asarray(valid[None] & ~first[:, None, :])
    s = jnp.where(mask[None, :, None, None], s + bias, NEG)
    sink = sinks.astype(jnp.float32).reshape(SWA_KV_HEADS, SWA_GROUP, 1, 1)
    m = jnp.maximum(jnp.max(s, axis=-1, keepdims=True), sink)
    p = jnp.exp(s - m)
    p = p / (jnp.sum(p, axis=-1, keepdims=True) + jnp.exp(sink - m))
    o = jnp.einsum('bnhgqk,bnkhd->bnqhgd', p.astype(vb.dtype), vb)
    return o.reshape(B, T, SWA_Q_HEADS * SWA_HEAD_DIM) @ w_out


def setup_inputs(seed: int = 0) -> dict:
    key = jax.random.key(seed)
    ks = jax.random.split(key, 20)
    f32 = jnp.float32

    def w(k, shape, fan_in, scale=1.0):
        return jax.random.normal(k, shape, f32) * (scale * fan_in ** -0.5)

    def gain(k, shape):
        return 1.0 + 0.02 * jax.random.normal(k, shape, f32)

    return {
        "x": jax.random.normal(ks[0], (BATCH, SEQ, D_MODEL), f32),
        "a_w_in": w(ks[1], (N_A_LAYERS, D_MODEL, A_PROJ), D_MODEL),
        "a_w_gk2": w(ks[2], (N_A_LAYERS, GLA_GATE_RANK, GLA_KEY_DIM), GLA_GATE_RANK),
        "a_b_gk": 0.1 * jax.random.normal(ks[3], (N_A_LAYERS, GLA_KEY_DIM), f32),
        "a_onorm": gain(ks[4], (N_A_LAYERS, GLA_HV)),
        "a_w_out": w(ks[5], (N_A_LAYERS, GLA_VAL_DIM, D_MODEL), GLA_VAL_DIM),
        "kv_norm": gain(ks[6], (D_MODEL,)),
        "w_kv": w(ks[7], (D_MODEL, KV_PROJ), D_MODEL),
        "b_w_q": w(ks[8], (N_B_LAYERS, D_MODEL, SWA_Q_HEADS * SWA_HEAD_DIM), D_MODEL),
        "b_sinks": 0.5 * jax.random.normal(ks[9], (N_B_LAYERS, SWA_Q_HEADS), f32),
        "b_w_out": w(ks[10], (N_B_LAYERS, SWA_Q_HEADS * SWA_HEAD_DIM, D_MODEL), D_MODEL),
        "rel_table": 0.5 * jax.random.normal(ks[11], (REL_BUCKETS, SWA_Q_HEADS), f32),
        "ln_mix": gain(ks[12], (DEPTH, D_MODEL)),
        "ln_mlp": gain(ks[13], (DEPTH, D_MODEL)),
        "w_up": w(ks[14], (DEPTH, D_MODEL, D_FF), D_MODEL),
        "w_down": w(ks[15], (DEPTH, D_FF, D_MODEL), D_FF, scale=0.5),
        "ln_final": gain(ks[16], (D_MODEL,)),
    }


def reference(x, a_w_in, a_w_gk2, a_b_gk, a_onorm, a_w_out, kv_norm, w_kv, b_w_q, b_sinks,
              b_w_out, rel_table, ln_mix, ln_mlp, w_up, w_down, ln_final):
    h = x
    kb = vb = None
    for layer in range(DEPTH):
        if layer < N_A_LAYERS:
            h = h + gla_mixer(rmsnorm(h, ln_mix[layer]), a_w_in[layer], a_w_gk2[layer],
                              a_b_gk[layer], a_onorm[layer], a_w_out[layer])
        else:
            if layer == N_A_LAYERS:
                kb, vb = shared_kv(rmsnorm(h, kv_norm), w_kv)
            j = layer - N_A_LAYERS
            h = h + swa_mixer(rmsnorm(h, ln_mix[layer]), kb, vb, b_w_q[j], b_sinks[j],
                              rel_table, b_w_out[j])
        h = h + sq_relu_mlp(rmsnorm(h, ln_mlp[layer]), w_up[layer], w_down[layer])
    return rmsnorm(h, ln_final)
```

```cpp
#include <hip/hip_runtime.h>
#include <cstdio>
#include <cstdint>

#ifndef MK_N_LAUNCHES
#define MK_N_LAUNCHES 26
#endif

namespace pg8 {
#define PG8_LAS __attribute__((address_space(3)))
typedef unsigned short bf16_t;
typedef short bf16x8 __attribute__((ext_vector_type(8)));
typedef float f32x4 __attribute__((ext_vector_type(4)));
typedef unsigned u32x4 __attribute__((ext_vector_type(4)));
typedef unsigned u32x2 __attribute__((ext_vector_type(2)));
constexpr int BM = 256, BK = 64, HALF = 128, HTB = HALF * BK * 2, STAGE_BYTES = 8 * HTB, NXCD = 8, WGM = 8;

__host__ __device__ __forceinline__ int lds_byte(int r, int c) { const int st = (r >> 4) * 2 + (c >> 5), rr = r & 15, cc = c & 31, ob = rr * 64 + cc * 2; return st * 1024 + (ob ^ (((ob >> 9) & 1) << 5)); }
__host__ __device__ __forceinline__ void stage_rc(int b, int& R, int& C) { const int st = b / 1024, sb = b % 1024, swz = sb ^ (((sb >> 9) & 1) << 5); R = (st >> 1) * 16 + swz / 64; C = (st & 1) * 32 + (swz % 64) / 2; }
__host__ __device__ __forceinline__ int perm32(int rho) { const int n = rho >> 4, i = rho & 15; return 8 * (i >> 2) + 4 * n + (i & 3); }

struct Unit { int pm, pn; };
struct Gemm { const bf16_t* A; const bf16_t* Bt; int M, N, K, lda; };

struct StaticOrder {
    int nM, nN, nwg, G, c;
    __host__ __device__ void init(int M, int N, int G_, int c_) { nM = M / BM; nN = N / BM; nwg = nM * nN; G = G_; c = c_; }
    __host__ __device__ bool next(int i, Unit& u) const {
        const long L = (long)i * G + c; if (L >= nwg) return false;
        int wgid = (int)L; { const int q = nwg / NXCD, r = nwg % NXCD, xcd = wgid % NXCD, off = wgid / NXCD; wgid = (xcd < r ? xcd * (q + 1) : r * (q + 1) + (xcd - r) * q) + off; }
        const int nig = WGM * nN, gid = wgid / nig, fm = gid * WGM, gsz = (nM - fm) < WGM ? (nM - fm) : WGM;
        u.pm = fm + ((wgid % nig) % gsz); u.pn = (wgid % nig) / gsz; return true;
    }
    __device__ __forceinline__ void a_ready(const Unit&) const {}
    __device__ __forceinline__ void done(const Unit&) const {}
};

__device__ __forceinline__ unsigned cvt_pk_bf16(float lo, float hi) { unsigned r; asm volatile("v_cvt_pk_bf16_f32 %0, %1, %2" : "=v"(r) : "v"(lo), "v"(hi)); return r; }

constexpr int MROWS = 16384;
__device__ __forceinline__ float row_rstd(const float* ssq, int row) {
    float s = 0.f;
#pragma unroll
    for (int i = 0; i < 16; ++i) s += ssq[(size_t)i * MROWS + row];
    return 1.0f / sqrtf(s * (1.0f / 1024.0f) + 1e-6f);
}

struct EpiScale {
    static constexpr bool PERM = true, AFTER_DRAIN = false;
    bf16_t* O; int ldc; bf16_t* O2; int ldc2; int split_col; const float* ssq; int act;
    __device__ __forceinline__ void operator()(const f32x4 (&acc)[2][2][4][2], const Unit& u, int wr, int wc, int fr, int fq) const {
        const int row0 = u.pm * BM + wr * 64 + fr; int colt = u.pn * BM; bf16_t* base = O; int ld = ldc;
        if (colt >= split_col) { base = O2; colt -= split_col; ld = ldc2; }
        const int col0 = colt + wc * 32 + 8 * fq;
#pragma unroll
        for (int ai = 0; ai < 2; ++ai)
#pragma unroll
            for (int m = 0; m < 4; ++m) { const int row = row0 + ai * HALF + m * 16; const float rs = row_rstd(ssq, row); bf16_t* rowp = base + (size_t)row * ld + col0;
#pragma unroll
                for (int bj = 0; bj < 2; ++bj) { f32x4 v0 = acc[ai][bj][m][0] * rs, v1 = acc[ai][bj][m][1] * rs;
                    if (act == 1) {
#pragma unroll
                        for (int e = 0; e < 4; ++e) { float a = fmaxf(v0[e], 0.f); v0[e] = a * a; float b = fmaxf(v1[e], 0.f); v1[e] = b * b; } }
                    u32x4 w; w.x = cvt_pk_bf16(v0[0], v0[1]); w.y = cvt_pk_bf16(v0[2], v0[3]); w.z = cvt_pk_bf16(v1[0], v1[1]); w.w = cvt_pk_bf16(v1[2], v1[3]);
                    *(u32x4*)(rowp + bj * HALF) = w; } }
    }
};

struct EpiResid {
    static constexpr bool PERM = false, AFTER_DRAIN = false;
    const float* hin; float* hout; bf16_t* hb; float* ssq;
    __device__ __forceinline__ void operator()(const f32x4 (&acc)[2][2][4][2], const Unit& u, int wr, int wc, int fr, int fq) const {
        const int row0 = u.pm * BM + wr * 64 + fr, col0 = u.pn * BM + wc * 32 + 4 * fq;
#pragma unroll
        for (int ai = 0; ai < 2; ++ai)
#pragma unroll
            for (int m = 0; m < 4; ++m) { const int row = row0 + ai * HALF + m * 16; const size_t off = (size_t)row * 1024 + col0; float ss = 0.f;
#pragma unroll
                for (int bj = 0; bj < 2; ++bj)
#pragma unroll
                    for (int n = 0; n < 2; ++n) { const size_t o2 = off + bj * HALF + n * 16; const f32x4 v = *(const f32x4*)(hin + o2) + acc[ai][bj][m][n];
                        *(f32x4*)(hout + o2) = v; u32x2 w; w.x = cvt_pk_bf16(v[0], v[1]); w.y = cvt_pk_bf16(v[2], v[3]); *(u32x2*)(hb + o2) = w;
                        ss += (v[0] * v[0] + v[1] * v[1]) + (v[2] * v[2] + v[3] * v[3]); }
                ss += __shfl_xor(ss, 16); ss += __shfl_xor(ss, 32);
                if (fq == 0) ssq[(size_t)(u.pn * 4 + wc) * MROWS + row] = ss; }
    }
};

template <class Epi, class Sched, bool ALIGN_EPI = false, bool SP2 = false>
__device__ __forceinline__ void gemm_phase(PG8_LAS unsigned char* lds, const Gemm g, const Sched& S, const Epi& E) {
    int tid_ = threadIdx.x; asm volatile("" : "+v"(tid_)); const int tid = tid_, wid = __builtin_amdgcn_readfirstlane(tid >> 6), lane = tid & 63, wr = wid >> 2, wc = wid & 3, fr = lane & 15, fq = lane >> 4;
    const int K = g.K, nt = K / BK, lda = g.lda;
    unsigned voffA[2], voffB[2];
#pragma unroll
    for (int i = 0; i < 2; ++i) { int R, C; stage_rc(tid * 16 + i * 8192, R, C); const int Rb = Epi::PERM ? ((R & ~31) + perm32(R & 31)) : R;
        voffA[i] = (unsigned)(R * lda + C) * 2u; voffB[i] = (unsigned)(Rb * K + C) * 2u; }
    const size_t kstep = (size_t)(BK * 2);
    const size_t hstepA = (size_t)HALF * lda * 2, hstepB = (size_t)HALF * K * 2;
    const size_t tstepA = 2 * hstepA, tstepB = 2 * hstepB;
    const unsigned ldsw = (unsigned)wid * 1024u;
    const int aoff = lds_byte(wr * 64 + fr, fq * 8), boff = lds_byte(wc * 32 + fr, fq * 8);
#define PG8_SA(b, h) (((b) * 2 + (h)) * HTB)
#define PG8_SB(b, h) ((4 + (b) * 2 + (h)) * HTB)
#define PG8_STAGE(bufoff, gbase, voff) do { _Pragma("unroll") for (int _i = 0; _i < 2; ++_i) \
        __builtin_amdgcn_global_load_lds((const unsigned*)((const char*)(gbase) + (voff)[_i]), (PG8_LAS unsigned*)(lds + (bufoff) + ldsw + _i * 8192), 16, 0, 0); } while (0)
#define PG8_LDA(dst, b, h) do { _Pragma("unroll") for (int m = 0; m < 4; ++m) _Pragma("unroll") for (int k = 0; k < 2; ++k) dst[m][k] = *(const PG8_LAS bf16x8*)(lds + PG8_SA(b, h) + aoff + m * 2048 + k * 1024); } while (0)
#define PG8_LDB(dst, b, h) do { _Pragma("unroll") for (int n = 0; n < 2; ++n) _Pragma("unroll") for (int k = 0; k < 2; ++k) dst[n][k] = *(const PG8_LAS bf16x8*)(lds + PG8_SB(b, h) + boff + n * 2048 + k * 1024); } while (0)
#define PG8_MMA(ai, bj, At, Bt) do { __builtin_amdgcn_s_setprio(1); _Pragma("unroll") for (int m = 0; m < 4; ++m) _Pragma("unroll") for (int n = 0; n < 2; ++n) _Pragma("unroll") for (int k = 0; k < 2; ++k) \
        acc[ai][bj][m][n] = __builtin_amdgcn_mfma_f32_16x16x32_bf16(Bt[n][k], At[m][k], acc[ai][bj][m][n], 0, 0, 0); __builtin_amdgcn_s_setprio(0); } while (0)
#define PG8_WAIT_V(n) asm volatile("s_waitcnt vmcnt(" #n ")" ::: "memory")
#define PG8_WAIT_L(n) asm volatile("s_waitcnt lgkmcnt(" #n ")" ::: "memory")
#define PG8_BAR __builtin_amdgcn_s_barrier()
#define PG8_SCHED __builtin_amdgcn_sched_barrier(0)
    Unit cur, nxt; int ui = 0;
    if (!S.next(0, cur)) return;
    f32x4 acc[2][2][4][2];
#pragma unroll
    for (int a = 0; a < 2; ++a)
#pragma unroll
        for (int b = 0; b < 2; ++b)
#pragma unroll
            for (int m = 0; m < 4; ++m)
#pragma unroll
                for (int n = 0; n < 2; ++n) acc[a][b][m][n] = (f32x4){0.f, 0.f, 0.f, 0.f};
    bf16x8 At[4][2], B0[2][2], B1[2][2];
    const char* cA = (const char*)g.A + (size_t)cur.pm * tstepA; const char* cB = (const char*)g.Bt + (size_t)cur.pn * tstepB;
    S.a_ready(cur);
    if constexpr (SP2) {
        PG8_STAGE(PG8_SB(0, 0), cB, voffB); PG8_STAGE(PG8_SB(0, 1), cB + hstepB, voffB); PG8_STAGE(PG8_SA(0, 0), cA, voffA); PG8_STAGE(PG8_SA(0, 1), cA + hstepA, voffA);
        if (wr == 1) PG8_BAR;
        PG8_WAIT_V(2); PG8_BAR;
        PG8_STAGE(PG8_SB(1, 0), cB + kstep, voffB); PG8_STAGE(PG8_SA(1, 0), cA + kstep, voffA); PG8_STAGE(PG8_SB(1, 1), cB + hstepB + kstep, voffB);
        PG8_WAIT_V(6); PG8_BAR;
    } else {
        PG8_STAGE(PG8_SB(0, 0), cB, voffB); PG8_STAGE(PG8_SA(0, 0), cA, voffA); PG8_STAGE(PG8_SB(0, 1), cB + hstepB, voffB); PG8_STAGE(PG8_SA(0, 1), cA + hstepA, voffA);
        if (wr == 1) PG8_BAR;
        PG8_WAIT_V(4); PG8_BAR;
        PG8_STAGE(PG8_SB(1, 0), cB + kstep, voffB); PG8_STAGE(PG8_SA(1, 0), cA + kstep, voffA); PG8_STAGE(PG8_SB(1, 1), cB + hstepB + kstep, voffB);
        PG8_WAIT_V(6); PG8_BAR;
    }
    for (;;) {
        const bool has_next = S.next(ui + 1, nxt);
        const char* nA = has_next ? (const char*)g.A + (size_t)nxt.pm * tstepA : cA; const char* nB = has_next ? (const char*)g.Bt + (size_t)nxt.pn * tstepB : cB;
        for (int t = 0; t < nt; t += 2) {
            const bool last = (t == nt - 2);
            const char* a1 = cA + (size_t)(t + 1) * kstep;
            const char* a2 = last ? nA : cA + (size_t)(t + 2) * kstep; const char* b2 = last ? nB : cB + (size_t)(t + 2) * kstep;
            const char* a3 = a2 + kstep; const char* b3 = b2 + kstep;
            if (last && has_next) S.a_ready(nxt);
            if constexpr (SP2) {
            PG8_LDB(B0, 0, 0); PG8_LDB(B1, 0, 1); PG8_SCHED; PG8_LDA(At, 0, 0); PG8_STAGE(PG8_SA(1, 1), a1 + hstepA, voffA);
            PG8_WAIT_V(8); PG8_WAIT_L(0); PG8_BAR; PG8_MMA(0, 0, At, B0); PG8_MMA(0, 1, At, B1); PG8_BAR; PG8_SCHED;
            PG8_LDA(At, 0, 1); PG8_STAGE(PG8_SB(0, 0), b2, voffB); PG8_STAGE(PG8_SB(0, 1), b2 + hstepB, voffB); PG8_STAGE(PG8_SA(0, 0), a2, voffA);
            PG8_WAIT_V(8); PG8_WAIT_L(0); PG8_BAR; PG8_MMA(1, 0, At, B0); PG8_MMA(1, 1, At, B1); PG8_BAR; PG8_SCHED;
            PG8_LDB(B0, 1, 0); PG8_LDB(B1, 1, 1); PG8_SCHED; PG8_LDA(At, 1, 0); PG8_STAGE(PG8_SA(0, 1), a2 + hstepA, voffA);
            PG8_WAIT_V(8); PG8_WAIT_L(0); PG8_BAR; PG8_MMA(0, 0, At, B0); PG8_MMA(0, 1, At, B1); PG8_BAR; PG8_SCHED;
            PG8_LDA(At, 1, 1); PG8_STAGE(PG8_SB(1, 0), b3, voffB); PG8_STAGE(PG8_SB(1, 1), b3 + hstepB, voffB); PG8_STAGE(PG8_SA(1, 0), a3, voffA);
            PG8_WAIT_V(8); PG8_WAIT_L(0); PG8_BAR; PG8_MMA(1, 0, At, B0); PG8_MMA(1, 1, At, B1); PG8_BAR; PG8_SCHED;
            } else {
            PG8_LDB(B0, 0, 0); PG8_SCHED; PG8_LDA(At, 0, 0); PG8_STAGE(PG8_SA(1, 1), a1 + hstepA, voffA);
            PG8_WAIT_L(8); PG8_BAR; PG8_WAIT_L(0); PG8_MMA(0, 0, At, B0); PG8_BAR; PG8_SCHED;
            PG8_LDB(B1, 0, 1); PG8_STAGE(PG8_SB(0, 0), b2, voffB);
            PG8_BAR; PG8_WAIT_L(0); PG8_MMA(0, 1, At, B1); PG8_BAR;
            PG8_LDA(At, 0, 1); PG8_STAGE(PG8_SA(0, 0), a2, voffA);
            PG8_BAR; PG8_WAIT_L(0); PG8_MMA(1, 0, At, B0); PG8_BAR; PG8_SCHED;
            PG8_STAGE(PG8_SB(0, 1), b2 + hstepB, voffB);
            PG8_WAIT_V(6); PG8_BAR; PG8_MMA(1, 1, At, B1); PG8_BAR;
            PG8_LDB(B0, 1, 0); PG8_SCHED; PG8_LDA(At, 1, 0); PG8_STAGE(PG8_SA(0, 1), a2 + hstepA, voffA);
            PG8_WAIT_L(8); PG8_BAR; PG8_WAIT_L(0); PG8_MMA(0, 0, At, B0); PG8_BAR; PG8_SCHED;
            PG8_LDB(B1, 1, 1); PG8_STAGE(PG8_SB(1, 0), b3, voffB);
            PG8_BAR; PG8_WAIT_L(0); PG8_MMA(0, 1, At, B1); PG8_BAR;
            PG8_LDA(At, 1, 1); PG8_STAGE(PG8_SA(1, 0), a3, voffA);
            PG8_BAR; PG8_WAIT_L(0); PG8_MMA(1, 0, At, B0); PG8_BAR; PG8_SCHED;
            PG8_STAGE(PG8_SB(1, 1), b3 + hstepB, voffB);
            PG8_WAIT_V(6); PG8_BAR; PG8_MMA(1, 1, At, B1); PG8_BAR;
            }
        }
        if constexpr (ALIGN_EPI) { if (wr == 0) PG8_BAR; }
        if constexpr (!Epi::AFTER_DRAIN) { E(acc, cur, wr, wc, fr, fq); S.done(cur); }
        if (!has_next) break;
#pragma unroll
        for (int a = 0; a < 2; ++a)
#pragma unroll
            for (int b = 0; b < 2; ++b)
#pragma unroll
                for (int m = 0; m < 4; ++m)
#pragma unroll
                    for (int n = 0; n < 2; ++n) acc[a][b][m][n] = (f32x4){0.f, 0.f, 0.f, 0.f};
        cur = nxt; cA = nA; cB = nB; ++ui;
        if constexpr (ALIGN_EPI) { if (wr == 1) PG8_BAR; }
    }
    PG8_WAIT_V(0);
    if constexpr (!ALIGN_EPI) { if (wr == 0) PG8_BAR; }
    PG8_BAR;
#undef PG8_SA
#undef PG8_SB
#undef PG8_STAGE
#undef PG8_LDA
#undef PG8_LDB
#undef PG8_MMA
#undef PG8_WAIT_V
#undef PG8_WAIT_L
#undef PG8_BAR
#undef PG8_SCHED
}
}

constexpr int NWAVES = 8;
constexpr int N_LAUNCHES = MK_N_LAUNCHES;
constexpr int NPH = 26;
constexpr int M = 16384, D = 1024, T = 4096, FF = 4096, NIN = 3072, APROJ = 3088, KD = 512;
constexpr float EPS = 1e-6f, LOG2E = 1.4426950408889634f;

constexpr size_t MiB = 1u << 20;
constexpr size_t WS_CTL = 0, CTL_ZERO_BYTES = 1 * MiB;
constexpr size_t WS_SSQ = 1 * MiB;
constexpr size_t WS_WG = 2 * MiB;
constexpr size_t WS_BEND = 2 * MiB + 65536;
constexpr size_t WS_WIN = 3 * MiB;
constexpr size_t WS_KV = 3 * MiB;
constexpr size_t WS_WAO = 15 * MiB;
constexpr size_t WS_WUP = 19 * MiB;
constexpr size_t WS_WDN = 51 * MiB;
constexpr size_t WS_WQ = 83 * MiB;
constexpr size_t WS_WQ1 = WS_WQ + (size_t)1280 * 1024 * 2;
constexpr size_t WS_WBO = 88 * MiB;
constexpr size_t WS_HB = 92 * MiB;
constexpr size_t WS_U = 124 * MiB;
constexpr size_t WS_BCUM = WS_U + 96 * MiB;
constexpr size_t WS_END = 252 * MiB;
constexpr int CW_BAR = 4096;

constexpr int LDS_BYTES = 147456;
constexpr int RING_BYTES = 131072, LDSCTL_OFF = RING_BYTES, MISC_OFF = LDSCTL_OFF + 320;

#define GAS __attribute__((address_space(1)))
#define LAS __attribute__((address_space(3)))
typedef unsigned short bf16;
typedef unsigned v4u __attribute__((ext_vector_type(4)));
typedef unsigned v2u __attribute__((ext_vector_type(2)));
typedef float f32x4 __attribute__((ext_vector_type(4)));
typedef GAS unsigned gu32;
#define RLX_AGENT __ATOMIC_RELAXED, __HIP_MEMORY_SCOPE_AGENT
#define LDS_WAIT() asm volatile("s_waitcnt lgkmcnt(0)" ::: "memory")
#define VM_WAIT() asm volatile("s_waitcnt vmcnt(0)" ::: "memory")
__device__ __forceinline__ unsigned f2bf(float f) { unsigned u = __builtin_bit_cast(unsigned, f); return (u + 0x7fffu + ((u >> 16) & 1u)) >> 16; }
__device__ __forceinline__ unsigned pk2(float lo, float hi) { return f2bf(lo) | (f2bf(hi) << 16); }
__device__ __forceinline__ float bf2f(unsigned short b) { return __builtin_bit_cast(float, (unsigned)b << 16); }
__device__ __forceinline__ float bflo(unsigned w) { return __builtin_bit_cast(float, w << 16); }
__device__ __forceinline__ float bfhi(unsigned w) { return __builtin_bit_cast(float, w & 0xffff0000u); }

#define XB_TMO      128
#define XB_XCNT(j)  (256  + 64 * (j))
#define XB_XSUB(j)  (1280 + 64 * (j))
#define XB_XGEN(j)  (2304 + 64 * (j))
#define XB_TOP      3328
#define XB_TOPGEN   3392
#define XCD_BAR_WORDS 3456
#define XB_SPIN_CAP (1u << 18)
__device__ __forceinline__ unsigned xb_ld(unsigned* p)              { return __hip_atomic_load(p, __ATOMIC_RELAXED, __HIP_MEMORY_SCOPE_AGENT); }
__device__ __forceinline__ unsigned xb_add(unsigned* p, unsigned v) { return __hip_atomic_fetch_add(p, v, __ATOMIC_RELAXED, __HIP_MEMORY_SCOPE_AGENT); }
__device__ __forceinline__ unsigned xb_xcc_id() { return (unsigned)__builtin_amdgcn_s_getreg((3 << 11) | 20) & 0xFu; }
#define XB_SPIN(cond, bar) do { unsigned _sp = 0; while (cond) { __builtin_amdgcn_s_sleep(1); \
    if ((++_sp & 255u) == 0u) { if (xb_ld(&(bar)[XB_TMO])) break; if (_sp > XB_SPIN_CAP) { atomicAdd(&(bar)[XB_TMO], 1u); break; } } } } while (0)
struct XcdBarrier { unsigned* bar; unsigned x; volatile LAS unsigned* st; };
__device__ __forceinline__ XcdBarrier xcd_barrier_post(unsigned* bar, volatile LAS unsigned* st) {
    XcdBarrier b; b.bar = bar; b.x = xb_xcc_id(); b.st = st;
    if (threadIdx.x == 0) (void)xb_add(&bar[XB_XCNT(b.x)], 1u);
    return b;
}
__device__ __forceinline__ void xcd_barrier_complete(unsigned* bar, unsigned x, unsigned& nloc, unsigned& nx) {
    const unsigned G = gridDim.x * gridDim.y * gridDim.z;
    unsigned sum, cnt, mine, sp = 0u;
    for (;;) {
        sum = 0u; cnt = 0u; mine = 0u;
#pragma unroll
        for (unsigned j = 0; j < 16; ++j) { const unsigned c = xb_ld(&bar[XB_XCNT(j)]); sum += c; cnt += (c > 0u) ? 1u : 0u; mine = (j == x) ? c : mine; }
        if (sum == G) break;
        __builtin_amdgcn_s_sleep(1);
        if ((++sp & 255u) == 0u) { if (xb_ld(&bar[XB_TMO])) break; if (sp > XB_SPIN_CAP) { atomicAdd(&bar[XB_TMO], 1u); break; } }
    }
    nloc = mine > 0u ? mine : 1u; nx = cnt > 0u ? cnt : 1u;
}
__device__ __forceinline__ void xcd_barrier(const XcdBarrier& b) {
    asm volatile("s_waitcnt vmcnt(0)" ::: "memory");
    __syncthreads();
    if (threadIdx.x == 0) {
        unsigned* bar = b.bar;
        __builtin_amdgcn_s_waitcnt(0);
        unsigned nloc = b.st[0], nx = b.st[1];
        if (nloc == 0u) { xcd_barrier_complete(bar, b.x, nloc, nx); b.st[0] = nloc; b.st[1] = nx; }
        const unsigned old = xb_add(&bar[XB_XSUB(b.x)], 1u);
        const unsigned gen = old / nloc;
        if (old + 1u == (gen + 1u) * nloc) {
            __builtin_amdgcn_fence(__ATOMIC_RELEASE, "agent");
            asm volatile("s_waitcnt vmcnt(0)" ::: "memory");
            const unsigned og = xb_add(&bar[XB_TOP], 1u);
            const unsigned tg = og / nx;
            if (og + 1u == (tg + 1u) * nx) xb_add(&bar[XB_TOPGEN], 1u);
            else XB_SPIN(xb_ld(&bar[XB_TOPGEN]) == tg, bar);
            __builtin_amdgcn_fence(__ATOMIC_ACQUIRE, "agent");
            xb_add(&bar[XB_XGEN(b.x)], 1u);
            asm volatile("s_waitcnt vmcnt(0)" ::: "memory");
        } else {
            XB_SPIN(xb_ld(&bar[XB_XGEN(b.x)]) == gen, bar);
            __builtin_amdgcn_fence(__ATOMIC_ACQUIRE, "agent");
            asm volatile("s_waitcnt vmcnt(0)" ::: "memory");
        }
    }
    __syncthreads();
}

__device__ __forceinline__ float wave_sum(float v) {
#pragma unroll
    for (int o = 1; o < 64; o <<= 1) v += __shfl_xor(v, o);
    return v;
}

__device__ __forceinline__ void p0_transpose_item(const float* W, int ldw, int K, int nblk, bf16* WT, const float* gain, float scale, int nscale, LAS float* scr, int item, int lane) {
    const int kb = item / nblk, nb = item % nblk, k0 = 64 * kb, n0 = 32 * nb;
    const float sc = (n0 + (lane & 31)) < nscale ? scale : 1.0f;
#pragma unroll 8
    for (int i = 0; i < 32; ++i) { const int kk = 2 * i + (lane >> 5); const float g = gain ? gain[k0 + kk] : 1.0f; scr[kk * 33 + (lane & 31)] = W[(size_t)(k0 + kk) * ldw + n0 + (lane & 31)] * (g * sc); }
    LDS_WAIT(); asm volatile("" ::: "memory");
    const int c = lane & 7;
#pragma unroll
    for (int j = 0; j < 4; ++j) { const int n = (lane >> 3) + 8 * j; const LAS float* s = scr + (8 * c) * 33 + n;
        v4u o; o.x = pk2(s[0 * 33], s[1 * 33]); o.y = pk2(s[2 * 33], s[3 * 33]); o.z = pk2(s[4 * 33], s[5 * 33]); o.w = pk2(s[6 * 33], s[7 * 33]);
        *(GAS v4u*)(WT + (size_t)(n0 + n) * K + k0 + 8 * c) = o; }
    LDS_WAIT(); asm volatile("" ::: "memory");
}

struct Args { const float* in[17]; float* out; unsigned char* ws; int ph_lo, ph_hi, li, pad; };

__device__ __forceinline__ float logsigmoidf(float z) { return fminf(z, 0.f) - log1pf(__expf(-fabsf(z))); }

__global__ void __launch_bounds__(NWAVES * 64, 2) yoco_fwd(Args args) {
    extern __shared__ __attribute__((aligned(16))) unsigned char lds[];
    LAS unsigned char* ldsl = (LAS unsigned char*)lds;
    volatile LAS unsigned* MISC = (volatile LAS unsigned*)(ldsl + MISC_OFF);
    const int tid0 = threadIdx.x, lane0 = tid0 & 63, wave0 = __builtin_amdgcn_readfirstlane(tid0 >> 6);
#define PHASE_IDS int tid = threadIdx.x; asm volatile("" : "+v"(tid)); const int lane = tid & 63, wave = __builtin_amdgcn_readfirstlane(tid >> 6); (void)lane; (void)wave;
    const int G = gridDim.x; const int bx = blockIdx.x; const int vcu = (G % 8 == 0) ? (bx % 8) * (G / 8) + bx / 8 : bx;
    unsigned char* ws = args.ws;
    gu32* ctl = (gu32*)(ws + WS_CTL);
    const float* x = args.in[0]; const float* a_w_in = args.in[1]; const float* a_w_gk2 = args.in[2]; const float* a_b_gk = args.in[3]; const float* a_onorm = args.in[4];
    const float* a_w_out = args.in[5]; const float* kv_norm = args.in[6]; const float* w_kv = args.in[7]; const float* b_w_q = args.in[8]; const float* b_sinks = args.in[9];
    const float* b_w_out = args.in[10]; const float* rel_table = args.in[11]; const float* ln_mix = args.in[12]; const float* ln_mlp = args.in[13];
    const float* w_up = args.in[14]; const float* w_down = args.in[15]; const float* ln_final = args.in[16];
    float* out = args.out;
    float* ssq = (float*)(ws + WS_SSQ);
    bf16* Wg_t = (bf16*)(ws + WS_WG); float* BendG = (float*)(ws + WS_BEND);
    bf16* Win_t = (bf16*)(ws + WS_WIN); bf16* KVb = (bf16*)(ws + WS_KV); bf16* Wao_t = (bf16*)(ws + WS_WAO); bf16* Wup_t = (bf16*)(ws + WS_WUP); bf16* Wdn_t = (bf16*)(ws + WS_WDN);
    bf16* Wq0_t = (bf16*)(ws + WS_WQ); bf16* Wq1_t = (bf16*)(ws + WS_WQ1); bf16* Wbo_t = (bf16*)(ws + WS_WBO);
    bf16* HB = (bf16*)(ws + WS_HB); float* Sst = (float*)(ws + WS_HB);
    bf16* U = (bf16*)(ws + WS_U); bf16* QKVG = (bf16*)(ws + WS_U); bf16* Qb = (bf16*)(ws + WS_U); float* BCUM = (float*)(ws + WS_BCUM);

    for (int u = tid0; u < (LDS_BYTES - LDSCTL_OFF) / 4; u += NWAVES * 64) ((LAS unsigned*)(ldsl + LDSCTL_OFF))[u] = 0u;
    __syncthreads();
    XcdBarrier bar; bar.bar = (unsigned*)(ctl + CW_BAR) + args.li * XCD_BAR_WORDS; bar.x = 0; bar.st = nullptr;
    if (N_LAUNCHES != NPH) bar = xcd_barrier_post((unsigned*)(ctl + CW_BAR) + args.li * XCD_BAR_WORDS, MISC + 8);
#define GRID_BAR() do { if (N_LAUNCHES != NPH) xcd_barrier(bar); } while (0)
    const int lo = args.ph_lo, hi = args.ph_hi;
#define IN(k) (lo <= (k) && (k) < hi)
#define BOTH(k) (IN(k) && IN((k) + 1))

    if (IN(0)) { PHASE_IDS
        LAS float* scr = (LAS float*)(ldsl + wave * 16384);
        const int gw = vcu * NWAVES + wave, NGW = G * NWAVES;
        constexpr int I_IN = 16 * 96, I_SQ = 16 * 32, I_UP = 16 * 128, I_DN = 64 * 32, I_KV = 16 * 8;
        constexpr int NITEMS = 2 * I_IN + 2 * I_SQ + 4 * I_UP + 4 * I_DN + 2 * I_SQ + I_KV + 2 * I_SQ;
        for (int it = gw; it < NITEMS; it += NGW) {
            int r = it;
            if (r < 2 * I_IN) { const int l = r / I_IN; p0_transpose_item(a_w_in + (size_t)l * D * APROJ, APROJ, D, 96, Win_t + (size_t)l * NIN * D, ln_mix + l * D, 0.08838834764831845f, 512, scr, r % I_IN, lane); continue; } r -= 2 * I_IN;
            if (r < 2 * I_SQ) { const int l = r / I_SQ; p0_transpose_item(a_w_out + (size_t)l * D * D, D, D, 32, Wao_t + (size_t)l * D * D, nullptr, 1.f, 0, scr, r % I_SQ, lane); continue; } r -= 2 * I_SQ;
            if (r < 4 * I_UP) { const int l = r / I_UP; p0_transpose_item(w_up + (size_t)l * D * FF, FF, D, 128, Wup_t + (size_t)l * FF * D, ln_mlp + l * D, 1.f, 0, scr, r % I_UP, lane); continue; } r -= 4 * I_UP;
            if (r < 4 * I_DN) { const int l = r / I_DN; p0_transpose_item(w_down + (size_t)l * FF * D, D, FF, 32, Wdn_t + (size_t)l * D * FF, nullptr, 1.f, 0, scr, r % I_DN, lane); continue; } r -= 4 * I_DN;
            if (r < 2 * I_SQ) { const int j = r / I_SQ; p0_transpose_item(b_w_q + (size_t)j * D * D, D, D, 32, j == 0 ? Wq0_t : Wq1_t, ln_mix + (2 + j) * D, 0.125f * LOG2E, 1024, scr, r % I_SQ, lane); continue; } r -= 2 * I_SQ;
            if (r < I_KV) { p0_transpose_item(w_kv, 256, D, 8, Wq0_t + (size_t)1024 * D, kv_norm, 1.f, 0, scr, r, lane); continue; } r -= I_KV;
            { const int j = r / I_SQ; p0_transpose_item(b_w_out + (size_t)j * D * D, D, D, 32, Wbo_t + (size_t)j * D * D, nullptr, 1.f, 0, scr, r % I_SQ, lane); }
        }
        for (int e = vcu * 512 + tid; e < 2 * 16 * 1024; e += G * 512) { const int l = e >> 14, n = (e >> 10) & 15, k = e & 1023;
            Wg_t[e] = (bf16)f2bf(a_w_in[((size_t)l * D + k) * APROJ + NIN + n] * ln_mix[l * D + k]); }
        for (int m = gw; m < M; m += NGW) {
            const GAS f32x4* xr = (const GAS f32x4*)(x + (size_t)m * D) + lane; f32x4 v[4]; float s = 0.f;
#pragma unroll
            for (int j = 0; j < 4; ++j) { v[j] = xr[64 * j]; s += (v[j].x * v[j].x + v[j].y * v[j].y) + (v[j].z * v[j].z + v[j].w * v[j].w); }
            s = wave_sum(s);
            GAS unsigned long long* o8 = (GAS unsigned long long*)(HB + (size_t)m * D) + lane;
#pragma unroll
            for (int j = 0; j < 4; ++j) o8[64 * j] = (unsigned long long)pk2(v[j].x, v[j].y) | ((unsigned long long)pk2(v[j].z, v[j].w) << 32);
            if (lane < 16) ssq[(size_t)lane * M + m] = lane == 0 ? s : 0.f;
        }
        if (BOTH(0)) GRID_BAR();
    }

    for (int L = 0; L < 4; ++L) {
        const bool gla = L < 2; const int jb = L - 2;
        const int base = gla ? 1 + 7 * L : 15 + 5 * jb;
        const int pG1 = gla ? base + 4 : base + 2;
        if (IN(base)) { PHASE_IDS
            pg8::Gemm g; pg8::EpiScale E; E.ssq = ssq; E.act = 0;
            if (gla) { g = pg8::Gemm{HB, Win_t + (size_t)L * NIN * D, M, NIN, D, D}; E.O = QKVG; E.ldc = NIN; E.O2 = nullptr; E.ldc2 = 0; E.split_col = 1 << 30; }
            else if (jb == 0) { g = pg8::Gemm{HB, Wq0_t, M, 1280, D, D}; E.O = Qb; E.ldc = D; E.O2 = KVb; E.ldc2 = 256; E.split_col = 1024; }
            else { g = pg8::Gemm{HB, Wq1_t, M, 1024, D, D}; E.O = Qb; E.ldc = D; E.O2 = nullptr; E.ldc2 = 0; E.split_col = 1 << 30; }
            pg8::StaticOrder S; S.init(M, g.N, G, (int)blockIdx.x);
            pg8::gemm_phase<pg8::EpiScale, pg8::StaticOrder, true, true>(ldsl, g, S, E);
            if (gla) {
                float* glr_s = (float*)lds;
                const bf16* Wg = Wg_t + (size_t)L * 16 * 1024;
                for (int c = vcu; c < M / 64; c += G) {
                    __syncthreads();
                    { const int r = tid >> 3, part = tid & 7, row = c * 64 + r; const bf16* hr = HB + (size_t)row * D; const bf16* w0 = Wg + (size_t)(2 * part) * D; const bf16* w1 = w0 + D;
                      float a0 = 0.f, a1 = 0.f;
                      for (int k = 0; k < D; k += 8) { const v4u hv = *(const v4u*)(hr + k), u0 = *(const v4u*)(w0 + k), u1 = *(const v4u*)(w1 + k);
#pragma unroll
                          for (int e = 0; e < 4; ++e) { const float hl = bflo(hv[e]), hh = bfhi(hv[e]); a0 += hl * bflo(u0[e]) + hh * bfhi(u0[e]); a1 += hl * bflo(u1[e]) + hh * bfhi(u1[e]); } }
                      const float rs = pg8::row_rstd(ssq, row);
                      glr_s[r * 16 + 2 * part] = a0 * rs; glr_s[r * 16 + 2 * part + 1] = a1 * rs; }
                    __syncthreads();
                    { const int kd = tid; float w2[16];
#pragma unroll
                      for (int r = 0; r < 16; ++r) w2[r] = a_w_gk2[((size_t)L * 16 + r) * KD + kd];
                      const float bb = a_b_gk[L * KD + kd]; float run = 0.f;
                      for (int t = 0; t < 64; ++t) { float z = bb;
#pragma unroll
                          for (int r = 0; r < 16; ++r) z += glr_s[t * 16 + r] * w2[r];
                          run += logsigmoidf(z) * (1.0f / 16.0f); BCUM[(size_t)(c * 64 + t) * KD + kd] = run; } }
                }
                __syncthreads();
            }
            if (BOTH(base)) GRID_BAR();
        }
        if (gla) {
            if (IN(base + 1)) { PHASE_IDS
                float* kdec = (float*)lds;
                float* vs = (float*)(lds + 16384);
                float* offs = (float*)(lds + 49152);
                for (int un = vcu; un < 256; un += G) {
                    const int seq = un >> 4, sc = un & 15, b = seq >> 2, h = seq & 3; const size_t t0 = (size_t)b * T + sc * 256;
                    __syncthreads();
                    if (tid < 128) { float o = 0.f;
                        for (int c = 0; c < 4; ++c) { offs[c * 128 + tid] = o; o += BCUM[(t0 + 64 * c + 63) * KD + h * 128 + tid]; }
                        offs[512 + tid] = o; BendG[(size_t)un * 128 + tid] = o; }
                    __syncthreads();
                    float acc[8][8];
#pragma unroll
                    for (int i = 0; i < 8; ++i)
#pragma unroll
                        for (int j = 0; j < 8; ++j) acc[i][j] = 0.f;
                    const int tk = tid >> 5, tv = tid & 31;
                    for (int tb = 0; tb < 8; ++tb) {
                        { const int tt = tid >> 4, k8 = (tid & 15) * 8, t = tb * 32 + tt, c = t >> 6; const size_t tok = t0 + t;
                          const v4u kv = *(const v4u*)(QKVG + tok * NIN + 512 + h * 128 + k8);
                          const f32x4 b0 = *(const f32x4*)(BCUM + tok * KD + h * 128 + k8), b1 = *(const f32x4*)(BCUM + tok * KD + h * 128 + k8 + 4);
#pragma unroll
                          for (int e = 0; e < 8; ++e) { const float kk = (e & 1) ? bfhi(kv[e >> 1]) : bflo(kv[e >> 1]); const float bc = (e < 4 ? b0[e] : b1[e - 4]) + offs[c * 128 + k8 + e];
                              kdec[tt * 128 + k8 + e] = kk * __expf(offs[512 + k8 + e] - bc); }
                          const int v16 = (tid & 15) * 16;
                          const v4u va = *(const v4u*)(QKVG + tok * NIN + 1024 + h * 256 + v16), vb = *(const v4u*)(QKVG + tok * NIN + 1024 + h * 256 + v16 + 8);
#pragma unroll
                          for (int e = 0; e < 4; ++e) { vs[tt * 256 + v16 + 2 * e] = bflo(va[e]); vs[tt * 256 + v16 + 2 * e + 1] = bfhi(va[e]); vs[tt * 256 + v16 + 8 + 2 * e] = bflo(vb[e]); vs[tt * 256 + v16 + 8 + 2 * e + 1] = bfhi(vb[e]); } }
                        __syncthreads();
                        for (int tt = 0; tt < 32; ++tt) { float a[8], bb[8];
#pragma unroll
                            for (int i = 0; i < 8; ++i) { a[i] = kdec[tt * 128 + tk * 8 + i]; bb[i] = vs[tt * 256 + tv * 8 + i]; }
#pragma unroll
                            for (int i = 0; i < 8; ++i)
#pragma unroll
                                for (int j = 0; j < 8; ++j) acc[i][j] += a[i] * bb[j]; }
                        __syncthreads();
                    }
#pragma unroll
                    for (int i = 0; i < 8; ++i) { float* p = Sst + ((size_t)un * 128 + tk * 8 + i) * 256 + tv * 8;
                        *(f32x4*)p = (f32x4){acc[i][0], acc[i][1], acc[i][2], acc[i][3]}; *(f32x4*)(p + 4) = (f32x4){acc[i][4], acc[i][5], acc[i][6], acc[i][7]}; }
                }
                if (BOTH(base + 1)) GRID_BAR();
            }
            if (IN(base + 2)) { PHASE_IDS
                for (int w = vcu * 512 + tid; w < 16 * 32768; w += G * 512) { const int seq = w >> 15, e = w & 32767, kd = e >> 8; float run = 0.f;
                    for (int sc = 0; sc < 16; ++sc) { float* p = Sst + (size_t)(seq * 16 + sc) * 32768 + e; const float tmp = *p; *p = run; run = run * __expf(BendG[(size_t)(seq * 16 + sc) * 128 + kd]) + tmp; } }
                if (BOTH(base + 2)) GRID_BAR();
            }
            if (IN(base + 3)) { PHASE_IDS
                bf16* kT = (bf16*)lds;
                float* qT = (float*)(lds + 65536);
                float* attn = (float*)(lds + 65536 + 16384);
                float* offs = (float*)(lds + 65536 + 16384 + 32768);
                for (int un = vcu; un < 256; un += G) {
                    const int seq = un >> 4, sc = un & 15, b = seq >> 2, h = seq & 3; const size_t t0 = (size_t)b * T + sc * 256;
                    __syncthreads();
                    if (tid < 128) { float o = 0.f;
                        for (int c = 0; c < 4; ++c) { offs[c * 128 + tid] = o; o += BCUM[(t0 + 64 * c + 63) * KD + h * 128 + tid]; } }
                    __syncthreads();
                    for (int e8 = tid; e8 < 256 * 16; e8 += 512) { const int t = e8 >> 4, k8 = (e8 & 15) * 8, c = t >> 6; const size_t tok = t0 + t;
                        const v4u kv = *(const v4u*)(QKVG + tok * NIN + 512 + h * 128 + k8);
                        const f32x4 b0 = *(const f32x4*)(BCUM + tok * KD + h * 128 + k8), b1 = *(const f32x4*)(BCUM + tok * KD + h * 128 + k8 + 4);
                        float r[8];
#pragma unroll
                        for (int e = 0; e < 8; ++e) { const float kk = (e & 1) ? bfhi(kv[e >> 1]) : bflo(kv[e >> 1]); const float bc = (e < 4 ? b0[e] : b1[e - 4]) + offs[c * 128 + k8 + e]; r[e] = kk * __expf(-bc); }
                        v4u o; o.x = pk2(r[0], r[1]); o.y = pk2(r[2], r[3]); o.z = pk2(r[4], r[5]); o.w = pk2(r[6], r[7]);
                        *(v4u*)(kT + t * 128 + k8) = o; }
                    for (int qb = 0; qb < 8; ++qb) {
                        __syncthreads();
                        { const int tt = tid >> 4, k8 = (tid & 15) * 8, t = qb * 32 + tt, c = t >> 6; const size_t tok = t0 + t;
                          const v4u qv = *(const v4u*)(QKVG + tok * NIN + h * 128 + k8);
                          const f32x4 b0 = *(const f32x4*)(BCUM + tok * KD + h * 128 + k8), b1 = *(const f32x4*)(BCUM + tok * KD + h * 128 + k8 + 4);
#pragma unroll
                          for (int e = 0; e < 8; ++e) { const float qq = (e & 1) ? bfhi(qv[e >> 1]) : bflo(qv[e >> 1]); const float bc = (e < 4 ? b0[e] : b1[e - 4]) + offs[c * 128 + k8 + e];
                              qT[tt * 128 + k8 + e] = qq * __expf(bc); } }
                        __syncthreads();
                        { const int qi = tid >> 4, jg = tid & 15, tq = qb * 32 + qi;
                          for (int i = 0; i < 16; ++i) { const int j = jg + 16 * i; float s = 0.f;
                              if (j <= tq) { for (int k = 0; k < 128; k += 8) { const v4u kv = *(const v4u*)(kT + j * 128 + k);
#pragma unroll
                                      for (int e = 0; e < 4; ++e) s += qT[qi * 128 + k + 2 * e] * bflo(kv[e]) + qT[qi * 128 + k + 2 * e + 1] * bfhi(kv[e]); } }
                              attn[qi * 256 + j] = s; } }
                        __syncthreads();
                        { const int qi = tid >> 4, vg = tid & 15, tq = qb * 32 + qi, v16 = vg * 16; float o[16];
#pragma unroll
                          for (int e = 0; e < 16; ++e) o[e] = 0.f;
                          for (int j = 0; j <= tq; ++j) { const float a = attn[qi * 256 + j]; const bf16* vp = QKVG + (t0 + j) * NIN + 1024 + h * 256 + v16; const v4u va = *(const v4u*)vp, vb = *(const v4u*)(vp + 8);
#pragma unroll
                              for (int e = 0; e < 4; ++e) { o[2 * e] += a * bflo(va[e]); o[2 * e + 1] += a * bfhi(va[e]); o[8 + 2 * e] += a * bflo(vb[e]); o[8 + 2 * e + 1] += a * bfhi(vb[e]); } }
                          for (int k = 0; k < 128; ++k) { const float a = qT[qi * 128 + k]; const float* sp = Sst + ((size_t)un * 128 + k) * 256 + v16;
#pragma unroll
                              for (int e4 = 0; e4 < 4; ++e4) { const f32x4 sv = *(const f32x4*)(sp + 4 * e4); o[4 * e4] += a * sv[0]; o[4 * e4 + 1] += a * sv[1]; o[4 * e4 + 2] += a * sv[2]; o[4 * e4 + 3] += a * sv[3]; } }
                          float ss = 0.f;
#pragma unroll
                          for (int e = 0; e < 16; ++e) ss += o[e] * o[e];
                          ss += __shfl_xor(ss, 1); ss += __shfl_xor(ss, 2); ss += __shfl_xor(ss, 4); ss += __shfl_xor(ss, 8);
                          const float rs = 1.0f / sqrtf(ss * (1.0f / 256.0f) + EPS);
                          bf16* gp = QKVG + (t0 + tq) * NIN + 2048 + h * 256 + v16; const v4u ga = *(const v4u*)gp, gb = *(const v4u*)(gp + 8); float r[16];
#pragma unroll
                          for (int e = 0; e < 16; ++e) { const unsigned w = e < 8 ? ga[e >> 1] : gb[(e - 8) >> 1]; const float gt = (e & 1) ? bfhi(w) : bflo(w);
                              const float sil = gt / (1.0f + __expf(-gt)); r[e] = o[e] * rs * a_onorm[L * 256 + v16 + e] * sil; }
                          v4u oa, ob; oa.x = pk2(r[0], r[1]); oa.y = pk2(r[2], r[3]); oa.z = pk2(r[4], r[5]); oa.w = pk2(r[6], r[7]); ob.x = pk2(r[8], r[9]); ob.y = pk2(r[10], r[11]); ob.z = pk2(r[12], r[13]); ob.w = pk2(r[14], r[15]);
                          *(v4u*)gp = oa; *(v4u*)(gp + 8) = ob; }
                    }
                }
                if (BOTH(base + 3)) GRID_BAR();
            }
        } else {
            if (IN(base + 1)) { PHASE_IDS
                float* Ks = (float*)lds;
                float* Vs = (float*)(lds + 65536);
                float* bias_s = (float*)(lds + 131072);
                (void)bias_s;
                for (int un = vcu; un < 256; un += G) {
                    const int b = un >> 6, nb = (un >> 1) & 31, kvh = un & 1; const size_t tq0 = (size_t)b * T + nb * 128;
                    __syncthreads();
                    for (int e8 = tid; e8 < 256 * 8; e8 += 512) { const int j = e8 >> 3, d8 = (e8 & 7) * 8; float kf[8], vf[8];
                        if (nb == 0 && j < 128) {
#pragma unroll
                            for (int e = 0; e < 8; ++e) { kf[e] = 0.f; vf[e] = 0.f; }
                        } else { const size_t tok = tq0 - 128 + j; const v4u kv = *(const v4u*)(KVb + tok * 256 + kvh * 64 + d8), vv = *(const v4u*)(KVb + tok * 256 + 128 + kvh * 64 + d8);
#pragma unroll
                            for (int e = 0; e < 4; ++e) { kf[2 * e] = bflo(kv[e]); kf[2 * e + 1] = bfhi(kv[e]); vf[2 * e] = bflo(vv[e]); vf[2 * e + 1] = bfhi(vv[e]); } }
#pragma unroll
                        for (int e = 0; e < 8; ++e) { Ks[j * 64 + d8 + e] = kf[e]; Vs[j * 64 + d8 + e] = vf[e]; } }
                    __syncthreads();
                    for (int p = tid; p < 1024; p += 512) { const int g = p >> 7, qi = p & 127, head = kvh * 8 + g;
                        bf16* qp = Qb + (tq0 + qi) * D + head * 64; float q[64];
#pragma unroll
                        for (int c = 0; c < 8; ++c) { const v4u qv = *(const v4u*)(qp + 8 * c);
#pragma unroll
                            for (int e = 0; e < 4; ++e) { q[8 * c + 2 * e] = bflo(qv[e]); q[8 * c + 2 * e + 1] = bfhi(qv[e]); } }
                        float m = b_sinks[jb * 16 + head] * LOG2E, l = 1.0f; float o[64];
#pragma unroll
                        for (int d = 0; d < 64; ++d) o[d] = 0.f;
                        const int jstart = (nb == 0) ? 128 : qi + 1;
                        for (int j = jstart; j <= qi + 128; ++j) { const int dist = qi + 128 - j;
                            int bk = dist; if (dist >= 16) { bk = 16 + (dist >= 19) + (dist >= 21) + (dist >= 24) + (dist >= 27) + (dist >= 31) + (dist >= 35) + (dist >= 40) + (dist >= 46) + (dist >= 52) + (dist >= 59) + (dist >= 67) + (dist >= 77) + (dist >= 87) + (dist >= 99) + (dist >= 113); }
                            float s = rel_table[bk * 16 + head] * LOG2E;
#pragma unroll
                            for (int d = 0; d < 64; ++d) s += q[d] * Ks[j * 64 + d];
                            if (s > m) { const float f = exp2f(m - s); l *= f;
#pragma unroll
                                for (int d = 0; d < 64; ++d) o[d] *= f;
                                m = s; }
                            const float pe = exp2f(s - m); l += pe;
#pragma unroll
                            for (int d = 0; d < 64; ++d) o[d] += pe * Vs[j * 64 + d]; }
                        const float il = 1.0f / l;
#pragma unroll
                        for (int c = 0; c < 8; ++c) { v4u w;
                            w.x = pk2(o[8 * c] * il, o[8 * c + 1] * il); w.y = pk2(o[8 * c + 2] * il, o[8 * c + 3] * il); w.z = pk2(o[8 * c + 4] * il, o[8 * c + 5] * il); w.w = pk2(o[8 * c + 6] * il, o[8 * c + 7] * il);
                            *(v4u*)(qp + 8 * c) = w; } }
                }
                if (BOTH(base + 1)) GRID_BAR();
            }
        }
        if (IN(pG1)) {
            pg8::Gemm g; pg8::EpiResid E; E.hin = (L == 0) ? x : out; E.hout = out; E.hb = HB; E.ssq = ssq;
            if (gla) g = pg8::Gemm{QKVG + 2048, Wao_t + (size_t)L * D * D, M, D, D, NIN};
            else g = pg8::Gemm{Qb, Wbo_t + (size_t)jb * D * D, M, D, D, D};
            pg8::StaticOrder S; S.init(M, D, G, (int)blockIdx.x);
            pg8::gemm_phase<pg8::EpiResid, pg8::StaticOrder, false, true>(ldsl, g, S, E);
            if (BOTH(pG1)) GRID_BAR();
        }
        if (IN(pG1 + 1)) {
            pg8::Gemm g{HB, Wup_t + (size_t)L * FF * D, M, FF, D, D};
            pg8::EpiScale E; E.O = U; E.ldc = FF; E.O2 = nullptr; E.ldc2 = 0; E.split_col = 1 << 30; E.ssq = ssq; E.act = 1;
            pg8::StaticOrder S; S.init(M, FF, G, (int)blockIdx.x);
            pg8::gemm_phase<pg8::EpiScale, pg8::StaticOrder, true, true>(ldsl, g, S, E);
            if (BOTH(pG1 + 1)) GRID_BAR();
        }
        if (IN(pG1 + 2)) {
            pg8::Gemm g{U, Wdn_t + (size_t)L * D * FF, M, D, FF, FF};
            pg8::EpiResid E; E.hin = out; E.hout = out; E.hb = HB; E.ssq = ssq;
            pg8::StaticOrder S; S.init(M, D, G, (int)blockIdx.x);
            pg8::gemm_phase<pg8::EpiResid, pg8::StaticOrder, false, true>(ldsl, g, S, E);
            if (BOTH(pG1 + 2)) GRID_BAR();
        }
    }
    if (IN(25)) { PHASE_IDS
        const int gw = vcu * NWAVES + wave, NGW = G * NWAVES;
        for (int m = gw; m < M; m += NGW) {
            const float rs = pg8::row_rstd(ssq, m);
            GAS f32x4* hr = (GAS f32x4*)(out + (size_t)m * D) + lane; const f32x4* gr = (const f32x4*)ln_final + lane;
#pragma unroll
            for (int j = 0; j < 4; ++j) { const f32x4 v = hr[64 * j], gg = gr[64 * j]; hr[64 * j] = v * rs * gg; }
        }
    }
#undef IN
#undef BOTH
#undef GRID_BAR
}

extern "C" void kernel_launch(void* const* d_in, const int* in_sizes, int n_in, void* d_out, int out_size, void* d_ws, size_t ws_size, hipStream_t stream) {
    static int grid = 0;
    if (grid == 0) {
        if (n_in != 17 || in_sizes[0] != M * D || out_size != M * D || ws_size < WS_END) { fprintf(stderr, "kernel_launch: unexpected shapes (n_in %d, in0 %d, out %d, ws %zu)\n", n_in, n_in > 0 ? in_sizes[0] : -1, out_size, ws_size); grid = -1; return; }
        int dev = 0, cus = 0;
        if (hipGetDevice(&dev) != hipSuccess || hipDeviceGetAttribute(&cus, hipDeviceAttributeMultiprocessorCount, dev) != hipSuccess) { grid = -1; return; }
        if (hipFuncSetAttribute((const void*)yoco_fwd, hipFuncAttributeMaxDynamicSharedMemorySize, LDS_BYTES) != hipSuccess) { fprintf(stderr, "kernel_launch: hipFuncSetAttribute failed\n"); grid = -1; return; }
        (void)hipGetLastError();
        grid = cus;
    }
    if (grid < 0) return;
    if (hipMemsetAsync((char*)d_ws + WS_CTL, 0, CTL_ZERO_BYTES, stream) != hipSuccess) return;
    Args a{};
    for (int i = 0; i < 17; ++i) a.in[i] = (const float*)d_in[i];
    a.out = (float*)d_out; a.ws = (unsigned char*)d_ws;
    if (N_LAUNCHES == 1) {
        a.ph_lo = 0; a.ph_hi = NPH; a.li = 0;
        hipLaunchKernelGGL(yoco_fwd, dim3(grid), dim3(NWAVES * 64), LDS_BYTES, stream, a);
    } else {
        for (int p = 0; p < NPH; ++p) { a.ph_lo = p; a.ph_hi = p + 1; a.li = 0;
            hipLaunchKernelGGL(yoco_fwd, dim3(grid), dim3(NWAVES * 64), LDS_BYTES, stream, a); }
    }
}
```

```cpp
#include <hip/hip_runtime.h>
#include <cstdio>
#include <cstdint>

#ifndef MK_N_LAUNCHES
#define MK_N_LAUNCHES 1
#endif

namespace pg8 {
#define PG8_LAS __attribute__((address_space(3)))
typedef unsigned short bf16_t;
typedef short bf16x8 __attribute__((ext_vector_type(8)));
typedef float f32x4 __attribute__((ext_vector_type(4)));
typedef unsigned u32x4 __attribute__((ext_vector_type(4)));
typedef unsigned u32x2 __attribute__((ext_vector_type(2)));
constexpr int BM = 256, BK = 64, HALF = 128, HTB = HALF * BK * 2, STAGE_BYTES = 8 * HTB, NXCD = 8, WGM = 8;

__host__ __device__ __forceinline__ int lds_byte(int r, int c) { const int st = (r >> 4) * 2 + (c >> 5), rr = r & 15, cc = c & 31, ob = rr * 64 + cc * 2; return st * 1024 + (ob ^ (((ob >> 9) & 1) << 5)); }
__host__ __device__ __forceinline__ void stage_rc(int b, int& R, int& C) { const int st = b / 1024, sb = b % 1024, swz = sb ^ (((sb >> 9) & 1) << 5); R = (st >> 1) * 16 + swz / 64; C = (st & 1) * 32 + (swz % 64) / 2; }
__host__ __device__ __forceinline__ int perm32(int rho) { const int n = rho >> 4, i = rho & 15; return 8 * (i >> 2) + 4 * n + (i & 3); }

struct Unit { int pm, pn; };
struct Gemm { const bf16_t* A; const bf16_t* Bt; int M, N, K, lda; };

struct StaticOrder {
    int nM, nN, nwg, G, c;
    __host__ __device__ void init(int M, int N, int G_, int c_) { nM = M / BM; nN = N / BM; nwg = nM * nN; G = G_; c = c_; }
    __host__ __device__ bool next(int i, Unit& u) const {
        const long L = (long)i * G + c; if (L >= nwg) return false;
        int wgid = (int)L; { const int q = nwg / NXCD, r = nwg % NXCD, xcd = wgid % NXCD, off = wgid / NXCD; wgid = (xcd < r ? xcd * (q + 1) : r * (q + 1) + (xcd - r) * q) + off; }
        const int nig = WGM * nN, gid = wgid / nig, fm = gid * WGM, gsz = (nM - fm) < WGM ? (nM - fm) : WGM;
        u.pm = fm + ((wgid % nig) % gsz); u.pn = (wgid % nig) / gsz; return true;
    }
    __device__ __forceinline__ void a_ready(const Unit&) const {}
    __device__ __forceinline__ void done(const Unit&) const {}
};

__device__ __forceinline__ unsigned cvt_pk_bf16(float lo, float hi) { unsigned r; asm volatile("v_cvt_pk_bf16_f32 %0, %1, %2" : "=v"(r) : "v"(lo), "v"(hi)); return r; }

constexpr int MROWS = 16384;
__device__ __forceinline__ float row_rstd(const float* ssq, int row) {
    float s = 0.f;
#pragma unroll
    for (int i = 0; i < 16; ++i) s += ssq[(size_t)i * MROWS + row];
    return 1.0f / sqrtf(s * (1.0f / 1024.0f) + 1e-6f);
}

struct EpiScale {
    static constexpr bool PERM = true, AFTER_DRAIN = false;
    bf16_t* O; int ldc; bf16_t* O2; int ldc2; int split_col; const float* ssq; int act;
    __device__ __forceinline__ void operator()(const f32x4 (&acc)[2][2][4][2], const Unit& u, int wr, int wc, int fr, int fq) const {
        const int row0 = u.pm * BM + wr * 64 + fr; int colt = u.pn * BM; bf16_t* base = O; int ld = ldc;
        if (colt >= split_col) { base = O2; colt -= split_col; ld = ldc2; }
        const int col0 = colt + wc * 32 + 8 * fq;
#pragma unroll
        for (int ai = 0; ai < 2; ++ai)
#pragma unroll
            for (int m = 0; m < 4; ++m) { const int row = row0 + ai * HALF + m * 16; const float rs = row_rstd(ssq, row); bf16_t* rowp = base + (size_t)row * ld + col0;
#pragma unroll
                for (int bj = 0; bj < 2; ++bj) { f32x4 v0 = acc[ai][bj][m][0] * rs, v1 = acc[ai][bj][m][1] * rs;
                    if (act == 1) {
#pragma unroll
                        for (int e = 0; e < 4; ++e) { float a = fmaxf(v0[e], 0.f); v0[e] = a * a; float b = fmaxf(v1[e], 0.f); v1[e] = b * b; } }
                    u32x4 w; w.x = cvt_pk_bf16(v0[0], v0[1]); w.y = cvt_pk_bf16(v0[2], v0[3]); w.z = cvt_pk_bf16(v1[0], v1[1]); w.w = cvt_pk_bf16(v1[2], v1[3]);
                    *(u32x4*)(rowp + bj * HALF) = w; } }
    }
};

struct EpiResid {
    static constexpr bool PERM = false, AFTER_DRAIN = false;
    const float* hin; float* hout; bf16_t* hb; float* ssq;
    __device__ __forceinline__ void operator()(const f32x4 (&acc)[2][2][4][2], const Unit& u, int wr, int wc, int fr, int fq) const {
        const int row0 = u.pm * BM + wr * 64 + fr, col0 = u.pn * BM + wc * 32 + 4 * fq;
#pragma unroll
        for (int ai = 0; ai < 2; ++ai)
#pragma unroll
            for (int m = 0; m < 4; ++m) { const int row = row0 + ai * HALF + m * 16; const size_t off = (size_t)row * 1024 + col0; float ss = 0.f;
#pragma unroll
                for (int bj = 0; bj < 2; ++bj)
#pragma unroll
                    for (int n = 0; n < 2; ++n) { const size_t o2 = off + bj * HALF + n * 16; const f32x4 v = *(const f32x4*)(hin + o2) + acc[ai][bj][m][n];
                        *(f32x4*)(hout + o2) = v; u32x2 w; w.x = cvt_pk_bf16(v[0], v[1]); w.y = cvt_pk_bf16(v[2], v[3]); *(u32x2*)(hb + o2) = w;
                        ss += (v[0] * v[0] + v[1] * v[1]) + (v[2] * v[2] + v[3] * v[3]); }
                ss += __shfl_xor(ss, 16); ss += __shfl_xor(ss, 32);
                if (fq == 0) ssq[(size_t)(u.pn * 4 + wc) * MROWS + row] = ss; }
    }
};

template <class Epi, class Sched, bool ALIGN_EPI = false, bool SP2 = false>
__device__ __forceinline__ void gemm_phase(PG8_LAS unsigned char* lds, const Gemm g, const Sched& S, const Epi& E) {
    int tid_ = threadIdx.x; asm volatile("" : "+v"(tid_)); const int tid = tid_, wid = __builtin_amdgcn_readfirstlane(tid >> 6), lane = tid & 63, wr = wid >> 2, wc = wid & 3, fr = lane & 15, fq = lane >> 4;
    const int K = g.K, nt = K / BK, lda = g.lda;
    unsigned voffA[2], voffB[2];
#pragma unroll
    for (int i = 0; i < 2; ++i) { int R, C; stage_rc(tid * 16 + i * 8192, R, C); const int Rb = Epi::PERM ? ((R & ~31) + perm32(R & 31)) : R;
        voffA[i] = (unsigned)(R * lda + C) * 2u; voffB[i] = (unsigned)(Rb * K + C) * 2u; }
    const size_t kstep = (size_t)(BK * 2);
    const size_t hstepA = (size_t)HALF * lda * 2, hstepB = (size_t)HALF * K * 2;
    const size_t tstepA = 2 * hstepA, tstepB = 2 * hstepB;
    const unsigned ldsw = (unsigned)wid * 1024u;
    const int aoff = lds_byte(wr * 64 + fr, fq * 8), boff = lds_byte(wc * 32 + fr, fq * 8);
#define PG8_SA(b, h) (((b) * 2 + (h)) * HTB)
#define PG8_SB(b, h) ((4 + (b) * 2 + (h)) * HTB)
#define PG8_STAGE(bufoff, gbase, voff) do { _Pragma("unroll") for (int _i = 0; _i < 2; ++_i) \
        __builtin_amdgcn_global_load_lds((const unsigned*)((const char*)(gbase) + (voff)[_i]), (PG8_LAS unsigned*)(lds + (bufoff) + ldsw + _i * 8192), 16, 0, 0); } while (0)
#define PG8_LDA(dst, b, h) do { _Pragma("unroll") for (int m = 0; m < 4; ++m) _Pragma("unroll") for (int k = 0; k < 2; ++k) dst[m][k] = *(const PG8_LAS bf16x8*)(lds + PG8_SA(b, h) + aoff + m * 2048 + k * 1024); } while (0)
#define PG8_LDB(dst, b, h) do { _Pragma("unroll") for (int n = 0; n < 2; ++n) _Pragma("unroll") for (int k = 0; k < 2; ++k) dst[n][k] = *(const PG8_LAS bf16x8*)(lds + PG8_SB(b, h) + boff + n * 2048 + k * 1024); } while (0)
#define PG8_MMA(ai, bj, At, Bt) do { __builtin_amdgcn_s_setprio(1); _Pragma("unroll") for (int m = 0; m < 4; ++m) _Pragma("unroll") for (int n = 0; n < 2; ++n) _Pragma("unroll") for (int k = 0; k < 2; ++k) \
        acc[ai][bj][m][n] = __builtin_amdgcn_mfma_f32_16x16x32_bf16(Bt[n][k], At[m][k], acc[ai][bj][m][n], 0, 0, 0); __builtin_amdgcn_s_setprio(0); } while (0)
#define PG8_WAIT_V(n) asm volatile("s_waitcnt vmcnt(" #n ")" ::: "memory")
#define PG8_WAIT_L(n) asm volatile("s_waitcnt lgkmcnt(" #n ")" ::: "memory")
#define PG8_BAR __builtin_amdgcn_s_barrier()
#define PG8_SCHED __builtin_amdgcn_sched_barrier(0)
    Unit cur, nxt; int ui = 0;
    if (!S.next(0, cur)) return;
    f32x4 acc[2][2][4][2];
#pragma unroll
    for (int a = 0; a < 2; ++a)
#pragma unroll
        for (int b = 0; b < 2; ++b)
#pragma unroll
            for (int m = 0; m < 4; ++m)
#pragma unroll
                for (int n = 0; n < 2; ++n) acc[a][b][m][n] = (f32x4){0.f, 0.f, 0.f, 0.f};
    bf16x8 At[4][2], B0[2][2], B1[2][2];
    const char* cA = (const char*)g.A + (size_t)cur.pm * tstepA; const char* cB = (const char*)g.Bt + (size_t)cur.pn * tstepB;
    S.a_ready(cur);
    if constexpr (SP2) {
        PG8_STAGE(PG8_SB(0, 0), cB, voffB); PG8_STAGE(PG8_SB(0, 1), cB + hstepB, voffB); PG8_STAGE(PG8_SA(0, 0), cA, voffA); PG8_STAGE(PG8_SA(0, 1), cA + hstepA, voffA);
        if (wr == 1) PG8_BAR;
        PG8_WAIT_V(2); PG8_BAR;
        PG8_STAGE(PG8_SB(1, 0), cB + kstep, voffB); PG8_STAGE(PG8_SA(1, 0), cA + kstep, voffA); PG8_STAGE(PG8_SB(1, 1), cB + hstepB + kstep, voffB);
        PG8_WAIT_V(6); PG8_BAR;
    } else {
        PG8_STAGE(PG8_SB(0, 0), cB, voffB); PG8_STAGE(PG8_SA(0, 0), cA, voffA); PG8_STAGE(PG8_SB(0, 1), cB + hstepB, voffB); PG8_STAGE(PG8_SA(0, 1), cA + hstepA, voffA);
        if (wr == 1) PG8_BAR;
        PG8_WAIT_V(4); PG8_BAR;
        PG8_STAGE(PG8_SB(1, 0), cB + kstep, voffB); PG8_STAGE(PG8_SA(1, 0), cA + kstep, voffA); PG8_STAGE(PG8_SB(1, 1), cB + hstepB + kstep, voffB);
        PG8_WAIT_V(6); PG8_BAR;
    }
    for (;;) {
        const bool has_next = S.next(ui + 1, nxt);
        const char* nA = has_next ? (const char*)g.A + (size_t)nxt.pm * tstepA : cA; const char* nB = has_next ? (const char*)g.Bt + (size_t)nxt.pn * tstepB : cB;
        for (int t = 0; t < nt; t += 2) {
            const bool last = (t == nt - 2);
            const char* a1 = cA + (size_t)(t + 1) * kstep;
            const char* a2 = last ? nA : cA + (size_t)(t + 2) * kstep; const char* b2 = last ? nB : cB + (size_t)(t + 2) * kstep;
            const char* a3 = a2 + kstep; const char* b3 = b2 + kstep;
            if (last && has_next) S.a_ready(nxt);
            if constexpr (SP2) {
            PG8_LDB(B0, 0, 0); PG8_LDB(B1, 0, 1); PG8_SCHED; PG8_LDA(At, 0, 0); PG8_STAGE(PG8_SA(1, 1), a1 + hstepA, voffA);
            PG8_WAIT_V(8); PG8_WAIT_L(0); PG8_BAR; PG8_MMA(0, 0, At, B0); PG8_MMA(0, 1, At, B1); PG8_BAR; PG8_SCHED;
            PG8_LDA(At, 0, 1); PG8_STAGE(PG8_SB(0, 0), b2, voffB); PG8_STAGE(PG8_SB(0, 1), b2 + hstepB, voffB); PG8_STAGE(PG8_SA(0, 0), a2, voffA);
            PG8_WAIT_V(8); PG8_WAIT_L(0); PG8_BAR; PG8_MMA(1, 0, At, B0); PG8_MMA(1, 1, At, B1); PG8_BAR; PG8_SCHED;
            PG8_LDB(B0, 1, 0); PG8_LDB(B1, 1, 1); PG8_SCHED; PG8_LDA(At, 1, 0); PG8_STAGE(PG8_SA(0, 1), a2 + hstepA, voffA);
            PG8_WAIT_V(8); PG8_WAIT_L(0); PG8_BAR; PG8_MMA(0, 0, At, B0); PG8_MMA(0, 1, At, B1); PG8_BAR; PG8_SCHED;
            PG8_LDA(At, 1, 1); PG8_STAGE(PG8_SB(1, 0), b3, voffB); PG8_STAGE(PG8_SB(1, 1), b3 + hstepB, voffB); PG8_STAGE(PG8_SA(1, 0), a3, voffA);
            PG8_WAIT_V(8); PG8_WAIT_L(0); PG8_BAR; PG8_MMA(1, 0, At, B0); PG8_MMA(1, 1, At, B1); PG8_BAR; PG8_SCHED;
            } else {
            PG8_LDB(B0, 0, 0); PG8_SCHED; PG8_LDA(At, 0, 0); PG8_STAGE(PG8_SA(1, 1), a1 + hstepA, voffA);
            PG8_WAIT_L(8); PG8_BAR; PG8_WAIT_L(0); PG8_MMA(0, 0, At, B0); PG8_BAR; PG8_SCHED;
            PG8_LDB(B1, 0, 1); PG8_STAGE(PG8_SB(0, 0), b2, voffB);
            PG8_BAR; PG8_WAIT_L(0); PG8_MMA(0, 1, At, B1); PG8_BAR;
            PG8_LDA(At, 0, 1); PG8_STAGE(PG8_SA(0, 0), a2, voffA);
            PG8_BAR; PG8_WAIT_L(0); PG8_MMA(1, 0, At, B0); PG8_BAR; PG8_SCHED;
            PG8_STAGE(PG8_SB(0, 1), b2 + hstepB, voffB);
            PG8_WAIT_V(6); PG8_BAR; PG8_MMA(1, 1, At, B1); PG8_BAR;
            PG8_LDB(B0, 1, 0); PG8_SCHED; PG8_LDA(At, 1, 0); PG8_STAGE(PG8_SA(0, 1), a2 + hstepA, voffA);
            PG8_WAIT_L(8); PG8_BAR; PG8_WAIT_L(0); PG8_MMA(0, 0, At, B0); PG8_BAR; PG8_SCHED;
            PG8_LDB(B1, 1, 1); PG8_STAGE(PG8_SB(1, 0), b3, voffB);
            PG8_BAR; PG8_WAIT_L(0); PG8_MMA(0, 1, At, B1); PG8_BAR;
            PG8_LDA(At, 1, 1); PG8_STAGE(PG8_SA(1, 0), a3, voffA);
            PG8_BAR; PG8_WAIT_L(0); PG8_MMA(1, 0, At, B0); PG8_BAR; PG8_SCHED;
            PG8_STAGE(PG8_SB(1, 1), b3 + hstepB, voffB);
            PG8_WAIT_V(6); PG8_BAR; PG8_MMA(1, 1, At, B1); PG8_BAR;
            }
        }
        if constexpr (ALIGN_EPI) { if (wr == 0) PG8_BAR; }
        if constexpr (!Epi::AFTER_DRAIN) { E(acc, cur, wr, wc, fr, fq); S.done(cur); }
        if (!has_next) break;
#pragma unroll
        for (int a = 0; a < 2; ++a)
#pragma unroll
            for (int b = 0; b < 2; ++b)
#pragma unroll
                for (int m = 0; m < 4; ++m)
#pragma unroll
                    for (int n = 0; n < 2; ++n) acc[a][b][m][n] = (f32x4){0.f, 0.f, 0.f, 0.f};
        cur = nxt; cA = nA; cB = nB; ++ui;
        if constexpr (ALIGN_EPI) { if (wr == 1) PG8_BAR; }
    }
    PG8_WAIT_V(0);
    if constexpr (!ALIGN_EPI) { if (wr == 0) PG8_BAR; }
    PG8_BAR;
#undef PG8_SA
#undef PG8_SB
#undef PG8_STAGE
#undef PG8_LDA
#undef PG8_LDB
#undef PG8_MMA
#undef PG8_WAIT_V
#undef PG8_WAIT_L
#undef PG8_BAR
#undef PG8_SCHED
}
}

constexpr int NWAVES = 8;
constexpr int N_LAUNCHES = MK_N_LAUNCHES;
constexpr int NPH = 26;
constexpr int M = 16384, D = 1024, T = 4096, FF = 4096, NIN = 3072, APROJ = 3088, KD = 512;
constexpr float EPS = 1e-6f, LOG2E = 1.4426950408889634f;

constexpr size_t MiB = 1u << 20;
constexpr size_t WS_CTL = 0, CTL_ZERO_BYTES = 1 * MiB;
constexpr size_t WS_SSQ = 1 * MiB;
constexpr size_t WS_WG = 2 * MiB;
constexpr size_t WS_BEND = 2 * MiB + 65536;
constexpr size_t WS_WIN = 3 * MiB;
constexpr size_t WS_KV = 3 * MiB;
constexpr size_t WS_WAO = 15 * MiB;
constexpr size_t WS_WUP = 19 * MiB;
constexpr size_t WS_WDN = 51 * MiB;
constexpr size_t WS_WQ = 83 * MiB;
constexpr size_t WS_WQ1 = WS_WQ + (size_t)1280 * 1024 * 2;
constexpr size_t WS_WBO = 88 * MiB;
constexpr size_t WS_HB = 92 * MiB;
constexpr size_t WS_U = 124 * MiB;
constexpr size_t WS_BCUM = WS_U + 96 * MiB;
constexpr size_t WS_END = 252 * MiB;
constexpr int CW_BAR = 4096;

constexpr int LDS_BYTES = 147456;
constexpr int RING_BYTES = 131072, LDSCTL_OFF = 143360, MISC_OFF = LDSCTL_OFF + 320;

#define GAS __attribute__((address_space(1)))
#define LAS __attribute__((address_space(3)))
typedef unsigned short bf16;
typedef unsigned v4u __attribute__((ext_vector_type(4)));
typedef unsigned v2u __attribute__((ext_vector_type(2)));
typedef float f32x4 __attribute__((ext_vector_type(4)));
typedef GAS unsigned gu32;
typedef short bf16x8 __attribute__((ext_vector_type(8)));
typedef short s16x4 __attribute__((ext_vector_type(4)));
__device__ __forceinline__ s16x4 tr_read(const LAS unsigned char* p) { return __builtin_bit_cast(s16x4, __builtin_amdgcn_ds_read_tr16_b64_v4i16((LAS s16x4*)p)); }
#define RLX_AGENT __ATOMIC_RELAXED, __HIP_MEMORY_SCOPE_AGENT
#define LDS_WAIT() asm volatile("s_waitcnt lgkmcnt(0)" ::: "memory")
#define VM_WAIT() asm volatile("s_waitcnt vmcnt(0)" ::: "memory")
__device__ __forceinline__ unsigned f2bf(float f) { unsigned u = __builtin_bit_cast(unsigned, f); return (u + 0x7fffu + ((u >> 16) & 1u)) >> 16; }
__device__ __forceinline__ unsigned pk2(float lo, float hi) { return f2bf(lo) | (f2bf(hi) << 16); }
__device__ __forceinline__ float bf2f(unsigned short b) { return __builtin_bit_cast(float, (unsigned)b << 16); }
__device__ __forceinline__ float bflo(unsigned w) { return __builtin_bit_cast(float, w << 16); }
__device__ __forceinline__ float bfhi(unsigned w) { return __builtin_bit_cast(float, w & 0xffff0000u); }

#define XB_TMO      128
#define XB_XCNT(j)  (256  + 64 * (j))
#define XB_XSUB(j)  (1280 + 64 * (j))
#define XB_XGEN(j)  (2304 + 64 * (j))
#define XB_TOP      3328
#define XB_TOPGEN   3392
#define XCD_BAR_WORDS 3456
#define XB_SPIN_CAP (1u << 18)
__device__ __forceinline__ unsigned xb_ld(unsigned* p)              { return __hip_atomic_load(p, __ATOMIC_RELAXED, __HIP_MEMORY_SCOPE_AGENT); }
__device__ __forceinline__ unsigned xb_add(unsigned* p, unsigned v) { return __hip_atomic_fetch_add(p, v, __ATOMIC_RELAXED, __HIP_MEMORY_SCOPE_AGENT); }
__device__ __forceinline__ unsigned xb_xcc_id() { return (unsigned)__builtin_amdgcn_s_getreg((3 << 11) | 20) & 0xFu; }
#define XB_SPIN(cond, bar) do { unsigned _sp = 0; while (cond) { __builtin_amdgcn_s_sleep(1); \
    if ((++_sp & 255u) == 0u) { if (xb_ld(&(bar)[XB_TMO])) break; if (_sp > XB_SPIN_CAP) { atomicAdd(&(bar)[XB_TMO], 1u); break; } } } } while (0)
struct XcdBarrier { unsigned* bar; unsigned x; volatile LAS unsigned* st; };
__device__ __forceinline__ XcdBarrier xcd_barrier_post(unsigned* bar, volatile LAS unsigned* st) {
    XcdBarrier b; b.bar = bar; b.x = xb_xcc_id(); b.st = st;
    if (threadIdx.x == 0) (void)xb_add(&bar[XB_XCNT(b.x)], 1u);
    return b;
}
__device__ __forceinline__ void xcd_barrier_complete(unsigned* bar, unsigned x, unsigned& nloc, unsigned& nx) {
    const unsigned G = gridDim.x * gridDim.y * gridDim.z;
    unsigned sum, cnt, mine, sp = 0u;
    for (;;) {
        sum = 0u; cnt = 0u; mine = 0u;
#pragma unroll
        for (unsigned j = 0; j < 16; ++j) { const unsigned c = xb_ld(&bar[XB_XCNT(j)]); sum += c; cnt += (c > 0u) ? 1u : 0u; mine = (j == x) ? c : mine; }
        if (sum == G) break;
        __builtin_amdgcn_s_sleep(1);
        if ((++sp & 255u) == 0u) { if (xb_ld(&bar[XB_TMO])) break; if (sp > XB_SPIN_CAP) { atomicAdd(&bar[XB_TMO], 1u); break; } }
    }
    nloc = mine > 0u ? mine : 1u; nx = cnt > 0u ? cnt : 1u;
}
__device__ __forceinline__ void xcd_barrier(const XcdBarrier& b) {
    asm volatile("s_waitcnt vmcnt(0)" ::: "memory");
    __syncthreads();
    if (threadIdx.x == 0) {
        unsigned* bar = b.bar;
        __builtin_amdgcn_s_waitcnt(0);
        unsigned nloc = b.st[0], nx = b.st[1];
        if (nloc == 0u) { xcd_barrier_complete(bar, b.x, nloc, nx); b.st[0] = nloc; b.st[1] = nx; }
        const unsigned old = xb_add(&bar[XB_XSUB(b.x)], 1u);
        const unsigned gen = old / nloc;
        if (old + 1u == (gen + 1u) * nloc) {
            __builtin_amdgcn_fence(__ATOMIC_RELEASE, "agent");
            asm volatile("s_waitcnt vmcnt(0)" ::: "memory");
            const unsigned og = xb_add(&bar[XB_TOP], 1u);
            const unsigned tg = og / nx;
            if (og + 1u == (tg + 1u) * nx) xb_add(&bar[XB_TOPGEN], 1u);
            else XB_SPIN(xb_ld(&bar[XB_TOPGEN]) == tg, bar);
            __builtin_amdgcn_fence(__ATOMIC_ACQUIRE, "agent");
            xb_add(&bar[XB_XGEN(b.x)], 1u);
            asm volatile("s_waitcnt vmcnt(0)" ::: "memory");
        } else {
            XB_SPIN(xb_ld(&bar[XB_XGEN(b.x)]) == gen, bar);
            __builtin_amdgcn_fence(__ATOMIC_ACQUIRE, "agent");
            asm volatile("s_waitcnt vmcnt(0)" ::: "memory");
        }
    }
    __syncthreads();
}

__device__ __forceinline__ float wave_sum(float v) {
#pragma unroll
    for (int o = 1; o < 64; o <<= 1) v += __shfl_xor(v, o);
    return v;
}

__device__ __forceinline__ void p0_transpose_item(const float* W, int ldw, int K, int nblk, bf16* WT, const float* gain, float scale, int nscale, LAS float* scr, int item, int lane) {
    const int kb = item / nblk, nb = item % nblk, k0 = 64 * kb, n0 = 32 * nb;
    const float sc = (n0 + (lane & 31)) < nscale ? scale : 1.0f;
#pragma unroll 8
    for (int i = 0; i < 32; ++i) { const int kk = 2 * i + (lane >> 5); const float g = gain ? gain[k0 + kk] : 1.0f; scr[kk * 33 + (lane & 31)] = W[(size_t)(k0 + kk) * ldw + n0 + (lane & 31)] * (g * sc); }
    LDS_WAIT(); asm volatile("" ::: "memory");
    const int c = lane & 7;
#pragma unroll
    for (int j = 0; j < 4; ++j) { const int n = (lane >> 3) + 8 * j; const LAS float* s = scr + (8 * c) * 33 + n;
        v4u o; o.x = pk2(s[0 * 33], s[1 * 33]); o.y = pk2(s[2 * 33], s[3 * 33]); o.z = pk2(s[4 * 33], s[5 * 33]); o.w = pk2(s[6 * 33], s[7 * 33]);
        *(GAS v4u*)(WT + (size_t)(n0 + n) * K + k0 + 8 * c) = o; }
    LDS_WAIT(); asm volatile("" ::: "memory");
}

struct Args { const float* in[17]; float* out; unsigned char* ws; int ph_lo, ph_hi, li, pad; };

__device__ __forceinline__ float logsigmoidf(float z) { return fminf(z, 0.f) - log1pf(__expf(-fabsf(z))); }

__global__ void __launch_bounds__(NWAVES * 64, 2) yoco_fwd(Args args) {
    extern __shared__ __attribute__((aligned(16))) unsigned char lds[];
    LAS unsigned char* ldsl = (LAS unsigned char*)lds;
    volatile LAS unsigned* MISC = (volatile LAS unsigned*)(ldsl + MISC_OFF);
    const int tid0 = threadIdx.x, lane0 = tid0 & 63, wave0 = __builtin_amdgcn_readfirstlane(tid0 >> 6);
#define PHASE_IDS int tid = threadIdx.x; asm volatile("" : "+v"(tid)); const int lane = tid & 63, wave = __builtin_amdgcn_readfirstlane(tid >> 6); (void)lane; (void)wave;
    const int G = gridDim.x; const int bx = blockIdx.x; const int vcu = (G % 8 == 0) ? (bx % 8) * (G / 8) + bx / 8 : bx;
    unsigned char* ws = args.ws;
    gu32* ctl = (gu32*)(ws + WS_CTL);
    const float* x = args.in[0]; const float* a_w_in = args.in[1]; const float* a_w_gk2 = args.in[2]; const float* a_b_gk = args.in[3]; const float* a_onorm = args.in[4];
    const float* a_w_out = args.in[5]; const float* kv_norm = args.in[6]; const float* w_kv = args.in[7]; const float* b_w_q = args.in[8]; const float* b_sinks = args.in[9];
    const float* b_w_out = args.in[10]; const float* rel_table = args.in[11]; const float* ln_mix = args.in[12]; const float* ln_mlp = args.in[13];
    const float* w_up = args.in[14]; const float* w_down = args.in[15]; const float* ln_final = args.in[16];
    float* out = args.out;
    float* ssq = (float*)(ws + WS_SSQ);
    bf16* Wg_t = (bf16*)(ws + WS_WG); float* BendG = (float*)(ws + WS_BEND);
    bf16* Win_t = (bf16*)(ws + WS_WIN); bf16* KVb = (bf16*)(ws + WS_KV); bf16* Wao_t = (bf16*)(ws + WS_WAO); bf16* Wup_t = (bf16*)(ws + WS_WUP); bf16* Wdn_t = (bf16*)(ws + WS_WDN);
    bf16* Wq0_t = (bf16*)(ws + WS_WQ); bf16* Wq1_t = (bf16*)(ws + WS_WQ1); bf16* Wbo_t = (bf16*)(ws + WS_WBO);
    bf16* HB = (bf16*)(ws + WS_HB); bf16* Sst = (bf16*)(ws + WS_HB);
    bf16* U = (bf16*)(ws + WS_U); bf16* QKVG = (bf16*)(ws + WS_U); bf16* Qb = (bf16*)(ws + WS_U); float* BCUM = (float*)(ws + WS_BCUM);

    for (int u = tid0; u < (LDS_BYTES - LDSCTL_OFF) / 4; u += NWAVES * 64) ((LAS unsigned*)(ldsl + LDSCTL_OFF))[u] = 0u;
    __syncthreads();
    XcdBarrier bar; bar.bar = (unsigned*)(ctl + CW_BAR) + args.li * XCD_BAR_WORDS; bar.x = 0; bar.st = nullptr;
    if (N_LAUNCHES != NPH) bar = xcd_barrier_post((unsigned*)(ctl + CW_BAR) + args.li * XCD_BAR_WORDS, MISC + 8);
#define GRID_BAR() do { if (N_LAUNCHES != NPH) xcd_barrier(bar); } while (0)
    const int lo = args.ph_lo, hi = args.ph_hi;
#define IN(k) (lo <= (k) && (k) < hi)
#define BOTH(k) (IN(k) && IN((k) + 1))

    if (IN(0)) { PHASE_IDS
        LAS float* scr = (LAS float*)(ldsl + wave * 16384);
        const int gw = vcu * NWAVES + wave, NGW = G * NWAVES;
        constexpr int I_IN = 16 * 96, I_SQ = 16 * 32, I_UP = 16 * 128, I_DN = 64 * 32, I_KV = 16 * 8;
        constexpr int NITEMS = 2 * I_IN + 2 * I_SQ + 4 * I_UP + 4 * I_DN + 2 * I_SQ + I_KV + 2 * I_SQ;
        for (int it = gw; it < NITEMS; it += NGW) {
            int r = it;
            if (r < 2 * I_IN) { const int l = r / I_IN; p0_transpose_item(a_w_in + (size_t)l * D * APROJ, APROJ, D, 96, Win_t + (size_t)l * NIN * D, ln_mix + l * D, 0.08838834764831845f, 512, scr, r % I_IN, lane); continue; } r -= 2 * I_IN;
            if (r < 2 * I_SQ) { const int l = r / I_SQ; p0_transpose_item(a_w_out + (size_t)l * D * D, D, D, 32, Wao_t + (size_t)l * D * D, nullptr, 1.f, 0, scr, r % I_SQ, lane); continue; } r -= 2 * I_SQ;
            if (r < 4 * I_UP) { const int l = r / I_UP; p0_transpose_item(w_up + (size_t)l * D * FF, FF, D, 128, Wup_t + (size_t)l * FF * D, ln_mlp + l * D, 1.f, 0, scr, r % I_UP, lane); continue; } r -= 4 * I_UP;
            if (r < 4 * I_DN) { const int l = r / I_DN; p0_transpose_item(w_down + (size_t)l * FF * D, D, FF, 32, Wdn_t + (size_t)l * D * FF, nullptr, 1.f, 0, scr, r % I_DN, lane); continue; } r -= 4 * I_DN;
            if (r < 2 * I_SQ) { const int j = r / I_SQ; p0_transpose_item(b_w_q + (size_t)j * D * D, D, D, 32, j == 0 ? Wq0_t : Wq1_t, ln_mix + (2 + j) * D, 0.125f * LOG2E, 1024, scr, r % I_SQ, lane); continue; } r -= 2 * I_SQ;
            if (r < I_KV) { p0_transpose_item(w_kv, 256, D, 8, Wq0_t + (size_t)1024 * D, kv_norm, 1.f, 0, scr, r, lane); continue; } r -= I_KV;
            { const int j = r / I_SQ; p0_transpose_item(b_w_out + (size_t)j * D * D, D, D, 32, Wbo_t + (size_t)j * D * D, nullptr, 1.f, 0, scr, r % I_SQ, lane); }
        }
        for (int e = vcu * 512 + tid; e < 2 * 16 * 1024; e += G * 512) { const int l = e >> 14, n = (e >> 10) & 15, k = e & 1023;
            Wg_t[e] = (bf16)f2bf(a_w_in[((size_t)l * D + k) * APROJ + NIN + n] * ln_mix[l * D + k]); }
        for (int m = gw; m < M; m += NGW) {
            const GAS f32x4* xr = (const GAS f32x4*)(x + (size_t)m * D) + lane; f32x4 v[4]; float s = 0.f;
#pragma unroll
            for (int j = 0; j < 4; ++j) { v[j] = xr[64 * j]; s += (v[j].x * v[j].x + v[j].y * v[j].y) + (v[j].z * v[j].z + v[j].w * v[j].w); }
            s = wave_sum(s);
            GAS unsigned long long* o8 = (GAS unsigned long long*)(HB + (size_t)m * D) + lane;
#pragma unroll
            for (int j = 0; j < 4; ++j) o8[64 * j] = (unsigned long long)pk2(v[j].x, v[j].y) | ((unsigned long long)pk2(v[j].z, v[j].w) << 32);
            if (lane < 16) ssq[(size_t)lane * M + m] = lane == 0 ? s : 0.f;
        }
        if (BOTH(0)) GRID_BAR();
    }

    for (int L = 0; L < 4; ++L) {
        const bool gla = L < 2; const int jb = L - 2;
        const int base = gla ? 1 + 7 * L : 15 + 5 * jb;
        const int pG1 = gla ? base + 4 : base + 2;
        if (IN(base)) { PHASE_IDS
            pg8::Gemm g; pg8::EpiScale E; E.ssq = ssq; E.act = 0;
            if (gla) { g = pg8::Gemm{HB, Win_t + (size_t)L * NIN * D, M, NIN, D, D}; E.O = QKVG; E.ldc = NIN; E.O2 = nullptr; E.ldc2 = 0; E.split_col = 1 << 30; }
            else if (jb == 0) { g = pg8::Gemm{HB, Wq0_t, M, 1280, D, D}; E.O = Qb; E.ldc = D; E.O2 = KVb; E.ldc2 = 256; E.split_col = 1024; }
            else { g = pg8::Gemm{HB, Wq1_t, M, 1024, D, D}; E.O = Qb; E.ldc = D; E.O2 = nullptr; E.ldc2 = 0; E.split_col = 1 << 30; }
            pg8::StaticOrder S; S.init(M, g.N, G, (int)blockIdx.x);
            pg8::gemm_phase<pg8::EpiScale, pg8::StaticOrder, true, true>(ldsl, g, S, E);
            if (gla) {
                float* glr_s = (float*)lds;
                const bf16* Wg = Wg_t + (size_t)L * 16 * 1024;
                for (int c = vcu; c < M / 64; c += G) {
                    __syncthreads();
                    { const int r = tid >> 3, part = tid & 7, row = c * 64 + r; const bf16* hr = HB + (size_t)row * D; const bf16* w0 = Wg + (size_t)(2 * part) * D; const bf16* w1 = w0 + D;
                      float a0 = 0.f, a1 = 0.f;
                      for (int k = 0; k < D; k += 8) { const v4u hv = *(const v4u*)(hr + k), u0 = *(const v4u*)(w0 + k), u1 = *(const v4u*)(w1 + k);
#pragma unroll
                          for (int e = 0; e < 4; ++e) { const float hl = bflo(hv[e]), hh = bfhi(hv[e]); a0 += hl * bflo(u0[e]) + hh * bfhi(u0[e]); a1 += hl * bflo(u1[e]) + hh * bfhi(u1[e]); } }
                      const float rs = pg8::row_rstd(ssq, row);
                      glr_s[r * 16 + 2 * part] = a0 * rs; glr_s[r * 16 + 2 * part + 1] = a1 * rs; }
                    __syncthreads();
                    { const int kd = tid; float w2[16];
#pragma unroll
                      for (int r = 0; r < 16; ++r) w2[r] = a_w_gk2[((size_t)L * 16 + r) * KD + kd];
                      const float bb = a_b_gk[L * KD + kd]; float run = 0.f;
                      for (int t = 0; t < 64; ++t) { float z = bb;
#pragma unroll
                          for (int r = 0; r < 16; ++r) z += glr_s[t * 16 + r] * w2[r];
                          run += logsigmoidf(z) * (1.0f / 16.0f); BCUM[(size_t)(c * 64 + t) * KD + kd] = run; } }
                }
                __syncthreads();
            }
            if (BOTH(base)) GRID_BAR();
        }
        if (gla) {
            if (IN(base + 1)) { PHASE_IDS
                constexpr int KD_OFF = 0, KD_RS = 288, V_OFF = 36864, V_RS = 544;
                const int g = lane >> 4, q4 = (lane & 15) >> 2, p4 = lane & 3, wk = wave >> 2, wv = wave & 3;
                for (int un = vcu; un < 512; un += G) {
                    const int seq = un >> 5, sc = un & 31, b = seq >> 2, h = seq & 3; const size_t t0 = (size_t)b * T + sc * 128;
                    __syncthreads();
                    { const int k8 = (tid & 15) * 8; const float* l0p = BCUM + (t0 + 63) * KD + h * 128 + k8; const float* l1p = BCUM + (t0 + 127) * KD + h * 128 + k8;
                      const f32x4 l0a = *(const f32x4*)l0p, l0b = *(const f32x4*)(l0p + 4), l1a = *(const f32x4*)l1p, l1b = *(const f32x4*)(l1p + 4);
                      float last0[8], bend[8];
#pragma unroll
                      for (int e = 0; e < 4; ++e) { last0[e] = l0a[e]; last0[4 + e] = l0b[e]; bend[e] = l0a[e] + l1a[e]; bend[4 + e] = l0b[e] + l1b[e]; }
                      if (tid < 16) {
#pragma unroll
                          for (int e = 0; e < 8; ++e) BendG[(size_t)un * 128 + k8 + e] = bend[e]; }
#pragma unroll
                      for (int i = 0; i < 4; ++i) { const int t = (tid >> 4) + 32 * i; const size_t tok = t0 + t;
                          const v4u kv = *(const v4u*)(QKVG + tok * NIN + 512 + h * 128 + k8);
                          const f32x4 b0 = *(const f32x4*)(BCUM + tok * KD + h * 128 + k8), b1 = *(const f32x4*)(BCUM + tok * KD + h * 128 + k8 + 4);
                          float r[8];
#pragma unroll
                          for (int e = 0; e < 8; ++e) { const float kk = (e & 1) ? bfhi(kv[e >> 1]) : bflo(kv[e >> 1]); const float bc = (e < 4 ? b0[e] : b1[e - 4]) + (t >= 64 ? last0[e] : 0.f); r[e] = kk * __expf(bend[e] - bc); }
                          v4u o; o.x = pk2(r[0], r[1]); o.y = pk2(r[2], r[3]); o.z = pk2(r[4], r[5]); o.w = pk2(r[6], r[7]);
                          *(LAS v4u*)(ldsl + KD_OFF + t * KD_RS + k8 * 2) = o; }
#pragma unroll
                      for (int i = 0; i < 8; ++i) { const int c = tid + 512 * i, t = c >> 5, v8 = (c & 31) * 8;
                          const v4u vv = *(const v4u*)(QKVG + (t0 + t) * NIN + 1024 + h * 256 + v8);
                          *(LAS v4u*)(ldsl + V_OFF + t * V_RS + v8 * 2) = vv; } }
                    __syncthreads();
                    f32x4 acc[4][4];
#pragma unroll
                    for (int a = 0; a < 4; ++a)
#pragma unroll
                        for (int c = 0; c < 4; ++c) acc[a][c] = (f32x4){0.f, 0.f, 0.f, 0.f};
#pragma unroll
                    for (int s = 0; s < 4; ++s) { const int rowb = 32 * s + 4 * g + q4;
                        bf16x8 af[4], bfr[4];
#pragma unroll
                        for (int kt = 0; kt < 4; ++kt) { const LAS unsigned char* ap = ldsl + KD_OFF + rowb * KD_RS + (64 * wk + 16 * kt + 4 * p4) * 2; const s16x4 lo = tr_read(ap), hi = tr_read(ap + 16 * KD_RS);
                            af[kt] = (bf16x8){lo[0], lo[1], lo[2], lo[3], hi[0], hi[1], hi[2], hi[3]}; }
#pragma unroll
                        for (int vt = 0; vt < 4; ++vt) { const LAS unsigned char* bp = ldsl + V_OFF + rowb * V_RS + (64 * wv + 16 * vt + 4 * p4) * 2; const s16x4 lo = tr_read(bp), hi = tr_read(bp + 16 * V_RS);
                            bfr[vt] = (bf16x8){lo[0], lo[1], lo[2], lo[3], hi[0], hi[1], hi[2], hi[3]}; }
#pragma unroll
                        for (int kt = 0; kt < 4; ++kt)
#pragma unroll
                            for (int vt = 0; vt < 4; ++vt) acc[kt][vt] = __builtin_amdgcn_mfma_f32_16x16x32_bf16(af[kt], bfr[vt], acc[kt][vt], 0, 0, 0); }
#pragma unroll
                    for (int kt = 0; kt < 4; ++kt)
#pragma unroll
                        for (int vt = 0; vt < 4; ++vt) { const int vd = 64 * wv + 16 * vt + (lane & 15), kd = 64 * wk + 16 * kt + 4 * g;
                            v2u w; w.x = pk2(acc[kt][vt][0], acc[kt][vt][1]); w.y = pk2(acc[kt][vt][2], acc[kt][vt][3]);
                            *(v2u*)(Sst + ((size_t)un * 256 + vd) * 128 + kd) = w; }
                }
                if (BOTH(base + 1)) GRID_BAR();
            }
            if (IN(base + 2)) { PHASE_IDS
                for (int w = vcu * 512 + tid; w < 16 * 8192; w += G * 512) { const int seq = w >> 13, e4 = (w & 8191) * 4, kd = e4 & 127; float run[4] = {0.f, 0.f, 0.f, 0.f};
                    for (int sc = 0; sc < 32; ++sc) { const int un = seq * 32 + sc; bf16* p = Sst + (size_t)un * 32768 + e4; const v2u tv = *(const v2u*)p;
                        const f32x4 be = *(const f32x4*)(BendG + (size_t)un * 128 + kd);
                        v2u o; o.x = pk2(run[0], run[1]); o.y = pk2(run[2], run[3]); *(v2u*)p = o;
                        run[0] = run[0] * __expf(be[0]) + bflo(tv.x); run[1] = run[1] * __expf(be[1]) + bfhi(tv.x); run[2] = run[2] * __expf(be[2]) + bflo(tv.y); run[3] = run[3] * __expf(be[3]) + bfhi(tv.y); } }
                if (BOTH(base + 2)) GRID_BAR();
            }
            if (IN(base + 3)) { PHASE_IDS
                constexpr int A_OFF = 0, A_RS = 288, B_OFF = 73728, B_RS = 544;
                const int g = lane >> 4, l15 = lane & 15, q4 = l15 >> 2, p4 = lane & 3;
                const int grp = wave < 4 ? wave : 11 - wave;
                for (int un = vcu; un < 512; un += G) {
                    const int seq = un >> 5, sc = un & 31, b = seq >> 2, h = seq & 3; const size_t t0 = (size_t)b * T + sc * 128;
                    __syncthreads();
#pragma unroll
                    for (int i = 0; i < 8; ++i) { const int c = tid + 512 * i, vd = c >> 4, k8 = (c & 15) * 8;
                        const v4u sv = *(const v4u*)(Sst + ((size_t)un * 256 + vd) * 128 + k8);
                        *(LAS v4u*)(ldsl + A_OFF + vd * A_RS + k8 * 2) = sv; }
#pragma unroll
                    for (int i = 0; i < 8; ++i) { const int c = tid + 512 * i, t = c >> 5, v8 = (c & 31) * 8;
                        const v4u vv = *(const v4u*)(QKVG + (t0 + t) * NIN + 1024 + h * 256 + v8);
                        *(LAS v4u*)(ldsl + B_OFF + t * B_RS + v8 * 2) = vv; }
                    bf16x8 qf[4];
                    { const int q = 16 * grp + l15; const size_t tok = t0 + q;
#pragma unroll
                      for (int ks = 0; ks < 4; ++ks) { const int kdb = 32 * ks + 8 * g;
                          const v4u qv = *(const v4u*)(QKVG + tok * NIN + h * 128 + kdb);
                          f32x4 b0 = *(const f32x4*)(BCUM + tok * KD + h * 128 + kdb), b1 = *(const f32x4*)(BCUM + tok * KD + h * 128 + kdb + 4);
                          if (q >= 64) { const float* lp = BCUM + (t0 + 63) * KD + h * 128 + kdb; b0 = b0 + *(const f32x4*)lp; b1 = b1 + *(const f32x4*)(lp + 4); }
                          float r[8];
#pragma unroll
                          for (int e = 0; e < 8; ++e) { const float qq = (e & 1) ? bfhi(qv[e >> 1]) : bflo(qv[e >> 1]); r[e] = qq * __expf(e < 4 ? b0[e] : b1[e - 4]); }
                          v4u o; o.x = pk2(r[0], r[1]); o.y = pk2(r[2], r[3]); o.z = pk2(r[4], r[5]); o.w = pk2(r[6], r[7]);
                          qf[ks] = __builtin_bit_cast(bf16x8, o); } }
                    __syncthreads();
                    f32x4 acc[16];
#pragma unroll
                    for (int vt = 0; vt < 16; ++vt) acc[vt] = (f32x4){0.f, 0.f, 0.f, 0.f};
#pragma unroll
                    for (int vt = 0; vt < 16; ++vt)
#pragma unroll
                        for (int ks = 0; ks < 4; ++ks) { const bf16x8 a = *(const LAS bf16x8*)(ldsl + A_OFF + (16 * vt + l15) * A_RS + (32 * ks + 8 * g) * 2);
                            acc[vt] = __builtin_amdgcn_mfma_f32_16x16x32_bf16(a, qf[ks], acc[vt], 0, 0, 0); }
                    __syncthreads();
                    { const int k8 = (tid & 15) * 8; const float* l0p = BCUM + (t0 + 63) * KD + h * 128 + k8; const f32x4 l0a = *(const f32x4*)l0p, l0b = *(const f32x4*)(l0p + 4);
#pragma unroll
                      for (int i = 0; i < 4; ++i) { const int t = (tid >> 4) + 32 * i; const size_t tok = t0 + t;
                          const v4u kv = *(const v4u*)(QKVG + tok * NIN + 512 + h * 128 + k8);
                          const f32x4 b0 = *(const f32x4*)(BCUM + tok * KD + h * 128 + k8), b1 = *(const f32x4*)(BCUM + tok * KD + h * 128 + k8 + 4);
                          float r[8];
#pragma unroll
                          for (int e = 0; e < 8; ++e) { const float kk = (e & 1) ? bfhi(kv[e >> 1]) : bflo(kv[e >> 1]); const float bc = (e < 4 ? b0[e] : b1[e - 4]) + (t >= 64 ? (e < 4 ? l0a[e] : l0b[e - 4]) : 0.f); r[e] = kk * __expf(-bc); }
                          v4u o; o.x = pk2(r[0], r[1]); o.y = pk2(r[2], r[3]); o.z = pk2(r[4], r[5]); o.w = pk2(r[6], r[7]);
                          *(LAS v4u*)(ldsl + A_OFF + t * A_RS + k8 * 2) = o; } }
                    __syncthreads();
                    const int nsteps = (grp >> 1) + 1;
                    for (int s = 0; s < nsteps; ++s) {
                        f32x4 pt[2];
#pragma unroll
                        for (int tt = 0; tt < 2; ++tt) { pt[tt] = (f32x4){0.f, 0.f, 0.f, 0.f};
#pragma unroll
                            for (int ks = 0; ks < 4; ++ks) { const bf16x8 a = *(const LAS bf16x8*)(ldsl + A_OFF + (32 * s + 16 * tt + l15) * A_RS + (32 * ks + 8 * g) * 2);
                                pt[tt] = __builtin_amdgcn_mfma_f32_16x16x32_bf16(a, qf[ks], pt[tt], 0, 0, 0); }
#pragma unroll
                            for (int r = 0; r < 4; ++r) { const int j = 32 * s + 16 * tt + 4 * g + r; if (j > 16 * grp + l15) pt[tt][r] = 0.f; } }
                        v4u pw; pw.x = pk2(pt[0][0], pt[0][1]); pw.y = pk2(pt[0][2], pt[0][3]); pw.z = pk2(pt[1][0], pt[1][1]); pw.w = pk2(pt[1][2], pt[1][3]);
                        const bf16x8 pf = __builtin_bit_cast(bf16x8, pw);
#pragma unroll
                        for (int vt = 0; vt < 16; ++vt) { const LAS unsigned char* vp = ldsl + B_OFF + (32 * s + 4 * g + q4) * B_RS + (16 * vt + 4 * p4) * 2; const s16x4 lo = tr_read(vp), hi = tr_read(vp + 16 * B_RS);
                            const bf16x8 a = (bf16x8){lo[0], lo[1], lo[2], lo[3], hi[0], hi[1], hi[2], hi[3]};
                            acc[vt] = __builtin_amdgcn_mfma_f32_16x16x32_bf16(a, pf, acc[vt], 0, 0, 0); }
                    }
                    { float ss = 0.f;
#pragma unroll
                      for (int vt = 0; vt < 16; ++vt) ss += (acc[vt][0] * acc[vt][0] + acc[vt][1] * acc[vt][1]) + (acc[vt][2] * acc[vt][2] + acc[vt][3] * acc[vt][3]);
                      ss += __shfl_xor(ss, 16); ss += __shfl_xor(ss, 32);
                      const float rs = 1.0f / sqrtf(ss * (1.0f / 256.0f) + EPS);
                      bf16* gp = QKVG + (t0 + 16 * grp + l15) * NIN + 2048 + h * 256 + 4 * g;
#pragma unroll
                      for (int vt = 0; vt < 16; ++vt) { const v2u gv = *(const v2u*)(gp + 16 * vt); const f32x4 gon = *(const f32x4*)(a_onorm + L * 256 + 16 * vt + 4 * g);
                          const float g0 = bflo(gv.x), g1 = bfhi(gv.x), g2 = bflo(gv.y), g3 = bfhi(gv.y);
                          const float r0 = acc[vt][0] * rs * gon[0] * (g0 / (1.0f + __expf(-g0))), r1 = acc[vt][1] * rs * gon[1] * (g1 / (1.0f + __expf(-g1)));
                          const float r2 = acc[vt][2] * rs * gon[2] * (g2 / (1.0f + __expf(-g2))), r3 = acc[vt][3] * rs * gon[3] * (g3 / (1.0f + __expf(-g3)));
                          v2u w; w.x = pk2(r0, r1); w.y = pk2(r2, r3); *(v2u*)(gp + 16 * vt) = w; } }
                }
                if (BOTH(base + 3)) GRID_BAR();
            }
        } else {
            if (IN(base + 1)) { PHASE_IDS
                constexpr int K_OFF = 0, V_OFF = 40960, RS = 160, BIAS_OFF = 81920;
                const int g = lane >> 4, l15 = lane & 15, q4 = l15 >> 2, p4 = lane & 3;
                LAS float* bias_s = (LAS float*)(ldsl + BIAS_OFF);
                for (int un = vcu; un < 256; un += G) {
                    const int b = un >> 6, nb = (un >> 1) & 31, kvh = un & 1; const size_t tq0 = (size_t)b * T + nb * 128;
                    __syncthreads();
#pragma unroll
                    for (int i = 0; i < 4; ++i) { const int c = tid + 512 * i, j = c >> 3, d8 = (c & 7) * 8; v4u kv = (v4u){0u, 0u, 0u, 0u}, vv = (v4u){0u, 0u, 0u, 0u};
                        if (!(nb == 0 && j < 128)) { const size_t tok = tq0 - 128 + j; kv = *(const v4u*)(KVb + tok * 256 + kvh * 64 + d8); vv = *(const v4u*)(KVb + tok * 256 + 128 + kvh * 64 + d8); }
                        *(LAS v4u*)(ldsl + K_OFF + j * RS + d8 * 2) = kv; *(LAS v4u*)(ldsl + V_OFF + j * RS + d8 * 2) = vv; }
                    for (int e = tid; e < 1024; e += 512) { const int hg = e >> 7, dist = e & 127;
                        int bk = dist; if (dist >= 16) { bk = 16 + (dist >= 19) + (dist >= 21) + (dist >= 24) + (dist >= 27) + (dist >= 31) + (dist >= 35) + (dist >= 40) + (dist >= 46) + (dist >= 52) + (dist >= 59) + (dist >= 67) + (dist >= 77) + (dist >= 87) + (dist >= 99) + (dist >= 113); }
                        bias_s[e] = rel_table[bk * 16 + kvh * 8 + hg] * LOG2E; }
                    __syncthreads();
                    const int head = kvh * 8 + wave; const float sink2 = b_sinks[jb * 16 + head] * LOG2E;
                    for (int qg = 0; qg < 8; ++qg) {
                        const int qi = 16 * qg + l15; bf16* qp = Qb + (tq0 + qi) * D + head * 64;
                        const bf16x8 qf0 = *(const bf16x8*)(qp + 8 * g), qf1 = *(const bf16x8*)(qp + 32 + 8 * g);
                        const int ts0 = qg & ~1;
                        f32x4 sc[10];
#pragma unroll
                        for (int tt = 0; tt < 10; ++tt) { const LAS unsigned char* kp = ldsl + K_OFF + (16 * (ts0 + tt) + l15) * RS + (8 * g) * 2;
                            const bf16x8 a0 = *(const LAS bf16x8*)kp, a1 = *(const LAS bf16x8*)(kp + 64);
                            sc[tt] = __builtin_amdgcn_mfma_f32_16x16x32_bf16(a0, qf0, (f32x4){0.f, 0.f, 0.f, 0.f}, 0, 0, 0);
                            sc[tt] = __builtin_amdgcn_mfma_f32_16x16x32_bf16(a1, qf1, sc[tt], 0, 0, 0); }
                        float m = sink2;
#pragma unroll
                        for (int tt = 0; tt < 10; ++tt)
#pragma unroll
                            for (int r = 0; r < 4; ++r) { const int j = 16 * (ts0 + tt) + 4 * g + r, dist = qi + 128 - j; const bool valid = (dist >= 0) && (dist < 128) && !(nb == 0 && j < 128);
                                const float s = valid ? sc[tt][r] + bias_s[wave * 128 + (dist & 127)] : -1e30f; sc[tt][r] = s; m = fmaxf(m, s); }
                        m = fmaxf(m, __shfl_xor(m, 16)); m = fmaxf(m, __shfl_xor(m, 32));
                        float l = 0.f;
#pragma unroll
                        for (int tt = 0; tt < 10; ++tt)
#pragma unroll
                            for (int r = 0; r < 4; ++r) { const float pe = __builtin_amdgcn_exp2f(sc[tt][r] - m); sc[tt][r] = pe; l += pe; }
                        l += __shfl_xor(l, 16); l += __shfl_xor(l, 32); l += __builtin_amdgcn_exp2f(sink2 - m);
                        f32x4 o[4];
#pragma unroll
                        for (int dt = 0; dt < 4; ++dt) o[dt] = (f32x4){0.f, 0.f, 0.f, 0.f};
#pragma unroll
                        for (int s5 = 0; s5 < 5; ++s5) { v4u pw; pw.x = pk2(sc[2 * s5][0], sc[2 * s5][1]); pw.y = pk2(sc[2 * s5][2], sc[2 * s5][3]); pw.z = pk2(sc[2 * s5 + 1][0], sc[2 * s5 + 1][1]); pw.w = pk2(sc[2 * s5 + 1][2], sc[2 * s5 + 1][3]);
                            const bf16x8 pf = __builtin_bit_cast(bf16x8, pw);
#pragma unroll
                            for (int dt = 0; dt < 4; ++dt) { const LAS unsigned char* vp = ldsl + V_OFF + (16 * (ts0 + 2 * s5) + 4 * g + q4) * RS + (16 * dt + 4 * p4) * 2; const s16x4 lo = tr_read(vp), hi = tr_read(vp + 16 * RS);
                                const bf16x8 a = (bf16x8){lo[0], lo[1], lo[2], lo[3], hi[0], hi[1], hi[2], hi[3]};
                                o[dt] = __builtin_amdgcn_mfma_f32_16x16x32_bf16(a, pf, o[dt], 0, 0, 0); } }
                        const float il = 1.0f / l;
#pragma unroll
                        for (int dt = 0; dt < 4; ++dt) { v2u w; w.x = pk2(o[dt][0] * il, o[dt][1] * il); w.y = pk2(o[dt][2] * il, o[dt][3] * il); *(v2u*)(qp + 16 * dt + 4 * g) = w; }
                    }
                }
                if (BOTH(base + 1)) GRID_BAR();
            }
        }
        if (IN(pG1)) {
            pg8::Gemm g; pg8::EpiResid E; E.hin = (L == 0) ? x : out; E.hout = out; E.hb = HB; E.ssq = ssq;
            if (gla) g = pg8::Gemm{QKVG + 2048, Wao_t + (size_t)L * D * D, M, D, D, NIN};
            else g = pg8::Gemm{Qb, Wbo_t + (size_t)jb * D * D, M, D, D, D};
            pg8::StaticOrder S; S.init(M, D, G, (int)blockIdx.x);
            pg8::gemm_phase<pg8::EpiResid, pg8::StaticOrder, false, true>(ldsl, g, S, E);
            if (BOTH(pG1)) GRID_BAR();
        }
        if (IN(pG1 + 1)) {
            pg8::Gemm g{HB, Wup_t + (size_t)L * FF * D, M, FF, D, D};
            pg8::EpiScale E; E.O = U; E.ldc = FF; E.O2 = nullptr; E.ldc2 = 0; E.split_col = 1 << 30; E.ssq = ssq; E.act = 1;
            pg8::StaticOrder S; S.init(M, FF, G, (int)blockIdx.x);
            pg8::gemm_phase<pg8::EpiScale, pg8::StaticOrder, true, true>(ldsl, g, S, E);
            if (BOTH(pG1 + 1)) GRID_BAR();
        }
        if (IN(pG1 + 2)) {
            pg8::Gemm g{U, Wdn_t + (size_t)L * D * FF, M, D, FF, FF};
            pg8::EpiResid E; E.hin = out; E.hout = out; E.hb = HB; E.ssq = ssq;
            pg8::StaticOrder S; S.init(M, D, G, (int)blockIdx.x);
            pg8::gemm_phase<pg8::EpiResid, pg8::StaticOrder, false, true>(ldsl, g, S, E);
            if (BOTH(pG1 + 2)) GRID_BAR();
        }
    }
    if (IN(25)) { PHASE_IDS
        const int gw = vcu * NWAVES + wave, NGW = G * NWAVES;
        for (int m = gw; m < M; m += NGW) {
            const float rs = pg8::row_rstd(ssq, m);
            GAS f32x4* hr = (GAS f32x4*)(out + (size_t)m * D) + lane; const f32x4* gr = (const f32x4*)ln_final + lane;
#pragma unroll
            for (int j = 0; j < 4; ++j) { const f32x4 v = hr[64 * j], gg = gr[64 * j]; hr[64 * j] = v * rs * gg; }
        }
    }
#undef IN
#undef BOTH
#undef GRID_BAR
}

extern "C" void kernel_launch(void* const* d_in, const int* in_sizes, int n_in, void* d_out, int out_size, void* d_ws, size_t ws_size, hipStream_t stream) {
    static int grid = 0;
    if (grid == 0) {
        if (n_in != 17 || in_sizes[0] != M * D || out_size != M * D || ws_size < WS_END) { fprintf(stderr, "kernel_launch: unexpected shapes (n_in %d, in0 %d, out %d, ws %zu)\n", n_in, n_in > 0 ? in_sizes[0] : -1, out_size, ws_size); grid = -1; return; }
        int dev = 0, cus = 0;
        if (hipGetDevice(&dev) != hipSuccess || hipDeviceGetAttribute(&cus, hipDeviceAttributeMultiprocessorCount, dev) != hipSuccess) { grid = -1; return; }
        if (hipFuncSetAttribute((const void*)yoco_fwd, hipFuncAttributeMaxDynamicSharedMemorySize, LDS_BYTES) != hipSuccess) { fprintf(stderr, "kernel_launch: hipFuncSetAttribute failed\n"); grid = -1; return; }
        (void)hipGetLastError();
        grid = cus;
    }
    if (grid < 0) return;
    if (hipMemsetAsync((char*)d_ws + WS_CTL, 0, CTL_ZERO_BYTES, stream) != hipSuccess) return;
    Args a{};
    for (int i = 0; i < 17; ++i) a.in[i] = (const float*)d_in[i];
    a.out = (float*)d_out; a.ws = (unsigned char*)d_ws;
    if (N_LAUNCHES == 1) {
        a.ph_lo = 0; a.ph_hi = NPH; a.li = 0;
        hipLaunchKernelGGL(yoco_fwd, dim3(grid), dim3(NWAVES * 64), LDS_BYTES, stream, a);
    } else {
        for (int p = 0; p < NPH; ++p) { a.ph_lo = p; a.ph_hi = p + 1; a.li = 0;
            hipLaunchKernelGGL(yoco_fwd, dim3(grid), dim3(NWAVES * 64), LDS_BYTES, stream, a); }
    }
}
```

```cpp
#include <hip/hip_runtime.h>
#include <cstdio>
#include <cstdint>

#ifndef PROBE_SEL
#define PROBE_SEL 0
#endif
#ifndef PROBE_MUL
#define PROBE_MUL 1
#endif
#ifndef MK_N_LAUNCHES
#define MK_N_LAUNCHES 1
#endif

namespace pg8 {
#define PG8_LAS __attribute__((address_space(3)))
typedef unsigned short bf16_t;
typedef short bf16x8 __attribute__((ext_vector_type(8)));
typedef float f32x4 __attribute__((ext_vector_type(4)));
typedef unsigned u32x4 __attribute__((ext_vector_type(4)));
typedef unsigned u32x2 __attribute__((ext_vector_type(2)));
constexpr int BM = 256, BK = 64, HALF = 128, HTB = HALF * BK * 2, STAGE_BYTES = 8 * HTB, NXCD = 8, WGM = 8;

__host__ __device__ __forceinline__ int lds_byte(int r, int c) { const int st = (r >> 4) * 2 + (c >> 5), rr = r & 15, cc = c & 31, ob = rr * 64 + cc * 2; return st * 1024 + (ob ^ (((ob >> 9) & 1) << 5)); }
__host__ __device__ __forceinline__ void stage_rc(int b, int& R, int& C) { const int st = b / 1024, sb = b % 1024, swz = sb ^ (((sb >> 9) & 1) << 5); R = (st >> 1) * 16 + swz / 64; C = (st & 1) * 32 + (swz % 64) / 2; }
__host__ __device__ __forceinline__ int perm32(int rho) { const int n = rho >> 4, i = rho & 15; return 8 * (i >> 2) + 4 * n + (i & 3); }

struct Unit { int pm, pn; };
struct Gemm { const bf16_t* A; const bf16_t* Bt; int M, N, K, lda; };

struct StaticOrder {
    int nM, nN, nwg, G, c;
    __host__ __device__ void init(int M, int N, int G_, int c_) { nM = M / BM; nN = N / BM; nwg = nM * nN; G = G_; c = c_; }
    __host__ __device__ bool next(int i, Unit& u) const {
        const long L = (long)i * G + c; if (L >= nwg) return false;
        int wgid = (int)L; { const int q = nwg / NXCD, r = nwg % NXCD, xcd = wgid % NXCD, off = wgid / NXCD; wgid = (xcd < r ? xcd * (q + 1) : r * (q + 1) + (xcd - r) * q) + off; }
        const int nig = WGM * nN, gid = wgid / nig, fm = gid * WGM, gsz = (nM - fm) < WGM ? (nM - fm) : WGM;
        u.pm = fm + ((wgid % nig) % gsz); u.pn = (wgid % nig) / gsz; return true;
    }
    __device__ __forceinline__ void a_ready(const Unit&) const {}
    __device__ __forceinline__ void done(const Unit&) const {}
};

__device__ __forceinline__ unsigned cvt_pk_bf16(float lo, float hi) { unsigned r; asm volatile("v_cvt_pk_bf16_f32 %0, %1, %2" : "=v"(r) : "v"(lo), "v"(hi)); return r; }

constexpr int MROWS = 16384;
__device__ __forceinline__ float row_rstd(const float* ssq, int row) { const float s = (ssq[row] + ssq[MROWS + row]) + (ssq[2 * MROWS + row] + ssq[3 * MROWS + row]); return 1.0f / sqrtf(s * (1.0f / 1024.0f) + 1e-6f); }

struct EpiScale {
    static constexpr bool PERM = true, AFTER_DRAIN = false;
    bf16_t* O; int ldc; bf16_t* O2; int ldc2; int split_col; const float* ssq; int act;
    __device__ __forceinline__ void operator()(const f32x4 (&acc)[2][2][4][2], const Unit& u, int wr, int wc, int fr, int fq) const {
        const int row0 = u.pm * BM + wr * 64 + fr; int colt = u.pn * BM; bf16_t* base = O; int ld = ldc;
        if (colt >= split_col) { base = O2; colt -= split_col; ld = ldc2; }
        const int col0 = colt + wc * 32 + 8 * fq;
        float rs[2][4]; f32x4 sq[2][4];
#pragma unroll
        for (int ai = 0; ai < 2; ++ai)
#pragma unroll
            for (int m = 0; m < 4; ++m) { const int row = row0 + ai * HALF + m * 16; sq[ai][m] = (f32x4){ssq[row], ssq[MROWS + row], ssq[2 * MROWS + row], ssq[3 * MROWS + row]}; }
#pragma unroll
        for (int ai = 0; ai < 2; ++ai)
#pragma unroll
            for (int m = 0; m < 4; ++m) rs[ai][m] = 1.0f / sqrtf(((sq[ai][m][0] + sq[ai][m][1]) + (sq[ai][m][2] + sq[ai][m][3])) * (1.0f / 1024.0f) + 1e-6f);
#pragma unroll
        for (int ai = 0; ai < 2; ++ai)
#pragma unroll
            for (int m = 0; m < 4; ++m) { const int row = row0 + ai * HALF + m * 16; const float r = rs[ai][m]; bf16_t* rowp = base + (size_t)row * ld + col0;
#pragma unroll
                for (int bj = 0; bj < 2; ++bj) { f32x4 v0 = acc[ai][bj][m][0] * r, v1 = acc[ai][bj][m][1] * r;
                    if (act == 1) {
#pragma unroll
                        for (int e = 0; e < 4; ++e) { float a = fmaxf(v0[e], 0.f); v0[e] = a * a; float b = fmaxf(v1[e], 0.f); v1[e] = b * b; } }
                    u32x4 w; w.x = cvt_pk_bf16(v0[0], v0[1]); w.y = cvt_pk_bf16(v0[2], v0[3]); w.z = cvt_pk_bf16(v1[0], v1[1]); w.w = cvt_pk_bf16(v1[2], v1[3]);
                    *(u32x4*)(rowp + bj * HALF) = w; } }
    }
};

struct EpiResid {
    static constexpr bool PERM = false, AFTER_DRAIN = true;
    const float* hin; float* hout; bf16_t* hb; float* ssq;
    __device__ __forceinline__ void fused(const f32x4 (&acc)[2][2][4][2], const Unit& u, int wr, int wc, int fr, int fq, PG8_LAS unsigned char* lds, int tid) const {
        PG8_LAS float* P = (PG8_LAS float*)lds;
        const int row0 = u.pm * BM + wr * 64 + fr, col0 = u.pn * BM + wc * 32 + 4 * fq;
#pragma unroll
        for (int ai = 0; ai < 2; ++ai) {
            f32x4 hv[4][2][2];
#pragma unroll
            for (int m = 0; m < 4; ++m)
#pragma unroll
                for (int bj = 0; bj < 2; ++bj)
#pragma unroll
                    for (int n = 0; n < 2; ++n) hv[m][bj][n] = *(const f32x4*)(hin + (size_t)(row0 + ai * HALF + m * 16) * 1024 + col0 + bj * HALF + n * 16);
            asm volatile("" ::: "memory");
#pragma unroll
            for (int m = 0; m < 4; ++m) { const int row = row0 + ai * HALF + m * 16; const size_t off = (size_t)row * 1024 + col0; float ss = 0.f;
#pragma unroll
                for (int bj = 0; bj < 2; ++bj)
#pragma unroll
                    for (int n = 0; n < 2; ++n) { const size_t o2 = off + bj * HALF + n * 16; const f32x4 v = hv[m][bj][n] + acc[ai][bj][m][n];
                        *(f32x4*)(hout + o2) = v; u32x2 w; w.x = cvt_pk_bf16(v[0], v[1]); w.y = cvt_pk_bf16(v[2], v[3]); *(u32x2*)(hb + o2) = w;
                        ss += (v[0] * v[0] + v[1] * v[1]) + (v[2] * v[2] + v[3] * v[3]); }
                ss += __shfl_xor(ss, 16); ss += __shfl_xor(ss, 32);
                if (fq == 0) P[(ai * HALF + wr * 64 + m * 16 + fr) * 4 + wc] = ss; }
            asm volatile("" ::: "memory");
        }
        asm volatile("s_waitcnt lgkmcnt(0)" ::: "memory"); __builtin_amdgcn_s_barrier(); asm volatile("" ::: "memory");
        if (tid < 256) { const PG8_LAS f32x4* p4 = (const PG8_LAS f32x4*)P + tid; const f32x4 v = *p4; ssq[(size_t)u.pn * MROWS + u.pm * BM + tid] = (v[0] + v[1]) + (v[2] + v[3]); }
    }
};

template <class Epi, class Sched, bool ALIGN_EPI = false, bool SP2 = false>
__device__ __forceinline__ void gemm_phase(PG8_LAS unsigned char* lds, const Gemm g, const Sched& S, const Epi& E) {
    int tid_ = threadIdx.x; asm volatile("" : "+v"(tid_)); const int tid = tid_, wid = __builtin_amdgcn_readfirstlane(tid >> 6), lane = tid & 63, wr = wid >> 2, wc = wid & 3, fr = lane & 15, fq = lane >> 4;
    const int K = g.K, nt = K / BK, lda = g.lda;
    unsigned voffA[2], voffB[2];
#pragma unroll
    for (int i = 0; i < 2; ++i) { int R, C; stage_rc(tid * 16 + i * 8192, R, C); const int Rb = Epi::PERM ? ((R & ~31) + perm32(R & 31)) : R;
        voffA[i] = (unsigned)(R * lda + C) * 2u; voffB[i] = (unsigned)(Rb * K + C) * 2u; }
    const size_t kstep = (size_t)(BK * 2);
    const size_t hstepA = (size_t)HALF * lda * 2, hstepB = (size_t)HALF * K * 2;
    const size_t tstepA = 2 * hstepA, tstepB = 2 * hstepB;
    const unsigned ldsw = (unsigned)wid * 1024u;
    const int aoff = lds_byte(wr * 64 + fr, fq * 8), boff = lds_byte(wc * 32 + fr, fq * 8);
#define PG8_SA(b, h) (((b) * 2 + (h)) * HTB)
#define PG8_SB(b, h) ((4 + (b) * 2 + (h)) * HTB)
#define PG8_STAGE(bufoff, gbase, voff) do { _Pragma("unroll") for (int _i = 0; _i < 2; ++_i) \
        __builtin_amdgcn_global_load_lds((const unsigned*)((const char*)(gbase) + (voff)[_i]), (PG8_LAS unsigned*)(lds + (bufoff) + ldsw + _i * 8192), 16, 0, 0); } while (0)
#define PG8_LDA(dst, b, h) do { _Pragma("unroll") for (int m = 0; m < 4; ++m) _Pragma("unroll") for (int k = 0; k < 2; ++k) dst[m][k] = *(const PG8_LAS bf16x8*)(lds + PG8_SA(b, h) + aoff + m * 2048 + k * 1024); } while (0)
#define PG8_LDB(dst, b, h) do { _Pragma("unroll") for (int n = 0; n < 2; ++n) _Pragma("unroll") for (int k = 0; k < 2; ++k) dst[n][k] = *(const PG8_LAS bf16x8*)(lds + PG8_SB(b, h) + boff + n * 2048 + k * 1024); } while (0)
#define PG8_MMA(ai, bj, At, Bt) do { __builtin_amdgcn_s_setprio(1); _Pragma("unroll") for (int m = 0; m < 4; ++m) _Pragma("unroll") for (int n = 0; n < 2; ++n) _Pragma("unroll") for (int k = 0; k < 2; ++k) \
        acc[ai][bj][m][n] = __builtin_amdgcn_mfma_f32_16x16x32_bf16(Bt[n][k], At[m][k], acc[ai][bj][m][n], 0, 0, 0); __builtin_amdgcn_s_setprio(0); } while (0)
#define PG8_WAIT_V(n) asm volatile("s_waitcnt vmcnt(" #n ")" ::: "memory")
#define PG8_WAIT_L(n) asm volatile("s_waitcnt lgkmcnt(" #n ")" ::: "memory")
#define PG8_BAR __builtin_amdgcn_s_barrier()
#define PG8_SCHED __builtin_amdgcn_sched_barrier(0)
    Unit cur, nxt; int ui = 0;
    if (!S.next(0, cur)) return;
    f32x4 acc[2][2][4][2];
#pragma unroll
    for (int a = 0; a < 2; ++a)
#pragma unroll
        for (int b = 0; b < 2; ++b)
#pragma unroll
            for (int m = 0; m < 4; ++m)
#pragma unroll
                for (int n = 0; n < 2; ++n) acc[a][b][m][n] = (f32x4){0.f, 0.f, 0.f, 0.f};
    bf16x8 At[4][2], B0[2][2], B1[2][2];
    const char* cA = (const char*)g.A + (size_t)cur.pm * tstepA; const char* cB = (const char*)g.Bt + (size_t)cur.pn * tstepB;
    S.a_ready(cur);
    if constexpr (SP2) {
        PG8_STAGE(PG8_SB(0, 0), cB, voffB); PG8_STAGE(PG8_SB(0, 1), cB + hstepB, voffB); PG8_STAGE(PG8_SA(0, 0), cA, voffA); PG8_STAGE(PG8_SA(0, 1), cA + hstepA, voffA);
        if (wr == 1) PG8_BAR;
        PG8_WAIT_V(2); PG8_BAR;
        PG8_STAGE(PG8_SB(1, 0), cB + kstep, voffB); PG8_STAGE(PG8_SA(1, 0), cA + kstep, voffA); PG8_STAGE(PG8_SB(1, 1), cB + hstepB + kstep, voffB);
        PG8_WAIT_V(6); PG8_BAR;
    } else {
        PG8_STAGE(PG8_SB(0, 0), cB, voffB); PG8_STAGE(PG8_SA(0, 0), cA, voffA); PG8_STAGE(PG8_SB(0, 1), cB + hstepB, voffB); PG8_STAGE(PG8_SA(0, 1), cA + hstepA, voffA);
        if (wr == 1) PG8_BAR;
        PG8_WAIT_V(4); PG8_BAR;
        PG8_STAGE(PG8_SB(1, 0), cB + kstep, voffB); PG8_STAGE(PG8_SA(1, 0), cA + kstep, voffA); PG8_STAGE(PG8_SB(1, 1), cB + hstepB + kstep, voffB);
        PG8_WAIT_V(6); PG8_BAR;
    }
    for (;;) {
        const bool has_next = S.next(ui + 1, nxt);
        const char* nA = has_next ? (const char*)g.A + (size_t)nxt.pm * tstepA : cA; const char* nB = has_next ? (const char*)g.Bt + (size_t)nxt.pn * tstepB : cB;
        for (int t = 0; t < nt; t += 2) {
            const bool last = (t == nt - 2);
            const char* a1 = cA + (size_t)(t + 1) * kstep;
            const char* a2 = last ? nA : cA + (size_t)(t + 2) * kstep; const char* b2 = last ? nB : cB + (size_t)(t + 2) * kstep;
            const char* a3 = a2 + kstep; const char* b3 = b2 + kstep;
            if (last && has_next) S.a_ready(nxt);
            if constexpr (SP2) {
            PG8_LDB(B0, 0, 0); PG8_LDB(B1, 0, 1); PG8_SCHED; PG8_LDA(At, 0, 0); PG8_STAGE(PG8_SA(1, 1), a1 + hstepA, voffA);
            PG8_WAIT_V(8); PG8_WAIT_L(0); PG8_BAR; PG8_MMA(0, 0, At, B0); PG8_MMA(0, 1, At, B1); PG8_BAR; PG8_SCHED;
            PG8_LDA(At, 0, 1); PG8_STAGE(PG8_SB(0, 0), b2, voffB); PG8_STAGE(PG8_SB(0, 1), b2 + hstepB, voffB); PG8_STAGE(PG8_SA(0, 0), a2, voffA);
            PG8_WAIT_V(8); PG8_WAIT_L(0); PG8_BAR; PG8_MMA(1, 0, At, B0); PG8_MMA(1, 1, At, B1); PG8_BAR; PG8_SCHED;
            PG8_LDB(B0, 1, 0); PG8_LDB(B1, 1, 1); PG8_SCHED; PG8_LDA(At, 1, 0); PG8_STAGE(PG8_SA(0, 1), a2 + hstepA, voffA);
            PG8_WAIT_V(8); PG8_WAIT_L(0); PG8_BAR; PG8_MMA(0, 0, At, B0); PG8_MMA(0, 1, At, B1); PG8_BAR; PG8_SCHED;
            PG8_LDA(At, 1, 1); PG8_STAGE(PG8_SB(1, 0), b3, voffB); PG8_STAGE(PG8_SB(1, 1), b3 + hstepB, voffB); PG8_STAGE(PG8_SA(1, 0), a3, voffA);
            PG8_WAIT_V(8); PG8_WAIT_L(0); PG8_BAR; PG8_MMA(1, 0, At, B0); PG8_MMA(1, 1, At, B1); PG8_BAR; PG8_SCHED;
            } else {
            PG8_LDB(B0, 0, 0); PG8_SCHED; PG8_LDA(At, 0, 0); PG8_STAGE(PG8_SA(1, 1), a1 + hstepA, voffA);
            PG8_WAIT_L(8); PG8_BAR; PG8_WAIT_L(0); PG8_MMA(0, 0, At, B0); PG8_BAR; PG8_SCHED;
            PG8_LDB(B1, 0, 1); PG8_STAGE(PG8_SB(0, 0), b2, voffB);
            PG8_BAR; PG8_WAIT_L(0); PG8_MMA(0, 1, At, B1); PG8_BAR;
            PG8_LDA(At, 0, 1); PG8_STAGE(PG8_SA(0, 0), a2, voffA);
            PG8_BAR; PG8_WAIT_L(0); PG8_MMA(1, 0, At, B0); PG8_BAR; PG8_SCHED;
            PG8_STAGE(PG8_SB(0, 1), b2 + hstepB, voffB);
            PG8_WAIT_V(6); PG8_BAR; PG8_MMA(1, 1, At, B1); PG8_BAR;
            PG8_LDB(B0, 1, 0); PG8_SCHED; PG8_LDA(At, 1, 0); PG8_STAGE(PG8_SA(0, 1), a2 + hstepA, voffA);
            PG8_WAIT_L(8); PG8_BAR; PG8_WAIT_L(0); PG8_MMA(0, 0, At, B0); PG8_BAR; PG8_SCHED;
            PG8_LDB(B1, 1, 1); PG8_STAGE(PG8_SB(1, 0), b3, voffB);
            PG8_BAR; PG8_WAIT_L(0); PG8_MMA(0, 1, At, B1); PG8_BAR;
            PG8_LDA(At, 1, 1); PG8_STAGE(PG8_SA(1, 0), a3, voffA);
            PG8_BAR; PG8_WAIT_L(0); PG8_MMA(1, 0, At, B0); PG8_BAR; PG8_SCHED;
            PG8_STAGE(PG8_SB(1, 1), b3 + hstepB, voffB);
            PG8_WAIT_V(6); PG8_BAR; PG8_MMA(1, 1, At, B1); PG8_BAR;
            }
        }
        if constexpr (ALIGN_EPI) { if (wr == 0) PG8_BAR; }
        if constexpr (!Epi::AFTER_DRAIN) { E(acc, cur, wr, wc, fr, fq); S.done(cur); }
        if (!has_next) break;
#pragma unroll
        for (int a = 0; a < 2; ++a)
#pragma unroll
            for (int b = 0; b < 2; ++b)
#pragma unroll
                for (int m = 0; m < 4; ++m)
#pragma unroll
                    for (int n = 0; n < 2; ++n) acc[a][b][m][n] = (f32x4){0.f, 0.f, 0.f, 0.f};
        cur = nxt; cA = nA; cB = nB; ++ui;
        if constexpr (ALIGN_EPI) { if (wr == 1) PG8_BAR; }
    }
    PG8_WAIT_V(0);
    if constexpr (!ALIGN_EPI) { if (wr == 0) PG8_BAR; }
    PG8_BAR;
    if constexpr (Epi::AFTER_DRAIN) { E.fused(acc, cur, wr, wc, fr, fq, lds, tid); S.done(cur); }
#undef PG8_SA
#undef PG8_SB
#undef PG8_STAGE
#undef PG8_LDA
#undef PG8_LDB
#undef PG8_MMA
#undef PG8_WAIT_V
#undef PG8_WAIT_L
#undef PG8_BAR
#undef PG8_SCHED
}
}

constexpr int NWAVES = 8;
constexpr int N_LAUNCHES = MK_N_LAUNCHES;
constexpr int NPH = 26;
constexpr int M = 16384, D = 1024, T = 4096, FF = 4096, NIN = 3072, APROJ = 3088, KD = 512;
constexpr float EPS = 1e-6f, LOG2E = 1.4426950408889634f;

constexpr size_t MiB = 1u << 20;
constexpr size_t WS_CTL = 0, CTL_ZERO_BYTES = 1 * MiB;
constexpr size_t WS_SSQ = 1 * MiB;
constexpr size_t WS_WG = 2 * MiB;
constexpr size_t WS_BEND = 2 * MiB + 65536;
constexpr size_t WS_WIN = 3 * MiB;
constexpr size_t WS_KV = 3 * MiB;
constexpr size_t WS_WAO = 15 * MiB;
constexpr size_t WS_WUP = 19 * MiB;
constexpr size_t WS_WDN = 51 * MiB;
constexpr size_t WS_WQ = 83 * MiB;
constexpr size_t WS_WQ1 = WS_WQ + (size_t)1280 * 1024 * 2;
constexpr size_t WS_WBO = 88 * MiB;
constexpr size_t WS_HB = 92 * MiB;
constexpr size_t WS_U = 124 * MiB;
constexpr size_t WS_BCUM = WS_U + 96 * MiB;
constexpr size_t WS_END = 252 * MiB;
constexpr int CW_BAR = 4096;

constexpr int LDS_BYTES = 147456;
constexpr int RING_BYTES = 131072, LDSCTL_OFF = 143360, MISC_OFF = LDSCTL_OFF + 320;

#define GAS __attribute__((address_space(1)))
#define LAS __attribute__((address_space(3)))
typedef unsigned short bf16;
typedef unsigned v4u __attribute__((ext_vector_type(4)));
typedef unsigned v2u __attribute__((ext_vector_type(2)));
typedef float f32x4 __attribute__((ext_vector_type(4)));
typedef GAS unsigned gu32;
typedef short bf16x8 __attribute__((ext_vector_type(8)));
typedef short s16x4 __attribute__((ext_vector_type(4)));
__device__ __forceinline__ s16x4 tr_read(const LAS unsigned char* p) { return __builtin_bit_cast(s16x4, __builtin_amdgcn_ds_read_tr16_b64_v4i16((LAS s16x4*)p)); }
#define RLX_AGENT __ATOMIC_RELAXED, __HIP_MEMORY_SCOPE_AGENT
#define LDS_WAIT() asm volatile("s_waitcnt lgkmcnt(0)" ::: "memory")
#define VM_WAIT() asm volatile("s_waitcnt vmcnt(0)" ::: "memory")
__device__ __forceinline__ unsigned f2bf(float f) { unsigned u = __builtin_bit_cast(unsigned, f); return (u + 0x7fffu + ((u >> 16) & 1u)) >> 16; }
__device__ __forceinline__ unsigned pk2(float lo, float hi) { return f2bf(lo) | (f2bf(hi) << 16); }
__device__ __forceinline__ float bf2f(unsigned short b) { return __builtin_bit_cast(float, (unsigned)b << 16); }
__device__ __forceinline__ float bflo(unsigned w) { return __builtin_bit_cast(float, w << 16); }
__device__ __forceinline__ float bfhi(unsigned w) { return __builtin_bit_cast(float, w & 0xffff0000u); }

#define XB_TMO      128
#define XB_XCNT(j)  (256  + 64 * (j))
#define XB_XSUB(j)  (1280 + 64 * (j))
#define XB_XGEN(j)  (2304 + 64 * (j))
#define XB_TOP      3328
#define XB_TOPGEN   3392
#define XCD_BAR_WORDS 3456
#define XB_SPIN_CAP (1u << 18)
__device__ __forceinline__ unsigned xb_ld(unsigned* p)              { return __hip_atomic_load(p, __ATOMIC_RELAXED, __HIP_MEMORY_SCOPE_AGENT); }
__device__ __forceinline__ unsigned xb_add(unsigned* p, unsigned v) { return __hip_atomic_fetch_add(p, v, __ATOMIC_RELAXED, __HIP_MEMORY_SCOPE_AGENT); }
__device__ __forceinline__ unsigned xb_xcc_id() { return (unsigned)__builtin_amdgcn_s_getreg((3 << 11) | 20) & 0xFu; }
#define XB_SPIN(cond, bar) do { unsigned _sp = 0; while (cond) { __builtin_amdgcn_s_sleep(1); \
    if ((++_sp & 255u) == 0u) { if (xb_ld(&(bar)[XB_TMO])) break; if (_sp > XB_SPIN_CAP) { atomicAdd(&(bar)[XB_TMO], 1u); break; } } } } while (0)
struct XcdBarrier { unsigned* bar; unsigned x; volatile LAS unsigned* st; };
__device__ __forceinline__ XcdBarrier xcd_barrier_post(unsigned* bar, volatile LAS unsigned* st) {
    XcdBarrier b; b.bar = bar; b.x = xb_xcc_id(); b.st = st;
    if (threadIdx.x == 0) (void)xb_add(&bar[XB_XCNT(b.x)], 1u);
    return b;
}
__device__ __forceinline__ void xcd_barrier_complete(unsigned* bar, unsigned x, unsigned& nloc, unsigned& nx) {
    const unsigned G = gridDim.x * gridDim.y * gridDim.z;
    unsigned sum, cnt, mine, sp = 0u;
    for (;;) {
        sum = 0u; cnt = 0u; mine = 0u;
#pragma unroll
        for (unsigned j = 0; j < 16; ++j) { const unsigned c = xb_ld(&bar[XB_XCNT(j)]); sum += c; cnt += (c > 0u) ? 1u : 0u; mine = (j == x) ? c : mine; }
        if (sum == G) break;
        __builtin_amdgcn_s_sleep(1);
        if ((++sp & 255u) == 0u) { if (xb_ld(&bar[XB_TMO])) break; if (sp > XB_SPIN_CAP) { atomicAdd(&bar[XB_TMO], 1u); break; } }
    }
    nloc = mine > 0u ? mine : 1u; nx = cnt > 0u ? cnt : 1u;
}
__device__ __forceinline__ void xcd_barrier(const XcdBarrier& b) {
    asm volatile("s_waitcnt vmcnt(0)" ::: "memory");
    __syncthreads();
    if (threadIdx.x == 0) {
        unsigned* bar = b.bar;
        __builtin_amdgcn_s_waitcnt(0);
        unsigned nloc = b.st[0], nx = b.st[1];
        if (nloc == 0u) { xcd_barrier_complete(bar, b.x, nloc, nx); b.st[0] = nloc; b.st[1] = nx; }
        const unsigned old = xb_add(&bar[XB_XSUB(b.x)], 1u);
        const unsigned gen = old / nloc;
        if (old + 1u == (gen + 1u) * nloc) {
            __builtin_amdgcn_fence(__ATOMIC_RELEASE, "agent");
            asm volatile("s_waitcnt vmcnt(0)" ::: "memory");
            const unsigned og = xb_add(&bar[XB_TOP], 1u);
            const unsigned tg = og / nx;
            if (og + 1u == (tg + 1u) * nx) xb_add(&bar[XB_TOPGEN], 1u);
            else XB_SPIN(xb_ld(&bar[XB_TOPGEN]) == tg, bar);
            __builtin_amdgcn_fence(__ATOMIC_ACQUIRE, "agent");
            xb_add(&bar[XB_XGEN(b.x)], 1u);
            asm volatile("s_waitcnt vmcnt(0)" ::: "memory");
        } else {
            XB_SPIN(xb_ld(&bar[XB_XGEN(b.x)]) == gen, bar);
            __builtin_amdgcn_fence(__ATOMIC_ACQUIRE, "agent");
            asm volatile("s_waitcnt vmcnt(0)" ::: "memory");
        }
    }
    __syncthreads();
}

__device__ __forceinline__ float wave_sum(float v) {
#pragma unroll
    for (int o = 1; o < 64; o <<= 1) v += __shfl_xor(v, o);
    return v;
}

__device__ __forceinline__ void p0_transpose_item(const float* W_, int ldw, int K, int nblk, bf16* WT, const float* gain, float scale, int nscale, LAS float* scr, int item, int lane) {
    const GAS float* W = (const GAS float*)W_;
    const int kb = item / nblk, nb = item % nblk, k0 = 64 * kb, n0 = 32 * nb;
    const int n4 = (lane & 7) * 4, kr = lane >> 3;
    const float sc = (n0 + n4) < nscale ? scale : 1.0f;
    f32x4 v[8]; float gn[8];
#pragma unroll
    for (int i = 0; i < 8; ++i) { v[i] = *(const GAS f32x4*)(W + (size_t)(k0 + kr + 8 * i) * ldw + n0 + n4); gn[i] = gain ? gain[k0 + kr + 8 * i] : 1.0f; }
#pragma unroll
    for (int i = 0; i < 8; ++i) { const float m = gn[i] * sc; LAS float* d = scr + (kr + 8 * i) * 33 + n4; d[0] = v[i][0] * m; d[1] = v[i][1] * m; d[2] = v[i][2] * m; d[3] = v[i][3] * m; }
    LDS_WAIT(); asm volatile("" ::: "memory");
    const int c = lane & 7;
#pragma unroll
    for (int j = 0; j < 4; ++j) { const int n = (lane >> 3) + 8 * j; const LAS float* s = scr + (8 * c) * 33 + n;
        v4u o; o.x = pk2(s[0 * 33], s[1 * 33]); o.y = pk2(s[2 * 33], s[3 * 33]); o.z = pk2(s[4 * 33], s[5 * 33]); o.w = pk2(s[6 * 33], s[7 * 33]);
        *(GAS v4u*)(WT + (size_t)(n0 + n) * K + k0 + 8 * c) = o; }
    LDS_WAIT(); asm volatile("" ::: "memory");
}

struct Args { const float* in[17]; float* out; unsigned char* ws; int ph_lo, ph_hi, li, pad; };

__device__ __forceinline__ float logsigmoidf(float z) { return fminf(z, 0.f) - log1pf(__expf(-fabsf(z))); }

__global__ void __launch_bounds__(NWAVES * 64, 2) yoco_fwd(Args args) {
    extern __shared__ __attribute__((aligned(16))) unsigned char lds[];
    LAS unsigned char* ldsl = (LAS unsigned char*)lds;
    volatile LAS unsigned* MISC = (volatile LAS unsigned*)(ldsl + MISC_OFF);
    const int tid0 = threadIdx.x, lane0 = tid0 & 63, wave0 = __builtin_amdgcn_readfirstlane(tid0 >> 6);
#define PHASE_IDS int tid = threadIdx.x; asm volatile("" : "+v"(tid)); const int lane = tid & 63, wave = __builtin_amdgcn_readfirstlane(tid >> 6); (void)lane; (void)wave;
    const int G = gridDim.x; const int bx = blockIdx.x; const int vcu = (G % 8 == 0) ? (bx % 8) * (G / 8) + bx / 8 : bx;
    unsigned char* ws = args.ws;
    gu32* ctl = (gu32*)(ws + WS_CTL);
    const float* x = args.in[0]; const float* a_w_in = args.in[1]; const float* a_w_gk2 = args.in[2]; const float* a_b_gk = args.in[3]; const float* a_onorm = args.in[4];
    const float* a_w_out = args.in[5]; const float* kv_norm = args.in[6]; const float* w_kv = args.in[7]; const float* b_w_q = args.in[8]; const float* b_sinks = args.in[9];
    const float* b_w_out = args.in[10]; const float* rel_table = args.in[11]; const float* ln_mix = args.in[12]; const float* ln_mlp = args.in[13];
    const float* w_up = args.in[14]; const float* w_down = args.in[15]; const float* ln_final = args.in[16];
    float* out = args.out;
    float* ssq = (float*)(ws + WS_SSQ);
    bf16* Wg_t = (bf16*)(ws + WS_WG); float* BendG = (float*)(ws + WS_BEND);
    bf16* Win_t = (bf16*)(ws + WS_WIN); bf16* KVb = (bf16*)(ws + WS_KV); bf16* Wao_t = (bf16*)(ws + WS_WAO); bf16* Wup_t = (bf16*)(ws + WS_WUP); bf16* Wdn_t = (bf16*)(ws + WS_WDN);
    bf16* Wq0_t = (bf16*)(ws + WS_WQ); bf16* Wq1_t = (bf16*)(ws + WS_WQ1); bf16* Wbo_t = (bf16*)(ws + WS_WBO);
    bf16* HB = (bf16*)(ws + WS_HB); bf16* Sst = (bf16*)(ws + WS_HB);
    bf16* U = (bf16*)(ws + WS_U); bf16* QKVG = (bf16*)(ws + WS_U); bf16* Qb = (bf16*)(ws + WS_U); float* BCUM = (float*)(ws + WS_BCUM);

    for (int u = tid0; u < (LDS_BYTES - LDSCTL_OFF) / 4; u += NWAVES * 64) ((LAS unsigned*)(ldsl + LDSCTL_OFF))[u] = 0u;
    __syncthreads();
    XcdBarrier bar; bar.bar = (unsigned*)(ctl + CW_BAR) + args.li * XCD_BAR_WORDS; bar.x = 0; bar.st = nullptr;
    if (N_LAUNCHES != NPH) bar = xcd_barrier_post((unsigned*)(ctl + CW_BAR) + args.li * XCD_BAR_WORDS, MISC + 8);
#if PROBE_SEL
    unsigned long long pr_acc = 0, pr_t0 = 0, pr_tb = 0;
#define TIC() do { pr_t0 = __builtin_amdgcn_s_memrealtime(); } while (0)
#define TOC(cls) do { if ((PROBE_SEL >> (cls)) & 1) pr_acc += __builtin_amdgcn_s_memrealtime() - pr_t0; } while (0)
#define GRID_BAR() do { if (N_LAUNCHES != NPH) { pr_tb = __builtin_amdgcn_s_memrealtime(); xcd_barrier(bar); if ((PROBE_SEL >> 12) & 1) pr_acc += __builtin_amdgcn_s_memrealtime() - pr_tb; } } while (0)
#else
#define TIC() do { } while (0)
#define TOC(cls) do { } while (0)
#define GRID_BAR() do { if (N_LAUNCHES != NPH) xcd_barrier(bar); } while (0)
#endif
    const int lo = args.ph_lo, hi = args.ph_hi;
#define IN(k) (lo <= (k) && (k) < hi)
#define BOTH(k) (IN(k) && IN((k) + 1))

    if (IN(0)) { PHASE_IDS TIC();
        LAS float* scr = (LAS float*)(ldsl + wave * 16384);
        const int gw = vcu * NWAVES + wave, NGW = G * NWAVES;
        constexpr int I_IN = 16 * 96, I_SQ = 16 * 32, I_UP = 16 * 128, I_DN = 64 * 32, I_KV = 16 * 8;
        constexpr int NITEMS = 2 * I_IN + 2 * I_SQ + 4 * I_UP + 4 * I_DN + 2 * I_SQ + I_KV + 2 * I_SQ;
        for (int it = gw; it < NITEMS; it += NGW) {
            int r = it;
            if (r < 2 * I_IN) { const int l = r / I_IN; p0_transpose_item(a_w_in + (size_t)l * D * APROJ, APROJ, D, 96, Win_t + (size_t)l * NIN * D, ln_mix + l * D, 0.08838834764831845f, 512, scr, r % I_IN, lane); continue; } r -= 2 * I_IN;
            if (r < 2 * I_SQ) { const int l = r / I_SQ; p0_transpose_item(a_w_out + (size_t)l * D * D, D, D, 32, Wao_t + (size_t)l * D * D, nullptr, 1.f, 0, scr, r % I_SQ, lane); continue; } r -= 2 * I_SQ;
            if (r < 4 * I_UP) { const int l = r / I_UP; p0_transpose_item(w_up + (size_t)l * D * FF, FF, D, 128, Wup_t + (size_t)l * FF * D, ln_mlp + l * D, 1.f, 0, scr, r % I_UP, lane); continue; } r -= 4 * I_UP;
            if (r < 4 * I_DN) { const int l = r / I_DN; p0_transpose_item(w_down + (size_t)l * FF * D, D, FF, 32, Wdn_t + (size_t)l * D * FF, nullptr, 1.f, 0, scr, r % I_DN, lane); continue; } r -= 4 * I_DN;
            if (r < 2 * I_SQ) { const int j = r / I_SQ; p0_transpose_item(b_w_q + (size_t)j * D * D, D, D, 32, j == 0 ? Wq0_t : Wq1_t, ln_mix + (2 + j) * D, 0.125f * LOG2E, 1024, scr, r % I_SQ, lane); continue; } r -= 2 * I_SQ;
            if (r < I_KV) { p0_transpose_item(w_kv, 256, D, 8, Wq0_t + (size_t)1024 * D, kv_norm, 1.f, 0, scr, r, lane); continue; } r -= I_KV;
            { const int j = r / I_SQ; p0_transpose_item(b_w_out + (size_t)j * D * D, D, D, 32, Wbo_t + (size_t)j * D * D, nullptr, 1.f, 0, scr, r % I_SQ, lane); }
        }
        for (int e = vcu * 512 + tid; e < 2 * 16 * 1024; e += G * 512) { const int l = e >> 14, n = (e >> 10) & 15, k = e & 1023;
            Wg_t[e] = (bf16)f2bf(a_w_in[((size_t)l * D + k) * APROJ + NIN + n] * ln_mix[l * D + k]); }
        for (int m = gw; m < M; m += NGW) {
            const GAS f32x4* xr = (const GAS f32x4*)(x + (size_t)m * D) + lane; f32x4 v[4]; float s = 0.f;
#pragma unroll
            for (int j = 0; j < 4; ++j) { v[j] = xr[64 * j]; s += (v[j].x * v[j].x + v[j].y * v[j].y) + (v[j].z * v[j].z + v[j].w * v[j].w); }
            s = wave_sum(s);
            GAS unsigned long long* o8 = (GAS unsigned long long*)(HB + (size_t)m * D) + lane;
#pragma unroll
            for (int j = 0; j < 4; ++j) o8[64 * j] = (unsigned long long)pk2(v[j].x, v[j].y) | ((unsigned long long)pk2(v[j].z, v[j].w) << 32);
            if (lane < 4) ssq[(size_t)lane * M + m] = lane == 0 ? s : 0.f;
        }
        TOC(0); if (BOTH(0)) GRID_BAR();
    }

    for (int L = 0; L < 4; ++L) {
        const bool gla = L < 2; const int jb = L - 2;
        const int base = gla ? 1 + 7 * L : 15 + 5 * jb;
        const int pG1 = gla ? base + 4 : base + 2;
        if (IN(base)) { PHASE_IDS TIC();
            pg8::Gemm g; pg8::EpiScale E; E.ssq = ssq; E.act = 0;
            if (gla) { g = pg8::Gemm{HB, Win_t + (size_t)L * NIN * D, M, NIN, D, D}; E.O = QKVG; E.ldc = NIN; E.O2 = nullptr; E.ldc2 = 0; E.split_col = 1 << 30; }
            else if (jb == 0) { g = pg8::Gemm{HB, Wq0_t, M, 1280, D, D}; E.O = Qb; E.ldc = D; E.O2 = KVb; E.ldc2 = 256; E.split_col = 1024; }
            else { g = pg8::Gemm{HB, Wq1_t, M, 1024, D, D}; E.O = Qb; E.ldc = D; E.O2 = nullptr; E.ldc2 = 0; E.split_col = 1 << 30; }
            pg8::StaticOrder S; S.init(M, g.N, G, (int)blockIdx.x);
            pg8::gemm_phase<pg8::EpiScale, pg8::StaticOrder, true, true>(ldsl, g, S, E);
            TOC(gla ? 1 : 6); TIC();
            if (gla) {
                LAS float* part = (LAS float*)ldsl;
                LAS float* glr_s = (LAS float*)(ldsl + 8192);
                const GAS bf16* Wg = (const GAS bf16*)(Wg_t + (size_t)L * 16 * 1024);
                const int g4 = lane >> 4, l15 = lane & 15, mt = wave & 3, kh = wave >> 2;
                for (int c = vcu; c < M / 64; c += G) {
                    __syncthreads();
                    { const GAS bf16* ap = (const GAS bf16*)HB + (size_t)(c * 64 + 16 * mt + l15) * D + 512 * kh + 8 * g4; const GAS bf16* bp = Wg + (size_t)l15 * D + 512 * kh + 8 * g4;
                      f32x4 acc = (f32x4){0.f, 0.f, 0.f, 0.f};
#pragma unroll
                      for (int kb = 0; kb < 2; ++kb) { bf16x8 av[8], bv[8];
#pragma unroll
                          for (int ks = 0; ks < 8; ++ks) { av[ks] = *(const GAS bf16x8*)(ap + 256 * kb + 32 * ks); bv[ks] = *(const GAS bf16x8*)(bp + 256 * kb + 32 * ks); }
#pragma unroll
                          for (int ks = 0; ks < 8; ++ks) acc = __builtin_amdgcn_mfma_f32_16x16x32_bf16(av[ks], bv[ks], acc, 0, 0, 0); }
#pragma unroll
                      for (int r = 0; r < 4; ++r) part[(kh * 64 + 16 * mt + 4 * g4 + r) * 16 + l15] = acc[r]; }
                    __syncthreads();
                    { const int r = tid >> 3, n2 = (tid & 7) * 2; const float rs = pg8::row_rstd(ssq, c * 64 + r);
                      glr_s[r * 16 + n2] = (part[r * 16 + n2] + part[(64 + r) * 16 + n2]) * rs; glr_s[r * 16 + n2 + 1] = (part[r * 16 + n2 + 1] + part[(64 + r) * 16 + n2 + 1]) * rs; }
                    __syncthreads();
                    { const int kd = tid; float w2[16];
#pragma unroll
                      for (int r = 0; r < 16; ++r) w2[r] = a_w_gk2[((size_t)L * 16 + r) * KD + kd];
                      const float bb = a_b_gk[L * KD + kd]; float run = 0.f; GAS float* bo = (GAS float*)BCUM + (size_t)(c * 64) * KD + kd;
#pragma unroll 4
                      for (int t = 0; t < 64; ++t) { const LAS f32x4* gp = (const LAS f32x4*)(glr_s + t * 16); const f32x4 g0 = gp[0], g1 = gp[1], g2 = gp[2], g3 = gp[3];
                          float z = bb + ((g0[0] * w2[0] + g0[1] * w2[1]) + (g0[2] * w2[2] + g0[3] * w2[3])) + ((g1[0] * w2[4] + g1[1] * w2[5]) + (g1[2] * w2[6] + g1[3] * w2[7]))
                                       + ((g2[0] * w2[8] + g2[1] * w2[9]) + (g2[2] * w2[10] + g2[3] * w2[11])) + ((g3[0] * w2[12] + g3[1] * w2[13]) + (g3[2] * w2[14] + g3[3] * w2[15]));
                          const float ls = fminf(z, 0.f) - __logf(1.0f + __expf(-fabsf(z)));
                          run += ls * (1.0f / 16.0f); bo[(size_t)t * KD] = run; } }
                }
                __syncthreads();
            }
            TOC(2); if (BOTH(base)) GRID_BAR();
        }
        if (gla) {
            if (IN(base + 1)) { PHASE_IDS
                TIC(); constexpr int KD_OFF = 0, KD_RS = 288, V_OFF = 36864, V_RS = 544;
                const int g = lane >> 4, q4 = (lane & 15) >> 2, p4 = lane & 3, wk = wave >> 2, wv = wave & 3;
                for (int un = vcu; un < 512; un += G) {
                    const int seq = un >> 5, sc = un & 31, b = seq >> 2, h = seq & 3; const size_t t0 = (size_t)b * T + sc * 128;
                    __syncthreads();
                    { const int k8 = (tid & 15) * 8; const GAS float* bcb = (const GAS float*)BCUM + t0 * KD + h * 128 + k8; const GAS bf16* kb = (const GAS bf16*)QKVG + t0 * NIN + 512 + h * 128 + k8;
                      const GAS bf16* vb = (const GAS bf16*)QKVG + t0 * NIN + 1024 + h * 256;
                      const f32x4 l0a = *(const GAS f32x4*)(bcb + 63 * KD), l0b = *(const GAS f32x4*)(bcb + 63 * KD + 4), l1a = *(const GAS f32x4*)(bcb + 127 * KD), l1b = *(const GAS f32x4*)(bcb + 127 * KD + 4);
                      v4u kv[4]; f32x4 b0[4], b1[4]; v4u vv[8];
#pragma unroll
                      for (int i = 0; i < 4; ++i) { const int t = (tid >> 4) + 32 * i; kv[i] = *(const GAS v4u*)(kb + (size_t)t * NIN); b0[i] = *(const GAS f32x4*)(bcb + (size_t)t * KD); b1[i] = *(const GAS f32x4*)(bcb + (size_t)t * KD + 4); }
#pragma unroll
                      for (int i = 0; i < 8; ++i) { const int c = tid + 512 * i, t = c >> 5, v8 = (c & 31) * 8; vv[i] = *(const GAS v4u*)(vb + (size_t)t * NIN + v8); }
                      float last0[8], bend[8];
#pragma unroll
                      for (int e = 0; e < 4; ++e) { last0[e] = l0a[e]; last0[4 + e] = l0b[e]; bend[e] = l0a[e] + l1a[e]; bend[4 + e] = l0b[e] + l1b[e]; }
                      if (tid < 16) {
#pragma unroll
                          for (int e = 0; e < 8; ++e) BendG[(size_t)un * 128 + k8 + e] = bend[e]; }
#pragma unroll
                      for (int i = 0; i < 4; ++i) { const int t = (tid >> 4) + 32 * i; float r[8];
#pragma unroll
                          for (int e = 0; e < 8; ++e) { const float kk = (e & 1) ? bfhi(kv[i][e >> 1]) : bflo(kv[i][e >> 1]); const float bc = (e < 4 ? b0[i][e] : b1[i][e - 4]) + (t >= 64 ? last0[e] : 0.f); r[e] = kk * __expf(bend[e] - bc); }
                          v4u o; o.x = pk2(r[0], r[1]); o.y = pk2(r[2], r[3]); o.z = pk2(r[4], r[5]); o.w = pk2(r[6], r[7]);
                          *(LAS v4u*)(ldsl + KD_OFF + t * KD_RS + k8 * 2) = o; }
#pragma unroll
                      for (int i = 0; i < 8; ++i) { const int c = tid + 512 * i, t = c >> 5, v8 = (c & 31) * 8; *(LAS v4u*)(ldsl + V_OFF + t * V_RS + v8 * 2) = vv[i]; } }
                    __syncthreads();
                    f32x4 acc[4][4];
#pragma unroll
                    for (int a = 0; a < 4; ++a)
#pragma unroll
                        for (int c = 0; c < 4; ++c) acc[a][c] = (f32x4){0.f, 0.f, 0.f, 0.f};
#pragma unroll
                    for (int s = 0; s < 4; ++s) { const int rowb = 32 * s + 4 * g + q4;
                        bf16x8 af[4], bfr[4];
#pragma unroll
                        for (int kt = 0; kt < 4; ++kt) { const LAS unsigned char* ap = ldsl + KD_OFF + rowb * KD_RS + (64 * wk + 16 * kt + 4 * p4) * 2; const s16x4 lo = tr_read(ap), hi = tr_read(ap + 16 * KD_RS);
                            af[kt] = (bf16x8){lo[0], lo[1], lo[2], lo[3], hi[0], hi[1], hi[2], hi[3]}; }
#pragma unroll
                        for (int vt = 0; vt < 4; ++vt) { const LAS unsigned char* bp = ldsl + V_OFF + rowb * V_RS + (64 * wv + 16 * vt + 4 * p4) * 2; const s16x4 lo = tr_read(bp), hi = tr_read(bp + 16 * V_RS);
                            bfr[vt] = (bf16x8){lo[0], lo[1], lo[2], lo[3], hi[0], hi[1], hi[2], hi[3]}; }
#pragma unroll
                        for (int kt = 0; kt < 4; ++kt)
#pragma unroll
                            for (int vt = 0; vt < 4; ++vt) acc[kt][vt] = __builtin_amdgcn_mfma_f32_16x16x32_bf16(af[kt], bfr[vt], acc[kt][vt], 0, 0, 0); }
#pragma unroll
                    for (int kt = 0; kt < 4; ++kt)
#pragma unroll
                        for (int vt = 0; vt < 4; ++vt) { const int vd = 64 * wv + 16 * vt + (lane & 15), kd = 64 * wk + 16 * kt + 4 * g;
                            v2u w; w.x = pk2(acc[kt][vt][0], acc[kt][vt][1]); w.y = pk2(acc[kt][vt][2], acc[kt][vt][3]);
                            *(v2u*)(Sst + ((size_t)un * 256 + vd) * 128 + kd) = w; }
                }
                TOC(3); if (BOTH(base + 1)) GRID_BAR();
            }
            if (IN(base + 2)) { PHASE_IDS TIC();
                for (int w = vcu * 512 + tid; w < 16 * 8192; w += G * 512) { const int seq = w >> 13, e4 = (w & 8191) * 4, kd = e4 & 127; float run[4] = {0.f, 0.f, 0.f, 0.f};
                    for (int sc = 0; sc < 32; ++sc) { const int un = seq * 32 + sc; bf16* p = Sst + (size_t)un * 32768 + e4; const v2u tv = *(const v2u*)p;
                        const f32x4 be = *(const f32x4*)(BendG + (size_t)un * 128 + kd);
                        v2u o; o.x = pk2(run[0], run[1]); o.y = pk2(run[2], run[3]); *(v2u*)p = o;
                        run[0] = run[0] * __expf(be[0]) + bflo(tv.x); run[1] = run[1] * __expf(be[1]) + bfhi(tv.x); run[2] = run[2] * __expf(be[2]) + bflo(tv.y); run[3] = run[3] * __expf(be[3]) + bfhi(tv.y); } }
                TOC(4); if (BOTH(base + 2)) GRID_BAR();
            }
            if (IN(base + 3)) { PHASE_IDS TIC();
                constexpr int A_OFF = 0, A_RS = 288, B_OFF = 73728, B_RS = 544;
                const int g = lane >> 4, l15 = lane & 15, q4 = l15 >> 2, p4 = lane & 3;
                const int grp = wave < 4 ? wave : 11 - wave;
                for (int un = vcu; un < 512; un += G) {
                    const int seq = un >> 5, sc = un & 31, b = seq >> 2, h = seq & 3; const size_t t0 = (size_t)b * T + sc * 128;
                    __syncthreads();
                    { const GAS bf16* sb = (const GAS bf16*)Sst + (size_t)un * 32768; const GAS bf16* vb = (const GAS bf16*)QKVG + t0 * NIN + 1024 + h * 256;
                      v4u sv[8], vv[8];
#pragma unroll
                      for (int i = 0; i < 8; ++i) { const int c = tid + 512 * i; sv[i] = *(const GAS v4u*)(sb + (size_t)c * 8); vv[i] = *(const GAS v4u*)(vb + (size_t)(c >> 5) * NIN + (c & 31) * 8); }
#pragma unroll
                      for (int i = 0; i < 8; ++i) { const int c = tid + 512 * i; *(LAS v4u*)(ldsl + A_OFF + (c >> 4) * A_RS + (c & 15) * 16) = sv[i]; *(LAS v4u*)(ldsl + B_OFF + (c >> 5) * B_RS + (c & 31) * 16) = vv[i]; } }
                    bf16x8 qf[4];
                    { const int q = 16 * grp + l15; const size_t tok = t0 + q;
                      const GAS bf16* qb = (const GAS bf16*)QKVG + tok * NIN + h * 128 + 8 * g; const GAS float* bq = (const GAS float*)BCUM + tok * KD + h * 128 + 8 * g; const GAS float* lq = (const GAS float*)BCUM + (t0 + 63) * KD + h * 128 + 8 * g;
                      v4u qv[4]; f32x4 b0[4], b1[4], c0[4], c1[4];
#pragma unroll
                      for (int ks = 0; ks < 4; ++ks) { qv[ks] = *(const GAS v4u*)(qb + 32 * ks); b0[ks] = *(const GAS f32x4*)(bq + 32 * ks); b1[ks] = *(const GAS f32x4*)(bq + 32 * ks + 4); c0[ks] = *(const GAS f32x4*)(lq + 32 * ks); c1[ks] = *(const GAS f32x4*)(lq + 32 * ks + 4); }
                      const float lm = q >= 64 ? 1.0f : 0.0f;
#pragma unroll
                      for (int ks = 0; ks < 4; ++ks) { float r[8];
#pragma unroll
                          for (int e = 0; e < 8; ++e) { const float qq = (e & 1) ? bfhi(qv[ks][e >> 1]) : bflo(qv[ks][e >> 1]); r[e] = qq * __expf(e < 4 ? b0[ks][e] + lm * c0[ks][e] : b1[ks][e - 4] + lm * c1[ks][e - 4]); }
                          v4u o; o.x = pk2(r[0], r[1]); o.y = pk2(r[2], r[3]); o.z = pk2(r[4], r[5]); o.w = pk2(r[6], r[7]);
                          qf[ks] = __builtin_bit_cast(bf16x8, o); } }
                    __syncthreads();
                    f32x4 acc[16];
#pragma unroll
                    for (int vt = 0; vt < 16; ++vt) acc[vt] = (f32x4){0.f, 0.f, 0.f, 0.f};
#pragma unroll
                    for (int vt = 0; vt < 16; ++vt)
#pragma unroll
                        for (int ks = 0; ks < 4; ++ks) { const bf16x8 a = *(const LAS bf16x8*)(ldsl + A_OFF + (16 * vt + l15) * A_RS + (32 * ks + 8 * g) * 2);
                            acc[vt] = __builtin_amdgcn_mfma_f32_16x16x32_bf16(a, qf[ks], acc[vt], 0, 0, 0); }
                    __syncthreads();
                    { const int k8 = (tid & 15) * 8; const GAS float* bcb = (const GAS float*)BCUM + t0 * KD + h * 128 + k8; const GAS bf16* kb = (const GAS bf16*)QKVG + t0 * NIN + 512 + h * 128 + k8;
                      const f32x4 l0a = *(const GAS f32x4*)(bcb + 63 * KD), l0b = *(const GAS f32x4*)(bcb + 63 * KD + 4);
                      v4u kv[4]; f32x4 b0[4], b1[4];
#pragma unroll
                      for (int i = 0; i < 4; ++i) { const int t = (tid >> 4) + 32 * i; kv[i] = *(const GAS v4u*)(kb + (size_t)t * NIN); b0[i] = *(const GAS f32x4*)(bcb + (size_t)t * KD); b1[i] = *(const GAS f32x4*)(bcb + (size_t)t * KD + 4); }
#pragma unroll
                      for (int i = 0; i < 4; ++i) { const int t = (tid >> 4) + 32 * i; float r[8];
#pragma unroll
                          for (int e = 0; e < 8; ++e) { const float kk = (e & 1) ? bfhi(kv[i][e >> 1]) : bflo(kv[i][e >> 1]); const float bc = (e < 4 ? b0[i][e] : b1[i][e - 4]) + (t >= 64 ? (e < 4 ? l0a[e] : l0b[e - 4]) : 0.f); r[e] = kk * __expf(-bc); }
                          v4u o; o.x = pk2(r[0], r[1]); o.y = pk2(r[2], r[3]); o.z = pk2(r[4], r[5]); o.w = pk2(r[6], r[7]);
                          *(LAS v4u*)(ldsl + A_OFF + t * A_RS + k8 * 2) = o; } }
                    __syncthreads();
                    const int nsteps = (grp >> 1) + 1;
                    for (int s = 0; s < nsteps; ++s) {
                        f32x4 pt[2];
#pragma unroll
                        for (int tt = 0; tt < 2; ++tt) { pt[tt] = (f32x4){0.f, 0.f, 0.f, 0.f};
#pragma unroll
                            for (int ks = 0; ks < 4; ++ks) { const bf16x8 a = *(const LAS bf16x8*)(ldsl + A_OFF + (32 * s + 16 * tt + l15) * A_RS + (32 * ks + 8 * g) * 2);
                                pt[tt] = __builtin_amdgcn_mfma_f32_16x16x32_bf16(a, qf[ks], pt[tt], 0, 0, 0); }
#pragma unroll
                            for (int r = 0; r < 4; ++r) { const int j = 32 * s + 16 * tt + 4 * g + r; if (j > 16 * grp + l15) pt[tt][r] = 0.f; } }
                        v4u pw; pw.x = pk2(pt[0][0], pt[0][1]); pw.y = pk2(pt[0][2], pt[0][3]); pw.z = pk2(pt[1][0], pt[1][1]); pw.w = pk2(pt[1][2], pt[1][3]);
                        const bf16x8 pf = __builtin_bit_cast(bf16x8, pw);
#pragma unroll
                        for (int vt = 0; vt < 16; ++vt) { const LAS unsigned char* vp = ldsl + B_OFF + (32 * s + 4 * g + q4) * B_RS + (16 * vt + 4 * p4) * 2; const s16x4 lo = tr_read(vp), hi = tr_read(vp + 16 * B_RS);
                            const bf16x8 a = (bf16x8){lo[0], lo[1], lo[2], lo[3], hi[0], hi[1], hi[2], hi[3]};
                            acc[vt] = __builtin_amdgcn_mfma_f32_16x16x32_bf16(a, pf, acc[vt], 0, 0, 0); }
                    }
                    { float ss = 0.f;
#pragma unroll
                      for (int vt = 0; vt < 16; ++vt) ss += (acc[vt][0] * acc[vt][0] + acc[vt][1] * acc[vt][1]) + (acc[vt][2] * acc[vt][2] + acc[vt][3] * acc[vt][3]);
                      ss += __shfl_xor(ss, 16); ss += __shfl_xor(ss, 32);
                      const float rs = 1.0f / sqrtf(ss * (1.0f / 256.0f) + EPS);
                      GAS bf16* gp = (GAS bf16*)QKVG + (t0 + 16 * grp + l15) * NIN + 2048 + h * 256 + 4 * g; const GAS float* gonp = (const GAS float*)a_onorm + L * 256 + 4 * g;
                      v2u gv[16];
#pragma unroll
                      for (int vt = 0; vt < 16; ++vt) gv[vt] = *(const GAS v2u*)(gp + 16 * vt);
#pragma unroll
                      for (int vt = 0; vt < 16; ++vt) { const f32x4 gon = *(const GAS f32x4*)(gonp + 16 * vt);
                          const float g0 = bflo(gv[vt].x), g1 = bfhi(gv[vt].x), g2 = bflo(gv[vt].y), g3 = bfhi(gv[vt].y);
                          const float r0 = acc[vt][0] * rs * gon[0] * (g0 / (1.0f + __expf(-g0))), r1 = acc[vt][1] * rs * gon[1] * (g1 / (1.0f + __expf(-g1)));
                          const float r2 = acc[vt][2] * rs * gon[2] * (g2 / (1.0f + __expf(-g2))), r3 = acc[vt][3] * rs * gon[3] * (g3 / (1.0f + __expf(-g3)));
                          v2u w; w.x = pk2(r0, r1); w.y = pk2(r2, r3); *(GAS v2u*)(gp + 16 * vt) = w; } }
                }
                TOC(5); if (BOTH(base + 3)) GRID_BAR();
            }
        } else {
            if (IN(base + 1)) { PHASE_IDS
                TIC(); constexpr int K_OFF = 0, V_OFF = 40960, RS = 160, BIAS_OFF = 81920;
                const int g = lane >> 4, l15 = lane & 15, q4 = l15 >> 2, p4 = lane & 3;
                LAS float* bias_s = (LAS float*)(ldsl + BIAS_OFF);
                for (int un = vcu; un < 256; un += G) {
                    const int b = un >> 6, nb = (un >> 1) & 31, kvh = un & 1; const size_t tq0 = (size_t)b * T + nb * 128;
                    __syncthreads();
                    { v4u kv[4], vv[4]; const GAS bf16* kvb = (const GAS bf16*)KVb + (tq0 - (nb == 0 ? 0 : 128)) * 256 + kvh * 64;
#pragma unroll
                      for (int i = 0; i < 4; ++i) { const int c = tid + 512 * i, j = c >> 3, d8 = (c & 7) * 8; const int jj = nb == 0 ? (j & 127) : j;
                          kv[i] = *(const GAS v4u*)(kvb + (size_t)jj * 256 + d8); vv[i] = *(const GAS v4u*)(kvb + (size_t)jj * 256 + 128 + d8); }
#pragma unroll
                      for (int i = 0; i < 4; ++i) { const int c = tid + 512 * i, j = c >> 3, d8 = (c & 7) * 8; const bool pad = nb == 0 && j < 128;
                          *(LAS v4u*)(ldsl + K_OFF + j * RS + d8 * 2) = pad ? (v4u){0u, 0u, 0u, 0u} : kv[i]; *(LAS v4u*)(ldsl + V_OFF + j * RS + d8 * 2) = pad ? (v4u){0u, 0u, 0u, 0u} : vv[i]; } }
                    for (int e = tid; e < 1024; e += 512) { const int hg = e >> 7, dist = e & 127;
                        int bk = dist; if (dist >= 16) { bk = 16 + (dist >= 19) + (dist >= 21) + (dist >= 24) + (dist >= 27) + (dist >= 31) + (dist >= 35) + (dist >= 40) + (dist >= 46) + (dist >= 52) + (dist >= 59) + (dist >= 67) + (dist >= 77) + (dist >= 87) + (dist >= 99) + (dist >= 113); }
                        bias_s[e] = rel_table[bk * 16 + kvh * 8 + hg] * LOG2E; }
                    __syncthreads();
                    const int head = kvh * 8 + wave; const float sink2 = b_sinks[jb * 16 + head] * LOG2E;
                    for (int qg = 0; qg < 8; ++qg) {
                        const int qi = 16 * qg + l15; bf16* qp = Qb + (tq0 + qi) * D + head * 64;
                        const bf16x8 qf0 = *(const bf16x8*)(qp + 8 * g), qf1 = *(const bf16x8*)(qp + 32 + 8 * g);
                        const int ts0 = qg & ~1;
                        f32x4 sc[10];
#pragma unroll
                        for (int tt = 0; tt < 10; ++tt) { const LAS unsigned char* kp = ldsl + K_OFF + (16 * (ts0 + tt) + l15) * RS + (8 * g) * 2;
                            const bf16x8 a0 = *(const LAS bf16x8*)kp, a1 = *(const LAS bf16x8*)(kp + 64);
                            sc[tt] = __builtin_amdgcn_mfma_f32_16x16x32_bf16(a0, qf0, (f32x4){0.f, 0.f, 0.f, 0.f}, 0, 0, 0);
                            sc[tt] = __builtin_amdgcn_mfma_f32_16x16x32_bf16(a1, qf1, sc[tt], 0, 0, 0); }
                        float m = sink2;
#pragma unroll
                        for (int tt = 0; tt < 10; ++tt)
#pragma unroll
                            for (int r = 0; r < 4; ++r) { const int j = 16 * (ts0 + tt) + 4 * g + r, dist = qi + 128 - j; const bool valid = (dist >= 0) && (dist < 128) && !(nb == 0 && j < 128);
                                const float s = valid ? sc[tt][r] + bias_s[wave * 128 + (dist & 127)] : -1e30f; sc[tt][r] = s; m = fmaxf(m, s); }
                        m = fmaxf(m, __shfl_xor(m, 16)); m = fmaxf(m, __shfl_xor(m, 32));
                        float l = 0.f;
#pragma unroll
                        for (int tt = 0; tt < 10; ++tt)
#pragma unroll
                            for (int r = 0; r < 4; ++r) { const float pe = __builtin_amdgcn_exp2f(sc[tt][r] - m); sc[tt][r] = pe; l += pe; }
                        l += __shfl_xor(l, 16); l += __shfl_xor(l, 32); l += __builtin_amdgcn_exp2f(sink2 - m);
                        f32x4 o[4];
#pragma unroll
                        for (int dt = 0; dt < 4; ++dt) o[dt] = (f32x4){0.f, 0.f, 0.f, 0.f};
#pragma unroll
                        for (int s5 = 0; s5 < 5; ++s5) { v4u pw; pw.x = pk2(sc[2 * s5][0], sc[2 * s5][1]); pw.y = pk2(sc[2 * s5][2], sc[2 * s5][3]); pw.z = pk2(sc[2 * s5 + 1][0], sc[2 * s5 + 1][1]); pw.w = pk2(sc[2 * s5 + 1][2], sc[2 * s5 + 1][3]);
                            const bf16x8 pf = __builtin_bit_cast(bf16x8, pw);
#pragma unroll
                            for (int dt = 0; dt < 4; ++dt) { const LAS unsigned char* vp = ldsl + V_OFF + (16 * (ts0 + 2 * s5) + 4 * g + q4) * RS + (16 * dt + 4 * p4) * 2; const s16x4 lo = tr_read(vp), hi = tr_read(vp + 16 * RS);
                                const bf16x8 a = (bf16x8){lo[0], lo[1], lo[2], lo[3], hi[0], hi[1], hi[2], hi[3]};
                                o[dt] = __builtin_amdgcn_mfma_f32_16x16x32_bf16(a, pf, o[dt], 0, 0, 0); } }
                        const float il = 1.0f / l;
#pragma unroll
                        for (int dt = 0; dt < 4; ++dt) { v2u w; w.x = pk2(o[dt][0] * il, o[dt][1] * il); w.y = pk2(o[dt][2] * il, o[dt][3] * il); *(v2u*)(qp + 16 * dt + 4 * g) = w; }
                    }
                }
                TOC(7); if (BOTH(base + 1)) GRID_BAR();
            }
        }
        if (IN(pG1)) { TIC();
            pg8::Gemm g; pg8::EpiResid E; E.hin = (L == 0) ? x : out; E.hout = out; E.hb = HB; E.ssq = ssq;
            if (gla) g = pg8::Gemm{QKVG + 2048, Wao_t + (size_t)L * D * D, M, D, D, NIN};
            else g = pg8::Gemm{Qb, Wbo_t + (size_t)jb * D * D, M, D, D, D};
            pg8::StaticOrder S; S.init(M, D, G, (int)blockIdx.x);
            pg8::gemm_phase<pg8::EpiResid, pg8::StaticOrder, false, true>(ldsl, g, S, E);
            TOC(8); if (BOTH(pG1)) GRID_BAR();
        }
        if (IN(pG1 + 1)) { TIC();
            pg8::Gemm g{HB, Wup_t + (size_t)L * FF * D, M, FF, D, D};
            pg8::EpiScale E; E.O = U; E.ldc = FF; E.O2 = nullptr; E.ldc2 = 0; E.split_col = 1 << 30; E.ssq = ssq; E.act = 1;
            pg8::StaticOrder S; S.init(M, FF, G, (int)blockIdx.x);
            pg8::gemm_phase<pg8::EpiScale, pg8::StaticOrder, true, true>(ldsl, g, S, E);
            TOC(9); if (BOTH(pG1 + 1)) GRID_BAR();
        }
        if (IN(pG1 + 2)) { TIC();
            pg8::Gemm g{U, Wdn_t + (size_t)L * D * FF, M, D, FF, FF};
            pg8::EpiResid E; E.hin = out; E.hout = out; E.hb = HB; E.ssq = ssq;
            pg8::StaticOrder S; S.init(M, D, G, (int)blockIdx.x);
            pg8::gemm_phase<pg8::EpiResid, pg8::StaticOrder, false, true>(ldsl, g, S, E);
            TOC(10); if (BOTH(pG1 + 2)) GRID_BAR();
        }
    }
    if (IN(25)) { PHASE_IDS TIC();
        const int gw = vcu * NWAVES + wave, NGW = G * NWAVES;
        for (int m = gw; m < M; m += NGW) {
            const float rs = pg8::row_rstd(ssq, m);
            GAS f32x4* hr = (GAS f32x4*)(out + (size_t)m * D) + lane; const f32x4* gr = (const f32x4*)ln_final + lane;
#pragma unroll
            for (int j = 0; j < 4; ++j) { const f32x4 v = hr[64 * j], gg = gr[64 * j]; hr[64 * j] = v * rs * gg; }
        }
    TOC(11); }
#if PROBE_SEL
    if (blockIdx.x == 0) { const unsigned long long te = __builtin_amdgcn_s_memrealtime(); while (__builtin_amdgcn_s_memrealtime() - te < pr_acc * PROBE_MUL) __builtin_amdgcn_s_sleep(8); }
#endif
#undef IN
#undef BOTH
#undef GRID_BAR
}

extern "C" void kernel_launch(void* const* d_in, const int* in_sizes, int n_in, void* d_out, int out_size, void* d_ws, size_t ws_size, hipStream_t stream) {
    static int grid = 0;
    if (grid == 0) {
        if (n_in != 17 || in_sizes[0] != M * D || out_size != M * D || ws_size < WS_END) { fprintf(stderr, "kernel_launch: unexpected shapes (n_in %d, in0 %d, out %d, ws %zu)\n", n_in, n_in > 0 ? in_sizes[0] : -1, out_size, ws_size); grid = -1; return; }
        int dev = 0, cus = 0;
        if (hipGetDevice(&dev) != hipSuccess || hipDeviceGetAttribute(&cus, hipDeviceAttributeMultiprocessorCount, dev) != hipSuccess) { grid = -1; return; }
        if (hipFuncSetAttribute((const void*)yoco_fwd, hipFuncAttributeMaxDynamicSharedMemorySize, LDS_BYTES) != hipSuccess) { fprintf(stderr, "kernel_launch: hipFuncSetAttribute failed\n"); grid = -1; return; }
        (void)hipGetLastError();
        grid = cus;
    }
    if (grid < 0) return;
    if (hipMemsetAsync((char*)d_ws + WS_CTL, 0, CTL_ZERO_BYTES, stream) != hipSuccess) return;
    Args a{};
    for (int i = 0; i < 17; ++i) a.in[i] = (const float*)d_in[i];
    a.out = (float*)d_out; a.ws = (unsigned char*)d_ws;
    if (N_LAUNCHES == 1) {
        a.ph_lo = 0; a.ph_hi = NPH; a.li = 0;
        hipLaunchKernelGGL(yoco_fwd, dim3(grid), dim3(NWAVES * 64), LDS_BYTES, stream, a);
    } else {
        for (int p = 0; p < NPH; ++p) { a.ph_lo = p; a.ph_hi = p + 1; a.li = 0;
            hipLaunchKernelGGL(yoco_fwd, dim3(grid), dim3(NWAVES * 64), LDS_BYTES, stream, a); }
    }
}
```

```cpp
#include <hip/hip_runtime.h>
#include <cstdio>
#include <cstdint>

#ifndef PROBE_SEL
#define PROBE_SEL 0
#endif
#ifndef PROBE_MUL
#define PROBE_MUL 1
#endif
#ifndef MK_N_LAUNCHES
#define MK_N_LAUNCHES 1
#endif

namespace pg8 {
#define PG8_LAS __attribute__((address_space(3)))
typedef unsigned short bf16_t;
typedef short bf16x8 __attribute__((ext_vector_type(8)));
typedef float f32x4 __attribute__((ext_vector_type(4)));
typedef unsigned u32x4 __attribute__((ext_vector_type(4)));
typedef unsigned u32x2 __attribute__((ext_vector_type(2)));
constexpr int BM = 256, BK = 64, HALF = 128, HTB = HALF * BK * 2, STAGE_BYTES = 8 * HTB, NXCD = 8, WGM = 8;

__host__ __device__ __forceinline__ int lds_byte(int r, int c) { const int st = (r >> 4) * 2 + (c >> 5), rr = r & 15, cc = c & 31, ob = rr * 64 + cc * 2; return st * 1024 + (ob ^ (((ob >> 9) & 1) << 5)); }
__host__ __device__ __forceinline__ void stage_rc(int b, int& R, int& C) { const int st = b / 1024, sb = b % 1024, swz = sb ^ (((sb >> 9) & 1) << 5); R = (st >> 1) * 16 + swz / 64; C = (st & 1) * 32 + (swz % 64) / 2; }
__host__ __device__ __forceinline__ int perm32(int rho) { const int n = rho >> 4, i = rho & 15; return 8 * (i >> 2) + 4 * n + (i & 3); }

struct Unit { int pm, pn; };
struct Gemm { const bf16_t* A; const bf16_t* Bt; int M, N, K, lda; };

struct StaticOrder {
    int nM, nN, nwg, G, c;
    __host__ __device__ void init(int M, int N, int G_, int c_) { nM = M / BM; nN = N / BM; nwg = nM * nN; G = G_; c = c_; }
    __host__ __device__ bool next(int i, Unit& u) const {
        const long L = (long)i * G + c; if (L >= nwg) return false;
        int wgid = (int)L; { const int q = nwg / NXCD, r = nwg % NXCD, xcd = wgid % NXCD, off = wgid / NXCD; wgid = (xcd < r ? xcd * (q + 1) : r * (q + 1) + (xcd - r) * q) + off; }
        const int nig = WGM * nN, gid = wgid / nig, fm = gid * WGM, gsz = (nM - fm) < WGM ? (nM - fm) : WGM;
        u.pm = fm + ((wgid % nig) % gsz); u.pn = (wgid % nig) / gsz; return true;
    }
    __device__ __forceinline__ void a_ready(const Unit&) const {}
    __device__ __forceinline__ void done(const Unit&) const {}
};

__device__ __forceinline__ unsigned cvt_pk_bf16(float lo, float hi) { unsigned r; asm volatile("v_cvt_pk_bf16_f32 %0, %1, %2" : "=v"(r) : "v"(lo), "v"(hi)); return r; }

constexpr int MROWS = 16384;
__device__ __forceinline__ float row_rstd(const float* ssq, int row) { const float s = (ssq[row] + ssq[MROWS + row]) + (ssq[2 * MROWS + row] + ssq[3 * MROWS + row]); return 1.0f / sqrtf(s * (1.0f / 1024.0f) + 1e-6f); }

struct EpiScale {
    static constexpr bool PERM = true, AFTER_DRAIN = false;
    bf16_t* O; int ldc; bf16_t* O2; int ldc2; int split_col; const float* ssq; int act;
    __device__ __forceinline__ void operator()(const f32x4 (&acc)[2][2][4][2], const Unit& u, int wr, int wc, int fr, int fq) const {
        const int row0 = u.pm * BM + wr * 64 + fr; int colt = u.pn * BM; bf16_t* base = O; int ld = ldc;
        if (colt >= split_col) { base = O2; colt -= split_col; ld = ldc2; }
        const int col0 = colt + wc * 32 + 8 * fq;
        const __amdgpu_buffer_rsrc_t rsrc = __builtin_amdgcn_make_buffer_rsrc((void*)base, 0, 0x7fffffff, 0x00020000);
        float rs[2][4]; f32x4 sq[2][4];
#pragma unroll
        for (int ai = 0; ai < 2; ++ai)
#pragma unroll
            for (int m = 0; m < 4; ++m) { const int row = row0 + ai * HALF + m * 16; sq[ai][m] = (f32x4){ssq[row], ssq[MROWS + row], ssq[2 * MROWS + row], ssq[3 * MROWS + row]}; }
#pragma unroll
        for (int ai = 0; ai < 2; ++ai)
#pragma unroll
            for (int m = 0; m < 4; ++m) rs[ai][m] = 1.0f / sqrtf(((sq[ai][m][0] + sq[ai][m][1]) + (sq[ai][m][2] + sq[ai][m][3])) * (1.0f / 1024.0f) + 1e-6f);
#pragma unroll
        for (int ai = 0; ai < 2; ++ai)
#pragma unroll
            for (int m = 0; m < 4; ++m) { const int row = row0 + ai * HALF + m * 16; const float r = rs[ai][m]; const unsigned boff = (unsigned)(row * ld + col0) * 2u;
#pragma unroll
                for (int bj = 0; bj < 2; ++bj) { f32x4 v0 = acc[ai][bj][m][0] * r, v1 = acc[ai][bj][m][1] * r;
                    if (act == 1) {
#pragma unroll
                        for (int e = 0; e < 4; ++e) { float a = fmaxf(v0[e], 0.f); v0[e] = a * a; float b = fmaxf(v1[e], 0.f); v1[e] = b * b; } }
                    u32x4 w; w.x = cvt_pk_bf16(v0[0], v0[1]); w.y = cvt_pk_bf16(v0[2], v0[3]); w.z = cvt_pk_bf16(v1[0], v1[1]); w.w = cvt_pk_bf16(v1[2], v1[3]);
                    __builtin_amdgcn_raw_buffer_store_b128(w, rsrc, boff + bj * HALF * 2, 0, 16); } }
    }
};

struct EpiResid {
    static constexpr bool PERM = false, AFTER_DRAIN = true;
    bf16_t* hb; float* ssq;
    __device__ __forceinline__ void fused(const f32x4 (&acc)[2][2][4][2], const Unit& u, int wr, int wc, int fr, int fq, PG8_LAS unsigned char* lds, int tid) const {
        PG8_LAS float* P = (PG8_LAS float*)lds;
        const int row0 = u.pm * BM + wr * 64 + fr, col0 = u.pn * BM + wc * 32 + 4 * fq;
        const __amdgpu_buffer_rsrc_t rsrc = __builtin_amdgcn_make_buffer_rsrc((void*)hb, 0, 0x7fffffff, 0x00020000);
        u32x2 hv[2][4][2][2];
#pragma unroll
        for (int ai = 0; ai < 2; ++ai)
#pragma unroll
            for (int m = 0; m < 4; ++m)
#pragma unroll
                for (int bj = 0; bj < 2; ++bj)
#pragma unroll
                    for (int n = 0; n < 2; ++n) hv[ai][m][bj][n] = *(const u32x2*)(hb + (size_t)(row0 + ai * HALF + m * 16) * 1024 + col0 + bj * HALF + n * 16);
        asm volatile("" ::: "memory");
#pragma unroll
        for (int ai = 0; ai < 2; ++ai)
#pragma unroll
            for (int m = 0; m < 4; ++m) { const int row = row0 + ai * HALF + m * 16; const unsigned off = (unsigned)(row * 1024 + col0) * 2u; float ss = 0.f;
#pragma unroll
                for (int bj = 0; bj < 2; ++bj)
#pragma unroll
                    for (int n = 0; n < 2; ++n) { const u32x2 h2 = hv[ai][m][bj][n]; const f32x4 a = acc[ai][bj][m][n];
                        u32x2 w; w.x = cvt_pk_bf16(__builtin_bit_cast(float, h2.x << 16) + a[0], __builtin_bit_cast(float, h2.x & 0xffff0000u) + a[1]);
                        w.y = cvt_pk_bf16(__builtin_bit_cast(float, h2.y << 16) + a[2], __builtin_bit_cast(float, h2.y & 0xffff0000u) + a[3]);
                        __builtin_amdgcn_raw_buffer_store_b64(w, rsrc, off + (bj * HALF + n * 16) * 2, 0, 16);
                        const float r0 = __builtin_bit_cast(float, w.x << 16), r1 = __builtin_bit_cast(float, w.x & 0xffff0000u), r2 = __builtin_bit_cast(float, w.y << 16), r3 = __builtin_bit_cast(float, w.y & 0xffff0000u);
                        ss += (r0 * r0 + r1 * r1) + (r2 * r2 + r3 * r3); }
                ss += __shfl_xor(ss, 16); ss += __shfl_xor(ss, 32);
                if (fq == 0) P[(ai * HALF + wr * 64 + m * 16 + fr) * 4 + wc] = ss; }
        asm volatile("s_waitcnt lgkmcnt(0)" ::: "memory"); __builtin_amdgcn_s_barrier(); asm volatile("" ::: "memory");
        if (tid < 256) { const PG8_LAS f32x4* p4 = (const PG8_LAS f32x4*)P + tid; const f32x4 v = *p4; ssq[(size_t)u.pn * MROWS + u.pm * BM + tid] = (v[0] + v[1]) + (v[2] + v[3]); }
    }
};

template <class Epi, class Sched, bool ALIGN_EPI = false, bool SP2 = false>
__device__ __forceinline__ void gemm_phase(PG8_LAS unsigned char* lds, const Gemm g, const Sched& S, const Epi& E) {
    int tid_ = threadIdx.x; asm volatile("" : "+v"(tid_)); const int tid = tid_, wid = __builtin_amdgcn_readfirstlane(tid >> 6), lane = tid & 63, wr = wid >> 2, wc = wid & 3, fr = lane & 15, fq = lane >> 4;
    const int K = g.K, nt = K / BK, lda = g.lda;
    unsigned voffA[2], voffB[2];
#pragma unroll
    for (int i = 0; i < 2; ++i) { int R, C; stage_rc(tid * 16 + i * 8192, R, C); const int Rb = Epi::PERM ? ((R & ~31) + perm32(R & 31)) : R;
        voffA[i] = (unsigned)(R * lda + C) * 2u; voffB[i] = (unsigned)(Rb * K + C) * 2u; }
    const size_t kstep = (size_t)(BK * 2);
    const size_t hstepA = (size_t)HALF * lda * 2, hstepB = (size_t)HALF * K * 2;
    const size_t tstepA = 2 * hstepA, tstepB = 2 * hstepB;
    const unsigned ldsw = (unsigned)wid * 1024u;
    const int aoff = lds_byte(wr * 64 + fr, fq * 8), boff = lds_byte(wc * 32 + fr, fq * 8);
#define PG8_SA(b, h) (((b) * 2 + (h)) * HTB)
#define PG8_SB(b, h) ((4 + (b) * 2 + (h)) * HTB)
#define PG8_STAGE(bufoff, gbase, voff) do { _Pragma("unroll") for (int _i = 0; _i < 2; ++_i) \
        __builtin_amdgcn_global_load_lds((const unsigned*)((const char*)(gbase) + (voff)[_i]), (PG8_LAS unsigned*)(lds + (bufoff) + ldsw + _i * 8192), 16, 0, 0); } while (0)
#define PG8_LDA(dst, b, h) do { _Pragma("unroll") for (int m = 0; m < 4; ++m) _Pragma("unroll") for (int k = 0; k < 2; ++k) dst[m][k] = *(const PG8_LAS bf16x8*)(lds + PG8_SA(b, h) + aoff + m * 2048 + k * 1024); } while (0)
#define PG8_LDB(dst, b, h) do { _Pragma("unroll") for (int n = 0; n < 2; ++n) _Pragma("unroll") for (int k = 0; k < 2; ++k) dst[n][k] = *(const PG8_LAS bf16x8*)(lds + PG8_SB(b, h) + boff + n * 2048 + k * 1024); } while (0)
#define PG8_MMA(ai, bj, At, Bt) do { __builtin_amdgcn_s_setprio(1); _Pragma("unroll") for (int m = 0; m < 4; ++m) _Pragma("unroll") for (int n = 0; n < 2; ++n) _Pragma("unroll") for (int k = 0; k < 2; ++k) \
        acc[ai][bj][m][n] = __builtin_amdgcn_mfma_f32_16x16x32_bf16(Bt[n][k], At[m][k], acc[ai][bj][m][n], 0, 0, 0); __builtin_amdgcn_s_setprio(0); } while (0)
#define PG8_WAIT_V(n) asm volatile("s_waitcnt vmcnt(" #n ")" ::: "memory")
#define PG8_WAIT_L(n) asm volatile("s_waitcnt lgkmcnt(" #n ")" ::: "memory")
#define PG8_BAR __builtin_amdgcn_s_barrier()
#define PG8_SCHED __builtin_amdgcn_sched_barrier(0)
    Unit cur, nxt; int ui = 0;
    if (!S.next(0, cur)) return;
    f32x4 acc[2][2][4][2];
#pragma unroll
    for (int a = 0; a < 2; ++a)
#pragma unroll
        for (int b = 0; b < 2; ++b)
#pragma unroll
            for (int m = 0; m < 4; ++m)
#pragma unroll
                for (int n = 0; n < 2; ++n) acc[a][b][m][n] = (f32x4){0.f, 0.f, 0.f, 0.f};
    bf16x8 At[4][2], B0[2][2], B1[2][2];
    const char* cA = (const char*)g.A + (size_t)cur.pm * tstepA; const char* cB = (const char*)g.Bt + (size_t)cur.pn * tstepB;
    S.a_ready(cur);
    if constexpr (SP2) {
        PG8_STAGE(PG8_SB(0, 0), cB, voffB); PG8_STAGE(PG8_SB(0, 1), cB + hstepB, voffB); PG8_STAGE(PG8_SA(0, 0), cA, voffA); PG8_STAGE(PG8_SA(0, 1), cA + hstepA, voffA);
        if (wr == 1) PG8_BAR;
        PG8_WAIT_V(2); PG8_BAR;
        PG8_STAGE(PG8_SB(1, 0), cB + kstep, voffB); PG8_STAGE(PG8_SA(1, 0), cA + kstep, voffA); PG8_STAGE(PG8_SB(1, 1), cB + hstepB + kstep, voffB);
        PG8_WAIT_V(6); PG8_BAR;
    } else {
        PG8_STAGE(PG8_SB(0, 0), cB, voffB); PG8_STAGE(PG8_SA(0, 0), cA, voffA); PG8_STAGE(PG8_SB(0, 1), cB + hstepB, voffB); PG8_STAGE(PG8_SA(0, 1), cA + hstepA, voffA);
        if (wr == 1) PG8_BAR;
        PG8_WAIT_V(4); PG8_BAR;
        PG8_STAGE(PG8_SB(1, 0), cB + kstep, voffB); PG8_STAGE(PG8_SA(1, 0), cA + kstep, voffA); PG8_STAGE(PG8_SB(1, 1), cB + hstepB + kstep, voffB);
        PG8_WAIT_V(6); PG8_BAR;
    }
    for (;;) {
        const bool has_next = S.next(ui + 1, nxt);
        const char* nA = has_next ? (const char*)g.A + (size_t)nxt.pm * tstepA : cA; const char* nB = has_next ? (const char*)g.Bt + (size_t)nxt.pn * tstepB : cB;
        for (int t = 0; t < nt; t += 2) {
            const bool last = (t == nt - 2);
            const char* a1 = cA + (size_t)(t + 1) * kstep;
            const char* a2 = last ? nA : cA + (size_t)(t + 2) * kstep; const char* b2 = last ? nB : cB + (size_t)(t + 2) * kstep;
            const char* a3 = a2 + kstep; const char* b3 = b2 + kstep;
            if (last && has_next) S.a_ready(nxt);
            if constexpr (SP2) {
            PG8_LDB(B0, 0, 0); PG8_LDB(B1, 0, 1); PG8_SCHED; PG8_LDA(At, 0, 0); PG8_STAGE(PG8_SA(1, 1), a1 + hstepA, voffA);
            PG8_WAIT_V(8); PG8_WAIT_L(0); PG8_BAR; PG8_MMA(0, 0, At, B0); PG8_MMA(0, 1, At, B1); PG8_BAR; PG8_SCHED;
            PG8_LDA(At, 0, 1); PG8_STAGE(PG8_SB(0, 0), b2, voffB); PG8_STAGE(PG8_SB(0, 1), b2 + hstepB, voffB); PG8_STAGE(PG8_SA(0, 0), a2, voffA);
            PG8_WAIT_V(8); PG8_WAIT_L(0); PG8_BAR; PG8_MMA(1, 0, At, B0); PG8_MMA(1, 1, At, B1); PG8_BAR; PG8_SCHED;
            PG8_LDB(B0, 1, 0); PG8_LDB(B1, 1, 1); PG8_SCHED; PG8_LDA(At, 1, 0); PG8_STAGE(PG8_SA(0, 1), a2 + hstepA, voffA);
            PG8_WAIT_V(8); PG8_WAIT_L(0); PG8_BAR; PG8_MMA(0, 0, At, B0); PG8_MMA(0, 1, At, B1); PG8_BAR; PG8_SCHED;
            PG8_LDA(At, 1, 1); PG8_STAGE(PG8_SB(1, 0), b3, voffB); PG8_STAGE(PG8_SB(1, 1), b3 + hstepB, voffB); PG8_STAGE(PG8_SA(1, 0), a3, voffA);
            PG8_WAIT_V(8); PG8_WAIT_L(0); PG8_BAR; PG8_MMA(1, 0, At, B0); PG8_MMA(1, 1, At, B1); PG8_BAR; PG8_SCHED;
            } else {
            PG8_LDB(B0, 0, 0); PG8_SCHED; PG8_LDA(At, 0, 0); PG8_STAGE(PG8_SA(1, 1), a1 + hstepA, voffA);
            PG8_WAIT_L(8); PG8_BAR; PG8_WAIT_L(0); PG8_MMA(0, 0, At, B0); PG8_BAR; PG8_SCHED;
            PG8_LDB(B1, 0, 1); PG8_STAGE(PG8_SB(0, 0), b2, voffB);
            PG8_BAR; PG8_WAIT_L(0); PG8_MMA(0, 1, At, B1); PG8_BAR;
            PG8_LDA(At, 0, 1); PG8_STAGE(PG8_SA(0, 0), a2, voffA);
            PG8_BAR; PG8_WAIT_L(0); PG8_MMA(1, 0, At, B0); PG8_BAR; PG8_SCHED;
            PG8_STAGE(PG8_SB(0, 1), b2 + hstepB, voffB);
            PG8_WAIT_V(6); PG8_BAR; PG8_MMA(1, 1, At, B1); PG8_BAR;
            PG8_LDB(B0, 1, 0); PG8_SCHED; PG8_LDA(At, 1, 0); PG8_STAGE(PG8_SA(0, 1), a2 + hstepA, voffA);
            PG8_WAIT_L(8); PG8_BAR; PG8_WAIT_L(0); PG8_MMA(0, 0, At, B0); PG8_BAR; PG8_SCHED;
            PG8_LDB(B1, 1, 1); PG8_STAGE(PG8_SB(1, 0), b3, voffB);
            PG8_BAR; PG8_WAIT_L(0); PG8_MMA(0, 1, At, B1); PG8_BAR;
            PG8_LDA(At, 1, 1); PG8_STAGE(PG8_SA(1, 0), a3, voffA);
            PG8_BAR; PG8_WAIT_L(0); PG8_MMA(1, 0, At, B0); PG8_BAR; PG8_SCHED;
            PG8_STAGE(PG8_SB(1, 1), b3 + hstepB, voffB);
            PG8_WAIT_V(6); PG8_BAR; PG8_MMA(1, 1, At, B1); PG8_BAR;
            }
        }
        if constexpr (ALIGN_EPI) { if (wr == 0) PG8_BAR; }
        if constexpr (!Epi::AFTER_DRAIN) { E(acc, cur, wr, wc, fr, fq); S.done(cur); }
        if (!has_next) break;
#pragma unroll
        for (int a = 0; a < 2; ++a)
#pragma unroll
            for (int b = 0; b < 2; ++b)
#pragma unroll
                for (int m = 0; m < 4; ++m)
#pragma unroll
                    for (int n = 0; n < 2; ++n) acc[a][b][m][n] = (f32x4){0.f, 0.f, 0.f, 0.f};
        cur = nxt; cA = nA; cB = nB; ++ui;
        if constexpr (ALIGN_EPI) { if (wr == 1) PG8_BAR; }
    }
    PG8_WAIT_V(0);
    if constexpr (!ALIGN_EPI) { if (wr == 0) PG8_BAR; }
    PG8_BAR;
    if constexpr (Epi::AFTER_DRAIN) { E.fused(acc, cur, wr, wc, fr, fq, lds, tid); S.done(cur); }
#undef PG8_SA
#undef PG8_SB
#undef PG8_STAGE
#undef PG8_LDA
#undef PG8_LDB
#undef PG8_MMA
#undef PG8_WAIT_V
#undef PG8_WAIT_L
#undef PG8_BAR
#undef PG8_SCHED
}
}

constexpr int NWAVES = 8;
constexpr int N_LAUNCHES = MK_N_LAUNCHES;
constexpr int NPH = 26;
constexpr int M = 16384, D = 1024, T = 4096, FF = 4096, NIN = 3072, APROJ = 3088, KD = 512;
constexpr float EPS = 1e-6f, LOG2E = 1.4426950408889634f;

constexpr size_t MiB = 1u << 20;
constexpr size_t WS_CTL = 0, CTL_ZERO_BYTES = 1 * MiB;
constexpr size_t WS_SSQ = 1 * MiB;
constexpr size_t WS_WG = 2 * MiB;
constexpr size_t WS_BEND = 2 * MiB + 65536;
constexpr size_t WS_WIN = 3 * MiB;
constexpr size_t WS_KV = 3 * MiB;
constexpr size_t WS_WAO = 15 * MiB;
constexpr size_t WS_WUP = 19 * MiB;
constexpr size_t WS_WDN = 51 * MiB;
constexpr size_t WS_WQ = 83 * MiB;
constexpr size_t WS_WQ1 = WS_WQ + (size_t)1280 * 1024 * 2;
constexpr size_t WS_WBO = 88 * MiB;
constexpr size_t WS_HB = 92 * MiB;
constexpr size_t WS_U = 124 * MiB;
constexpr size_t WS_BCUM = WS_U + 96 * MiB;
constexpr size_t WS_END = 252 * MiB;
constexpr int CW_BAR = 4096;

constexpr int LDS_BYTES = 147456;
constexpr int RING_BYTES = 131072, LDSCTL_OFF = 143360, MISC_OFF = LDSCTL_OFF + 320;

#define GAS __attribute__((address_space(1)))
#define LAS __attribute__((address_space(3)))
typedef unsigned short bf16;
typedef unsigned v4u __attribute__((ext_vector_type(4)));
typedef unsigned v2u __attribute__((ext_vector_type(2)));
typedef float f32x4 __attribute__((ext_vector_type(4)));
typedef GAS unsigned gu32;
typedef short bf16x8 __attribute__((ext_vector_type(8)));
typedef short s16x4 __attribute__((ext_vector_type(4)));
__device__ __forceinline__ s16x4 tr_read(const LAS unsigned char* p) { return __builtin_bit_cast(s16x4, __builtin_amdgcn_ds_read_tr16_b64_v4i16((LAS s16x4*)p)); }
#define RLX_AGENT __ATOMIC_RELAXED, __HIP_MEMORY_SCOPE_AGENT
#define LDS_WAIT() asm volatile("s_waitcnt lgkmcnt(0)" ::: "memory")
#define VM_WAIT() asm volatile("s_waitcnt vmcnt(0)" ::: "memory")
__device__ __forceinline__ unsigned f2bf(float f) { unsigned u = __builtin_bit_cast(unsigned, f); return (u + 0x7fffu + ((u >> 16) & 1u)) >> 16; }
__device__ __forceinline__ unsigned pk2(float lo, float hi) { return f2bf(lo) | (f2bf(hi) << 16); }
__device__ __forceinline__ float bf2f(unsigned short b) { return __builtin_bit_cast(float, (unsigned)b << 16); }
__device__ __forceinline__ float bflo(unsigned w) { return __builtin_bit_cast(float, w << 16); }
__device__ __forceinline__ float bfhi(unsigned w) { return __builtin_bit_cast(float, w & 0xffff0000u); }

#define XB_TMO      128
#define XB_XCNT(j)  (256  + 64 * (j))
#define XB_XSUB(j)  (1280 + 64 * (j))
#define XB_XGEN(j)  (2304 + 64 * (j))
#define XB_TOP      3328
#define XB_TOPGEN   3392
#define XCD_BAR_WORDS 3456
#define XB_SPIN_CAP (1u << 18)
__device__ __forceinline__ unsigned xb_ld(unsigned* p)              { return __hip_atomic_load(p, __ATOMIC_RELAXED, __HIP_MEMORY_SCOPE_AGENT); }
__device__ __forceinline__ unsigned xb_add(unsigned* p, unsigned v) { return __hip_atomic_fetch_add(p, v, __ATOMIC_RELAXED, __HIP_MEMORY_SCOPE_AGENT); }
__device__ __forceinline__ unsigned xb_xcc_id() { return (unsigned)__builtin_amdgcn_s_getreg((3 << 11) | 20) & 0xFu; }
#define XB_SPIN(cond, bar) do { unsigned _sp = 0; while (cond) { __builtin_amdgcn_s_sleep(1); \
    if ((++_sp & 255u) == 0u) { if (xb_ld(&(bar)[XB_TMO])) break; if (_sp > XB_SPIN_CAP) { atomicAdd(&(bar)[XB_TMO], 1u); break; } } } } while (0)
struct XcdBarrier { unsigned* bar; unsigned x; volatile LAS unsigned* st; };
__device__ __forceinline__ XcdBarrier xcd_barrier_post(unsigned* bar, volatile LAS unsigned* st) {
    XcdBarrier b; b.bar = bar; b.x = xb_xcc_id(); b.st = st;
    if (threadIdx.x == 0) (void)xb_add(&bar[XB_XCNT(b.x)], 1u);
    return b;
}
__device__ __forceinline__ void xcd_barrier_complete(unsigned* bar, unsigned x, unsigned& nloc, unsigned& nx) {
    const unsigned G = gridDim.x * gridDim.y * gridDim.z;
    unsigned sum, cnt, mine, sp = 0u;
    for (;;) {
        sum = 0u; cnt = 0u; mine = 0u;
#pragma unroll
        for (unsigned j = 0; j < 16; ++j) { const unsigned c = xb_ld(&bar[XB_XCNT(j)]); sum += c; cnt += (c > 0u) ? 1u : 0u; mine = (j == x) ? c : mine; }
        if (sum == G) break;
        __builtin_amdgcn_s_sleep(1);
        if ((++sp & 255u) == 0u) { if (xb_ld(&bar[XB_TMO])) break; if (sp > XB_SPIN_CAP) { atomicAdd(&bar[XB_TMO], 1u); break; } }
    }
    nloc = mine > 0u ? mine : 1u; nx = cnt > 0u ? cnt : 1u;
}
__device__ __forceinline__ void xcd_barrier(const XcdBarrier& b) {
    asm volatile("s_waitcnt vmcnt(0)" ::: "memory");
    __syncthreads();
    if (threadIdx.x == 0) {
        unsigned* bar = b.bar;
        __builtin_amdgcn_s_waitcnt(0);
        unsigned nloc = b.st[0], nx = b.st[1];
        if (nloc == 0u) { xcd_barrier_complete(bar, b.x, nloc, nx); b.st[0] = nloc; b.st[1] = nx; }
        const unsigned old = xb_add(&bar[XB_XSUB(b.x)], 1u);
        const unsigned gen = old / nloc;
        if (old + 1u == (gen + 1u) * nloc) {
            __builtin_amdgcn_fence(__ATOMIC_RELEASE, "agent");
            asm volatile("s_waitcnt vmcnt(0)" ::: "memory");
            const unsigned og = xb_add(&bar[XB_TOP], 1u);
            const unsigned tg = og / nx;
            if (og + 1u == (tg + 1u) * nx) xb_add(&bar[XB_TOPGEN], 1u);
            else XB_SPIN(xb_ld(&bar[XB_TOPGEN]) == tg, bar);
            __builtin_amdgcn_fence(__ATOMIC_ACQUIRE, "agent");
            xb_add(&bar[XB_XGEN(b.x)], 1u);
            asm volatile("s_waitcnt vmcnt(0)" ::: "memory");
        } else {
            XB_SPIN(xb_ld(&bar[XB_XGEN(b.x)]) == gen, bar);
            __builtin_amdgcn_fence(__ATOMIC_ACQUIRE, "agent");
            asm volatile("s_waitcnt vmcnt(0)" ::: "memory");
        }
    }
    __syncthreads();
}

__device__ __forceinline__ float wave_sum(float v) {
#pragma unroll
    for (int o = 1; o < 64; o <<= 1) v += __shfl_xor(v, o);
    return v;
}

struct P0Item { const float* W; int ldw, K, nblk; bf16* WT; const float* gain; float scale; int nscale, item; };
__device__ __forceinline__ void p0_load(const P0Item& d, int lane, f32x4 (&v)[8], float (&gn)[8]) {
    const GAS float* W = (const GAS float*)d.W;
    const int kb = d.item / d.nblk, nb = d.item % d.nblk, k0 = 64 * kb, n0 = 32 * nb, n4 = (lane & 7) * 4, kr = lane >> 3;
#pragma unroll
    for (int i = 0; i < 8; ++i) { v[i] = *(const GAS f32x4*)(W + (size_t)(k0 + kr + 8 * i) * d.ldw + n0 + n4); gn[i] = d.gain ? d.gain[k0 + kr + 8 * i] : 1.0f; }
}
__device__ __forceinline__ void p0_finish(const P0Item& d, int lane, const f32x4 (&v)[8], const float (&gn)[8], LAS float* scr) {
    const int kb = d.item / d.nblk, nb = d.item % d.nblk, k0 = 64 * kb, n0 = 32 * nb, n4 = (lane & 7) * 4, kr = lane >> 3;
    const float sc = (n0 + n4) < d.nscale ? d.scale : 1.0f;
#pragma unroll
    for (int i = 0; i < 8; ++i) { const float m = gn[i] * sc; LAS float* p = scr + (kr + 8 * i) * 33 + n4; p[0] = v[i][0] * m; p[1] = v[i][1] * m; p[2] = v[i][2] * m; p[3] = v[i][3] * m; }
    LDS_WAIT(); asm volatile("" ::: "memory");
    const int c = lane & 7;
#pragma unroll
    for (int j = 0; j < 4; ++j) { const int n = (lane >> 3) + 8 * j; const LAS float* s = scr + (8 * c) * 33 + n;
        v4u o; o.x = pk2(s[0 * 33], s[1 * 33]); o.y = pk2(s[2 * 33], s[3 * 33]); o.z = pk2(s[4 * 33], s[5 * 33]); o.w = pk2(s[6 * 33], s[7 * 33]);
        *(GAS v4u*)(d.WT + (size_t)(n0 + n) * d.K + k0 + 8 * c) = o; }
    LDS_WAIT(); asm volatile("" ::: "memory");
}

struct Args { const float* in[17]; float* out; unsigned char* ws; int ph_lo, ph_hi, li, pad; };

__device__ __forceinline__ float logsigmoidf(float z) { return fminf(z, 0.f) - log1pf(__expf(-fabsf(z))); }

__global__ void __launch_bounds__(NWAVES * 64, 2) yoco_fwd(Args args) {
    extern __shared__ __attribute__((aligned(16))) unsigned char lds[];
    LAS unsigned char* ldsl = (LAS unsigned char*)lds;
    volatile LAS unsigned* MISC = (volatile LAS unsigned*)(ldsl + MISC_OFF);
    const int tid0 = threadIdx.x, lane0 = tid0 & 63, wave0 = __builtin_amdgcn_readfirstlane(tid0 >> 6);
#define PHASE_IDS int tid = threadIdx.x; asm volatile("" : "+v"(tid)); const int lane = tid & 63, wave = __builtin_amdgcn_readfirstlane(tid >> 6); (void)lane; (void)wave;
    const int G = gridDim.x; const int bx = blockIdx.x; const int vcu = (G % 8 == 0) ? (bx % 8) * (G / 8) + bx / 8 : bx;
    unsigned char* ws = args.ws;
    gu32* ctl = (gu32*)(ws + WS_CTL);
    const float* x = args.in[0]; const float* a_w_in = args.in[1]; const float* a_w_gk2 = args.in[2]; const float* a_b_gk = args.in[3]; const float* a_onorm = args.in[4];
    const float* a_w_out = args.in[5]; const float* kv_norm = args.in[6]; const float* w_kv = args.in[7]; const float* b_w_q = args.in[8]; const float* b_sinks = args.in[9];
    const float* b_w_out = args.in[10]; const float* rel_table = args.in[11]; const float* ln_mix = args.in[12]; const float* ln_mlp = args.in[13];
    const float* w_up = args.in[14]; const float* w_down = args.in[15]; const float* ln_final = args.in[16];
    float* out = args.out;
    float* ssq = (float*)(ws + WS_SSQ);
    bf16* Wg_t = (bf16*)(ws + WS_WG); float* BendG = (float*)(ws + WS_BEND);
    bf16* Win_t = (bf16*)(ws + WS_WIN); bf16* KVb = (bf16*)(ws + WS_KV); bf16* Wao_t = (bf16*)(ws + WS_WAO); bf16* Wup_t = (bf16*)(ws + WS_WUP); bf16* Wdn_t = (bf16*)(ws + WS_WDN);
    bf16* Wq0_t = (bf16*)(ws + WS_WQ); bf16* Wq1_t = (bf16*)(ws + WS_WQ1); bf16* Wbo_t = (bf16*)(ws + WS_WBO);
    bf16* HB = (bf16*)(ws + WS_HB); bf16* Sst = (bf16*)out;
    bf16* U = (bf16*)(ws + WS_U); bf16* QKVG = (bf16*)(ws + WS_U); bf16* Qb = (bf16*)(ws + WS_U); float* BCUM = (float*)(ws + WS_BCUM);

    for (int u = tid0; u < (LDS_BYTES - LDSCTL_OFF) / 4; u += NWAVES * 64) ((LAS unsigned*)(ldsl + LDSCTL_OFF))[u] = 0u;
    __syncthreads();
    XcdBarrier bar; bar.bar = (unsigned*)(ctl + CW_BAR) + args.li * XCD_BAR_WORDS; bar.x = 0; bar.st = nullptr;
    if (N_LAUNCHES != NPH) bar = xcd_barrier_post((unsigned*)(ctl + CW_BAR) + args.li * XCD_BAR_WORDS, MISC + 8);
#if PROBE_SEL
    unsigned long long pr_acc = 0, pr_t0 = 0, pr_tb = 0;
#define TIC() do { pr_t0 = __builtin_amdgcn_s_memrealtime(); } while (0)
#define TOC(cls) do { if ((PROBE_SEL >> (cls)) & 1) pr_acc += __builtin_amdgcn_s_memrealtime() - pr_t0; } while (0)
#define GRID_BAR(cls) do { if (N_LAUNCHES != NPH) { pr_tb = __builtin_amdgcn_s_memrealtime(); xcd_barrier(bar); if (((PROBE_SEL >> 12) & 1) || ((PROBE_SEL >> (16 + (cls))) & 1)) pr_acc += __builtin_amdgcn_s_memrealtime() - pr_tb; } } while (0)
#else
#define TIC() do { } while (0)
#define TOC(cls) do { } while (0)
#define GRID_BAR(cls) do { if (N_LAUNCHES != NPH) xcd_barrier(bar); } while (0)
#endif
    const int lo = args.ph_lo, hi = args.ph_hi;
#define IN(k) (lo <= (k) && (k) < hi)
#define BOTH(k) (IN(k) && IN((k) + 1))

    if (IN(0)) { PHASE_IDS TIC();
        LAS float* scr = (LAS float*)(ldsl + wave * 16896);
        const int gw = vcu * NWAVES + wave, NGW = G * NWAVES;
        constexpr int I_IN = 16 * 96, I_SQ = 16 * 32, I_UP = 16 * 128, I_DN = 64 * 32, I_KV = 16 * 8;
        constexpr int NITEMS = 2 * I_IN + 2 * I_SQ + 4 * I_UP + 4 * I_DN + 2 * I_SQ + I_KV + 2 * I_SQ;
#define P0_DECODE(dst, itv) do { int r = (itv); \
            if (r < 2 * I_IN) { const int l = r / I_IN; dst = P0Item{a_w_in + (size_t)l * D * APROJ, APROJ, D, 96, Win_t + (size_t)l * NIN * D, ln_mix + l * D, 0.08838834764831845f, 512, r % I_IN}; break; } r -= 2 * I_IN; \
            if (r < 2 * I_SQ) { const int l = r / I_SQ; dst = P0Item{a_w_out + (size_t)l * D * D, D, D, 32, Wao_t + (size_t)l * D * D, nullptr, 1.f, 0, r % I_SQ}; break; } r -= 2 * I_SQ; \
            if (r < 4 * I_UP) { const int l = r / I_UP; dst = P0Item{w_up + (size_t)l * D * FF, FF, D, 128, Wup_t + (size_t)l * FF * D, ln_mlp + l * D, 1.f, 0, r % I_UP}; break; } r -= 4 * I_UP; \
            if (r < 4 * I_DN) { const int l = r / I_DN; dst = P0Item{w_down + (size_t)l * FF * D, D, FF, 32, Wdn_t + (size_t)l * D * FF, nullptr, 1.f, 0, r % I_DN}; break; } r -= 4 * I_DN; \
            if (r < 2 * I_SQ) { const int j = r / I_SQ; dst = P0Item{b_w_q + (size_t)j * D * D, D, D, 32, j == 0 ? Wq0_t : Wq1_t, ln_mix + (2 + j) * D, 0.125f * LOG2E, 1024, r % I_SQ}; break; } r -= 2 * I_SQ; \
            if (r < I_KV) { dst = P0Item{w_kv, 256, D, 8, Wq0_t + (size_t)1024 * D, kv_norm, 1.f, 0, r}; break; } r -= I_KV; \
            { const int j = r / I_SQ; dst = P0Item{b_w_out + (size_t)j * D * D, D, D, 32, Wbo_t + (size_t)j * D * D, nullptr, 1.f, 0, r % I_SQ}; } } while (0)
        for (int it = gw; it < NITEMS; it += 2 * NGW) {
            const bool two = it + NGW < NITEMS;
            P0Item da, db; P0_DECODE(da, it); P0_DECODE(db, two ? it + NGW : it);
            f32x4 va[8], vb[8]; float ga[8], gb[8];
            p0_load(da, lane, va, ga); p0_load(db, lane, vb, gb);
            p0_finish(da, lane, va, ga, scr);
            if (two) p0_finish(db, lane, vb, gb, scr + 64 * 33);
        }
#undef P0_DECODE
        for (int e = vcu * 512 + tid; e < 2 * 16 * 1024; e += G * 512) { const int l = e >> 14, n = (e >> 10) & 15, k = e & 1023;
            Wg_t[e] = (bf16)f2bf(a_w_in[((size_t)l * D + k) * APROJ + NIN + n] * ln_mix[l * D + k]); }
        for (int m = gw; m < M; m += NGW) {
            const GAS f32x4* xr = (const GAS f32x4*)(x + (size_t)m * D) + lane; f32x4 v[4]; float s = 0.f;
#pragma unroll
            for (int j = 0; j < 4; ++j) { v[j] = xr[64 * j]; s += (v[j].x * v[j].x + v[j].y * v[j].y) + (v[j].z * v[j].z + v[j].w * v[j].w); }
            s = wave_sum(s);
            GAS unsigned long long* o8 = (GAS unsigned long long*)(HB + (size_t)m * D) + lane;
#pragma unroll
            for (int j = 0; j < 4; ++j) o8[64 * j] = (unsigned long long)pk2(v[j].x, v[j].y) | ((unsigned long long)pk2(v[j].z, v[j].w) << 32);
            if (lane < 4) ssq[(size_t)lane * M + m] = lane == 0 ? s : 0.f;
        }
        TOC(0); if (BOTH(0)) GRID_BAR(0);
    }

    for (int L = 0; L < 4; ++L) {
        const bool gla = L < 2; const int jb = L - 2;
        const int base = gla ? 1 + 7 * L : 15 + 5 * jb;
        const int pG1 = gla ? base + 4 : base + 2;
        if (IN(base)) { PHASE_IDS TIC();
            pg8::Gemm g; pg8::EpiScale E; E.ssq = ssq; E.act = 0;
            if (gla) { g = pg8::Gemm{HB, Win_t + (size_t)L * NIN * D, M, NIN, D, D}; E.O = QKVG; E.ldc = NIN; E.O2 = nullptr; E.ldc2 = 0; E.split_col = 1 << 30; }
            else if (jb == 0) { g = pg8::Gemm{HB, Wq0_t, M, 1280, D, D}; E.O = Qb; E.ldc = D; E.O2 = KVb; E.ldc2 = 256; E.split_col = 1024; }
            else { g = pg8::Gemm{HB, Wq1_t, M, 1024, D, D}; E.O = Qb; E.ldc = D; E.O2 = nullptr; E.ldc2 = 0; E.split_col = 1 << 30; }
            pg8::StaticOrder S; S.init(M, g.N, G, (int)blockIdx.x);
            pg8::gemm_phase<pg8::EpiScale, pg8::StaticOrder, true, true>(ldsl, g, S, E);
            TOC(gla ? 1 : 6); TIC();
            if (gla) {
                LAS float* part = (LAS float*)ldsl;
                LAS float* glr_s = (LAS float*)(ldsl + 8192);
                const GAS bf16* Wg = (const GAS bf16*)(Wg_t + (size_t)L * 16 * 1024);
                const int g4 = lane >> 4, l15 = lane & 15, mt = wave & 3, kh = wave >> 2;
                for (int c = vcu; c < M / 64; c += G) {
                    __syncthreads();
                    { const GAS bf16* ap = (const GAS bf16*)HB + (size_t)(c * 64 + 16 * mt + l15) * D + 512 * kh + 8 * g4; const GAS bf16* bp = Wg + (size_t)l15 * D + 512 * kh + 8 * g4;
                      f32x4 acc = (f32x4){0.f, 0.f, 0.f, 0.f};
#pragma unroll
                      for (int kb = 0; kb < 2; ++kb) { bf16x8 av[8], bv[8];
#pragma unroll
                          for (int ks = 0; ks < 8; ++ks) { av[ks] = *(const GAS bf16x8*)(ap + 256 * kb + 32 * ks); bv[ks] = *(const GAS bf16x8*)(bp + 256 * kb + 32 * ks); }
#pragma unroll
                          for (int ks = 0; ks < 8; ++ks) acc = __builtin_amdgcn_mfma_f32_16x16x32_bf16(av[ks], bv[ks], acc, 0, 0, 0); }
#pragma unroll
                      for (int r = 0; r < 4; ++r) part[(kh * 64 + 16 * mt + 4 * g4 + r) * 16 + l15] = acc[r]; }
                    __syncthreads();
                    { const int r = tid >> 3, n2 = (tid & 7) * 2; const float rs = pg8::row_rstd(ssq, c * 64 + r);
                      glr_s[r * 16 + n2] = (part[r * 16 + n2] + part[(64 + r) * 16 + n2]) * rs; glr_s[r * 16 + n2 + 1] = (part[r * 16 + n2 + 1] + part[(64 + r) * 16 + n2 + 1]) * rs; }
                    __syncthreads();
                    { const int kd = tid; float w2[16];
#pragma unroll
                      for (int r = 0; r < 16; ++r) w2[r] = a_w_gk2[((size_t)L * 16 + r) * KD + kd];
                      const float bb = a_b_gk[L * KD + kd]; float run = 0.f; GAS float* bo = (GAS float*)BCUM + (size_t)(c * 64) * KD + kd;
#pragma unroll 4
                      for (int t = 0; t < 64; ++t) { const LAS f32x4* gp = (const LAS f32x4*)(glr_s + t * 16); const f32x4 g0 = gp[0], g1 = gp[1], g2 = gp[2], g3 = gp[3];
                          float z = bb + ((g0[0] * w2[0] + g0[1] * w2[1]) + (g0[2] * w2[2] + g0[3] * w2[3])) + ((g1[0] * w2[4] + g1[1] * w2[5]) + (g1[2] * w2[6] + g1[3] * w2[7]))
                                       + ((g2[0] * w2[8] + g2[1] * w2[9]) + (g2[2] * w2[10] + g2[3] * w2[11])) + ((g3[0] * w2[12] + g3[1] * w2[13]) + (g3[2] * w2[14] + g3[3] * w2[15]));
                          const float ls = fminf(z, 0.f) - __logf(1.0f + __expf(-fabsf(z)));
                          run += ls * (1.0f / 16.0f); bo[(size_t)t * KD] = run; } }
                }
                __syncthreads();
            }
            TOC(2); if (BOTH(base)) GRID_BAR(gla ? 2 : 6);
        }
        if (gla) {
            if (IN(base + 1)) { PHASE_IDS
                TIC(); constexpr int KD_OFF = 0, KD_RS = 288, V_OFF = 36864, V_RS = 544;
                const int g = lane >> 4, q4 = (lane & 15) >> 2, p4 = lane & 3, wk = wave >> 2, wv = wave & 3;
                for (int un = vcu; un < 512; un += G) {
                    const int seq = un >> 5, sc = un & 31, b = seq >> 2, h = seq & 3; const size_t t0 = (size_t)b * T + sc * 128;
                    __syncthreads();
                    { const int k8 = (tid & 15) * 8; const GAS float* bcb = (const GAS float*)BCUM + t0 * KD + h * 128 + k8; const GAS bf16* kb = (const GAS bf16*)QKVG + t0 * NIN + 512 + h * 128 + k8;
                      const GAS bf16* vb = (const GAS bf16*)QKVG + t0 * NIN + 1024 + h * 256;
                      const f32x4 l0a = *(const GAS f32x4*)(bcb + 63 * KD), l0b = *(const GAS f32x4*)(bcb + 63 * KD + 4), l1a = *(const GAS f32x4*)(bcb + 127 * KD), l1b = *(const GAS f32x4*)(bcb + 127 * KD + 4);
                      v4u kv[4]; f32x4 b0[4], b1[4]; v4u vv[8];
#pragma unroll
                      for (int i = 0; i < 4; ++i) { const int t = (tid >> 4) + 32 * i; kv[i] = *(const GAS v4u*)(kb + (size_t)t * NIN); b0[i] = *(const GAS f32x4*)(bcb + (size_t)t * KD); b1[i] = *(const GAS f32x4*)(bcb + (size_t)t * KD + 4); }
#pragma unroll
                      for (int i = 0; i < 8; ++i) { const int c = tid + 512 * i, t = c >> 5, v8 = (c & 31) * 8; vv[i] = *(const GAS v4u*)(vb + (size_t)t * NIN + v8); }
                      float last0[8], bend[8];
#pragma unroll
                      for (int e = 0; e < 4; ++e) { last0[e] = l0a[e]; last0[4 + e] = l0b[e]; bend[e] = l0a[e] + l1a[e]; bend[4 + e] = l0b[e] + l1b[e]; }
                      if (tid < 16) {
#pragma unroll
                          for (int e = 0; e < 8; ++e) BendG[(size_t)un * 128 + k8 + e] = bend[e]; }
#pragma unroll
                      for (int i = 0; i < 4; ++i) { const int t = (tid >> 4) + 32 * i; float r[8];
#pragma unroll
                          for (int e = 0; e < 8; ++e) { const float kk = (e & 1) ? bfhi(kv[i][e >> 1]) : bflo(kv[i][e >> 1]); const float bc = (e < 4 ? b0[i][e] : b1[i][e - 4]) + (t >= 64 ? last0[e] : 0.f); r[e] = kk * __expf(bend[e] - bc); }
                          v4u o; o.x = pk2(r[0], r[1]); o.y = pk2(r[2], r[3]); o.z = pk2(r[4], r[5]); o.w = pk2(r[6], r[7]);
                          *(LAS v4u*)(ldsl + KD_OFF + t * KD_RS + k8 * 2) = o; }
#pragma unroll
                      for (int i = 0; i < 8; ++i) { const int c = tid + 512 * i, t = c >> 5, v8 = (c & 31) * 8; *(LAS v4u*)(ldsl + V_OFF + t * V_RS + v8 * 2) = vv[i]; } }
                    __syncthreads();
                    f32x4 acc[4][4];
#pragma unroll
                    for (int a = 0; a < 4; ++a)
#pragma unroll
                        for (int c = 0; c < 4; ++c) acc[a][c] = (f32x4){0.f, 0.f, 0.f, 0.f};
#pragma unroll
                    for (int s = 0; s < 4; ++s) { const int rowb = 32 * s + 4 * g + q4;
                        bf16x8 af[4], bfr[4];
#pragma unroll
                        for (int kt = 0; kt < 4; ++kt) { const LAS unsigned char* ap = ldsl + KD_OFF + rowb * KD_RS + (64 * wk + 16 * kt + 4 * p4) * 2; const s16x4 lo = tr_read(ap), hi = tr_read(ap + 16 * KD_RS);
                            af[kt] = (bf16x8){lo[0], lo[1], lo[2], lo[3], hi[0], hi[1], hi[2], hi[3]}; }
#pragma unroll
                        for (int vt = 0; vt < 4; ++vt) { const LAS unsigned char* bp = ldsl + V_OFF + rowb * V_RS + (64 * wv + 16 * vt + 4 * p4) * 2; const s16x4 lo = tr_read(bp), hi = tr_read(bp + 16 * V_RS);
                            bfr[vt] = (bf16x8){lo[0], lo[1], lo[2], lo[3], hi[0], hi[1], hi[2], hi[3]}; }
#pragma unroll
                        for (int kt = 0; kt < 4; ++kt)
#pragma unroll
                            for (int vt = 0; vt < 4; ++vt) acc[kt][vt] = __builtin_amdgcn_mfma_f32_16x16x32_bf16(af[kt], bfr[vt], acc[kt][vt], 0, 0, 0); }
#pragma unroll
                    for (int kt = 0; kt < 4; ++kt)
#pragma unroll
                        for (int vt = 0; vt < 4; ++vt) { const int vd = 64 * wv + 16 * vt + (lane & 15), kd = 64 * wk + 16 * kt + 4 * g;
                            v2u w; w.x = pk2(acc[kt][vt][0], acc[kt][vt][1]); w.y = pk2(acc[kt][vt][2], acc[kt][vt][3]);
                            *(v2u*)(Sst + ((size_t)un * 256 + vd) * 128 + kd) = w; }
                }
                TOC(3); if (BOTH(base + 1)) GRID_BAR(3);
            }
            if (IN(base + 2)) { PHASE_IDS TIC();
                for (int w = vcu * 512 + tid; w < 16 * 8192; w += G * 512) { const int seq = w >> 13, e4 = (w & 8191) * 4, kd = e4 & 127; float run[4] = {0.f, 0.f, 0.f, 0.f};
                    for (int sc = 0; sc < 32; ++sc) { const int un = seq * 32 + sc; bf16* p = Sst + (size_t)un * 32768 + e4; const v2u tv = *(const v2u*)p;
                        const f32x4 be = *(const f32x4*)(BendG + (size_t)un * 128 + kd);
                        v2u o; o.x = pk2(run[0], run[1]); o.y = pk2(run[2], run[3]); *(v2u*)p = o;
                        run[0] = run[0] * __expf(be[0]) + bflo(tv.x); run[1] = run[1] * __expf(be[1]) + bfhi(tv.x); run[2] = run[2] * __expf(be[2]) + bflo(tv.y); run[3] = run[3] * __expf(be[3]) + bfhi(tv.y); } }
                TOC(4); if (BOTH(base + 2)) GRID_BAR(4);
            }
            if (IN(base + 3)) { PHASE_IDS TIC();
                constexpr int A_OFF = 0, A_RS = 288, B_OFF = 73728, B_RS = 544;
                const int g = lane >> 4, l15 = lane & 15, q4 = l15 >> 2, p4 = lane & 3;
                const int grp = wave < 4 ? wave : 11 - wave;
                for (int un = vcu; un < 512; un += G) {
                    const int seq = un >> 5, sc = un & 31, b = seq >> 2, h = seq & 3; const size_t t0 = (size_t)b * T + sc * 128;
                    const int k8 = (tid & 15) * 8, q = 16 * grp + l15;
                    v4u sv[8], vv[8], kv[4], qv[4]; f32x4 kb0[4], kb1[4], qb0[4], qb1[4], qc0[4], qc1[4];
                    { const GAS bf16* sb = (const GAS bf16*)Sst + (size_t)un * 32768; const GAS bf16* vb = (const GAS bf16*)QKVG + t0 * NIN + 1024 + h * 256;
#pragma unroll
                      for (int i = 0; i < 8; ++i) { const int c = tid + 512 * i; sv[i] = *(const GAS v4u*)(sb + (size_t)c * 8); vv[i] = *(const GAS v4u*)(vb + (size_t)(c >> 5) * NIN + (c & 31) * 8); } }
                    const GAS float* bcb = (const GAS float*)BCUM + t0 * KD + h * 128 + k8;
                    const f32x4 l0a = *(const GAS f32x4*)(bcb + 63 * KD), l0b = *(const GAS f32x4*)(bcb + 63 * KD + 4);
                    { const GAS bf16* kb = (const GAS bf16*)QKVG + t0 * NIN + 512 + h * 128 + k8;
#pragma unroll
                      for (int i = 0; i < 4; ++i) { const int t = (tid >> 4) + 32 * i; kv[i] = *(const GAS v4u*)(kb + (size_t)t * NIN); kb0[i] = *(const GAS f32x4*)(bcb + (size_t)t * KD); kb1[i] = *(const GAS f32x4*)(bcb + (size_t)t * KD + 4); } }
                    __syncthreads();
#pragma unroll
                    for (int i = 0; i < 8; ++i) { const int c = tid + 512 * i; *(LAS v4u*)(ldsl + A_OFF + (c >> 4) * A_RS + (c & 15) * 16) = sv[i]; *(LAS v4u*)(ldsl + B_OFF + (c >> 5) * B_RS + (c & 31) * 16) = vv[i]; }
                    asm volatile("" ::: "memory");
                    { const size_t tok = t0 + q; const GAS bf16* qb = (const GAS bf16*)QKVG + tok * NIN + h * 128 + 8 * g; const GAS float* bq = (const GAS float*)BCUM + tok * KD + h * 128 + 8 * g; const GAS float* lq = (const GAS float*)BCUM + (t0 + 63) * KD + h * 128 + 8 * g;
#pragma unroll
                      for (int ks = 0; ks < 4; ++ks) { qv[ks] = *(const GAS v4u*)(qb + 32 * ks); qb0[ks] = *(const GAS f32x4*)(bq + 32 * ks); qb1[ks] = *(const GAS f32x4*)(bq + 32 * ks + 4); qc0[ks] = *(const GAS f32x4*)(lq + 32 * ks); qc1[ks] = *(const GAS f32x4*)(lq + 32 * ks + 4); } }
                    v4u kreg[4];
#pragma unroll
                    for (int i = 0; i < 4; ++i) { const int t = (tid >> 4) + 32 * i; float r[8];
#pragma unroll
                        for (int e = 0; e < 8; ++e) { const float kk = (e & 1) ? bfhi(kv[i][e >> 1]) : bflo(kv[i][e >> 1]); const float bc = (e < 4 ? kb0[i][e] : kb1[i][e - 4]) + (t >= 64 ? (e < 4 ? l0a[e] : l0b[e - 4]) : 0.f); r[e] = kk * __expf(-bc); }
                        kreg[i].x = pk2(r[0], r[1]); kreg[i].y = pk2(r[2], r[3]); kreg[i].z = pk2(r[4], r[5]); kreg[i].w = pk2(r[6], r[7]); }
                    bf16x8 qf[4];
                    { const float lm = q >= 64 ? 1.0f : 0.0f;
#pragma unroll
                      for (int ks = 0; ks < 4; ++ks) { float r[8];
#pragma unroll
                          for (int e = 0; e < 8; ++e) { const float qq = (e & 1) ? bfhi(qv[ks][e >> 1]) : bflo(qv[ks][e >> 1]); r[e] = qq * __expf(e < 4 ? qb0[ks][e] + lm * qc0[ks][e] : qb1[ks][e - 4] + lm * qc1[ks][e - 4]); }
                          v4u o; o.x = pk2(r[0], r[1]); o.y = pk2(r[2], r[3]); o.z = pk2(r[4], r[5]); o.w = pk2(r[6], r[7]);
                          qf[ks] = __builtin_bit_cast(bf16x8, o); } }
                    GAS bf16* gp = (GAS bf16*)QKVG + (t0 + q) * NIN + 2048 + h * 256 + 4 * g;
                    v2u gv[16];
#pragma unroll
                    for (int vt = 0; vt < 16; ++vt) gv[vt] = *(const GAS v2u*)(gp + 16 * vt);
                    __syncthreads();
                    f32x4 acc[16];
#pragma unroll
                    for (int vt = 0; vt < 16; ++vt) acc[vt] = (f32x4){0.f, 0.f, 0.f, 0.f};
#pragma unroll
                    for (int vt = 0; vt < 16; ++vt)
#pragma unroll
                        for (int ks = 0; ks < 4; ++ks) { const bf16x8 a = *(const LAS bf16x8*)(ldsl + A_OFF + (16 * vt + l15) * A_RS + (32 * ks + 8 * g) * 2);
                            acc[vt] = __builtin_amdgcn_mfma_f32_16x16x32_bf16(a, qf[ks], acc[vt], 0, 0, 0); }
                    __syncthreads();
#pragma unroll
                    for (int i = 0; i < 4; ++i) { const int t = (tid >> 4) + 32 * i; *(LAS v4u*)(ldsl + A_OFF + t * A_RS + k8 * 2) = kreg[i]; }
                    __syncthreads();
                    const int nsteps = (grp >> 1) + 1;
                    for (int s = 0; s < nsteps; ++s) {
                        f32x4 pt[2];
#pragma unroll
                        for (int tt = 0; tt < 2; ++tt) { pt[tt] = (f32x4){0.f, 0.f, 0.f, 0.f};
#pragma unroll
                            for (int ks = 0; ks < 4; ++ks) { const bf16x8 a = *(const LAS bf16x8*)(ldsl + A_OFF + (32 * s + 16 * tt + l15) * A_RS + (32 * ks + 8 * g) * 2);
                                pt[tt] = __builtin_amdgcn_mfma_f32_16x16x32_bf16(a, qf[ks], pt[tt], 0, 0, 0); }
#pragma unroll
                            for (int r = 0; r < 4; ++r) { const int j = 32 * s + 16 * tt + 4 * g + r; if (j > q) pt[tt][r] = 0.f; } }
                        v4u pw; pw.x = pk2(pt[0][0], pt[0][1]); pw.y = pk2(pt[0][2], pt[0][3]); pw.z = pk2(pt[1][0], pt[1][1]); pw.w = pk2(pt[1][2], pt[1][3]);
                        const bf16x8 pf = __builtin_bit_cast(bf16x8, pw);
#pragma unroll
                        for (int vt = 0; vt < 16; ++vt) { const LAS unsigned char* vp = ldsl + B_OFF + (32 * s + 4 * g + q4) * B_RS + (16 * vt + 4 * p4) * 2; const s16x4 lo = tr_read(vp), hi = tr_read(vp + 16 * B_RS);
                            const bf16x8 a = (bf16x8){lo[0], lo[1], lo[2], lo[3], hi[0], hi[1], hi[2], hi[3]};
                            acc[vt] = __builtin_amdgcn_mfma_f32_16x16x32_bf16(a, pf, acc[vt], 0, 0, 0); }
                    }
                    { float ss = 0.f;
#pragma unroll
                      for (int vt = 0; vt < 16; ++vt) ss += (acc[vt][0] * acc[vt][0] + acc[vt][1] * acc[vt][1]) + (acc[vt][2] * acc[vt][2] + acc[vt][3] * acc[vt][3]);
                      ss += __shfl_xor(ss, 16); ss += __shfl_xor(ss, 32);
                      const float rs = 1.0f / sqrtf(ss * (1.0f / 256.0f) + EPS);
                      const GAS float* gonp = (const GAS float*)a_onorm + L * 256 + 4 * g;
#pragma unroll
                      for (int vt = 0; vt < 16; ++vt) { const f32x4 gon = *(const GAS f32x4*)(gonp + 16 * vt);
                          const float g0 = bflo(gv[vt].x), g1 = bfhi(gv[vt].x), g2 = bflo(gv[vt].y), g3 = bfhi(gv[vt].y);
                          const float r0 = acc[vt][0] * rs * gon[0] * (g0 / (1.0f + __expf(-g0))), r1 = acc[vt][1] * rs * gon[1] * (g1 / (1.0f + __expf(-g1)));
                          const float r2 = acc[vt][2] * rs * gon[2] * (g2 / (1.0f + __expf(-g2))), r3 = acc[vt][3] * rs * gon[3] * (g3 / (1.0f + __expf(-g3)));
                          v2u w; w.x = pk2(r0, r1); w.y = pk2(r2, r3); *(GAS v2u*)(gp + 16 * vt) = w; } }
                }
                TOC(5); if (BOTH(base + 3)) GRID_BAR(5);
            }
        } else {
            if (IN(base + 1)) { PHASE_IDS
                TIC(); constexpr int K_OFF = 0, V_OFF = 40960, RS = 160, BIAS_OFF = 81920;
                const int g = lane >> 4, l15 = lane & 15, q4 = l15 >> 2, p4 = lane & 3;
                LAS float* bias_s = (LAS float*)(ldsl + BIAS_OFF);
                for (int un = vcu; un < 256; un += G) {
                    const int b = un >> 6, nb = (un >> 1) & 31, kvh = un & 1; const size_t tq0 = (size_t)b * T + nb * 128;
                    __syncthreads();
                    { v4u kv[4], vv[4]; const GAS bf16* kvb = (const GAS bf16*)KVb + (tq0 - (nb == 0 ? 0 : 128)) * 256 + kvh * 64;
#pragma unroll
                      for (int i = 0; i < 4; ++i) { const int c = tid + 512 * i, j = c >> 3, d8 = (c & 7) * 8; const int jj = nb == 0 ? (j & 127) : j;
                          kv[i] = *(const GAS v4u*)(kvb + (size_t)jj * 256 + d8); vv[i] = *(const GAS v4u*)(kvb + (size_t)jj * 256 + 128 + d8); }
#pragma unroll
                      for (int i = 0; i < 4; ++i) { const int c = tid + 512 * i, j = c >> 3, d8 = (c & 7) * 8; const bool pad = nb == 0 && j < 128;
                          *(LAS v4u*)(ldsl + K_OFF + j * RS + d8 * 2) = pad ? (v4u){0u, 0u, 0u, 0u} : kv[i]; *(LAS v4u*)(ldsl + V_OFF + j * RS + d8 * 2) = pad ? (v4u){0u, 0u, 0u, 0u} : vv[i]; } }
                    for (int e = tid; e < 1024; e += 512) { const int hg = e >> 7, dist = e & 127;
                        int bk = dist; if (dist >= 16) { bk = 16 + (dist >= 19) + (dist >= 21) + (dist >= 24) + (dist >= 27) + (dist >= 31) + (dist >= 35) + (dist >= 40) + (dist >= 46) + (dist >= 52) + (dist >= 59) + (dist >= 67) + (dist >= 77) + (dist >= 87) + (dist >= 99) + (dist >= 113); }
                        bias_s[e] = rel_table[bk * 16 + kvh * 8 + hg] * LOG2E; }
                    __syncthreads();
                    const int head = kvh * 8 + wave; const float sink2 = b_sinks[jb * 16 + head] * LOG2E;
                    GAS bf16* qbase = (GAS bf16*)Qb + (tq0 + l15) * D + head * 64;
                    bf16x8 qn0 = *(const GAS bf16x8*)(qbase + 8 * g), qn1 = *(const GAS bf16x8*)(qbase + 32 + 8 * g);
#pragma unroll 1
                    for (int qg = 0; qg < 8; ++qg) {
                        const int qi = 16 * qg + l15; GAS bf16* qp = qbase + (size_t)(16 * qg) * D;
                        const bf16x8 qf0 = qn0, qf1 = qn1;
                        if (qg < 7) { qn0 = *(const GAS bf16x8*)(qp + 16 * D + 8 * g); qn1 = *(const GAS bf16x8*)(qp + 16 * D + 32 + 8 * g); }
                        const int ts0 = qg & ~1;
                        f32x4 sc[10];
#pragma unroll
                        for (int tt = 0; tt < 10; ++tt) { const LAS unsigned char* kp = ldsl + K_OFF + (16 * (ts0 + tt) + l15) * RS + (8 * g) * 2;
                            const bf16x8 a0 = *(const LAS bf16x8*)kp, a1 = *(const LAS bf16x8*)(kp + 64);
                            sc[tt] = __builtin_amdgcn_mfma_f32_16x16x32_bf16(a0, qf0, (f32x4){0.f, 0.f, 0.f, 0.f}, 0, 0, 0);
                            sc[tt] = __builtin_amdgcn_mfma_f32_16x16x32_bf16(a1, qf1, sc[tt], 0, 0, 0); }
                        float m = sink2;
#pragma unroll
                        for (int tt = 0; tt < 10; ++tt)
#pragma unroll
                            for (int r = 0; r < 4; ++r) { const int j = 16 * (ts0 + tt) + 4 * g + r, dist = qi + 128 - j; const bool valid = (dist >= 0) && (dist < 128) && !(nb == 0 && j < 128);
                                const float s = valid ? sc[tt][r] + bias_s[wave * 128 + (dist & 127)] : -1e30f; sc[tt][r] = s; m = fmaxf(m, s); }
                        m = fmaxf(m, __shfl_xor(m, 16)); m = fmaxf(m, __shfl_xor(m, 32));
                        float l = 0.f;
#pragma unroll
                        for (int tt = 0; tt < 10; ++tt)
#pragma unroll
                            for (int r = 0; r < 4; ++r) { const float pe = __builtin_amdgcn_exp2f(sc[tt][r] - m); sc[tt][r] = pe; l += pe; }
                        l += __shfl_xor(l, 16); l += __shfl_xor(l, 32); l += __builtin_amdgcn_exp2f(sink2 - m);
                        f32x4 o[4];
#pragma unroll
                        for (int dt = 0; dt < 4; ++dt) o[dt] = (f32x4){0.f, 0.f, 0.f, 0.f};
#pragma unroll
                        for (int s5 = 0; s5 < 5; ++s5) { v4u pw; pw.x = pk2(sc[2 * s5][0], sc[2 * s5][1]); pw.y = pk2(sc[2 * s5][2], sc[2 * s5][3]); pw.z = pk2(sc[2 * s5 + 1][0], sc[2 * s5 + 1][1]); pw.w = pk2(sc[2 * s5 + 1][2], sc[2 * s5 + 1][3]);
                            const bf16x8 pf = __builtin_bit_cast(bf16x8, pw);
#pragma unroll
                            for (int dt = 0; dt < 4; ++dt) { const LAS unsigned char* vp = ldsl + V_OFF + (16 * (ts0 + 2 * s5) + 4 * g + q4) * RS + (16 * dt + 4 * p4) * 2; const s16x4 lo = tr_read(vp), hi = tr_read(vp + 16 * RS);
                                const bf16x8 a = (bf16x8){lo[0], lo[1], lo[2], lo[3], hi[0], hi[1], hi[2], hi[3]};
                                o[dt] = __builtin_amdgcn_mfma_f32_16x16x32_bf16(a, pf, o[dt], 0, 0, 0); } }
                        const float il = 1.0f / l;
#pragma unroll
                        for (int dt = 0; dt < 4; ++dt) { v2u w; w.x = pk2(o[dt][0] * il, o[dt][1] * il); w.y = pk2(o[dt][2] * il, o[dt][3] * il); *(GAS v2u*)(qp + 16 * dt + 4 * g) = w; }
                    }
                }
                TOC(7); if (BOTH(base + 1)) GRID_BAR(7);
            }
        }
        if (IN(pG1)) { TIC();
            pg8::Gemm g; pg8::EpiResid E; E.hb = HB; E.ssq = ssq;
            if (gla) g = pg8::Gemm{QKVG + 2048, Wao_t + (size_t)L * D * D, M, D, D, NIN};
            else g = pg8::Gemm{Qb, Wbo_t + (size_t)jb * D * D, M, D, D, D};
            pg8::StaticOrder S; S.init(M, D, G, (int)blockIdx.x);
            pg8::gemm_phase<pg8::EpiResid, pg8::StaticOrder, false, true>(ldsl, g, S, E);
            TOC(8); if (BOTH(pG1)) GRID_BAR(8);
        }
        if (IN(pG1 + 1)) { TIC();
            pg8::Gemm g{HB, Wup_t + (size_t)L * FF * D, M, FF, D, D};
            pg8::EpiScale E; E.O = U; E.ldc = FF; E.O2 = nullptr; E.ldc2 = 0; E.split_col = 1 << 30; E.ssq = ssq; E.act = 1;
            pg8::StaticOrder S; S.init(M, FF, G, (int)blockIdx.x);
            pg8::gemm_phase<pg8::EpiScale, pg8::StaticOrder, true, true>(ldsl, g, S, E);
            TOC(9); if (BOTH(pG1 + 1)) GRID_BAR(9);
        }
        if (IN(pG1 + 2)) { TIC();
            pg8::Gemm g{U, Wdn_t + (size_t)L * D * FF, M, D, FF, FF};
            pg8::EpiResid E; E.hb = HB; E.ssq = ssq;
            pg8::StaticOrder S; S.init(M, D, G, (int)blockIdx.x);
            pg8::gemm_phase<pg8::EpiResid, pg8::StaticOrder, false, true>(ldsl, g, S, E);
            TOC(10); if (BOTH(pG1 + 2)) GRID_BAR(10);
        }
    }
    if (IN(25)) { PHASE_IDS TIC();
        const int gw = vcu * NWAVES + wave, NGW = G * NWAVES;
        for (int m = gw; m < M; m += NGW) {
            const float rs = pg8::row_rstd(ssq, m);
            const GAS v2u* hr = (const GAS v2u*)(HB + (size_t)m * D) + lane; GAS f32x4* orow = (GAS f32x4*)(out + (size_t)m * D) + lane; const f32x4* gr = (const f32x4*)ln_final + lane;
            v2u hvv[4];
#pragma unroll
            for (int j = 0; j < 4; ++j) hvv[j] = hr[64 * j];
#pragma unroll
            for (int j = 0; j < 4; ++j) { const f32x4 gg = gr[64 * j]; orow[64 * j] = (f32x4){bflo(hvv[j].x) * rs * gg[0], bfhi(hvv[j].x) * rs * gg[1], bflo(hvv[j].y) * rs * gg[2], bfhi(hvv[j].y) * rs * gg[3]}; }
        }
    TOC(11); }
#if PROBE_SEL
    if (blockIdx.x == 0) { const unsigned long long te = __builtin_amdgcn_s_memrealtime(); while (__builtin_amdgcn_s_memrealtime() - te < pr_acc * PROBE_MUL) __builtin_amdgcn_s_sleep(8); }
#endif
#undef IN
#undef BOTH
#undef GRID_BAR
}

extern "C" void kernel_launch(void* const* d_in, const int* in_sizes, int n_in, void* d_out, int out_size, void* d_ws, size_t ws_size, hipStream_t stream) {
    static int grid = 0;
    if (grid == 0) {
        if (n_in != 17 || in_sizes[0] != M * D || out_size != M * D || ws_size < WS_END) { fprintf(stderr, "kernel_launch: unexpected shapes (n_in %d, in0 %d, out %d, ws %zu)\n", n_in, n_in > 0 ? in_sizes[0] : -1, out_size, ws_size); grid = -1; return; }
        int dev = 0, cus = 0;
        if (hipGetDevice(&dev) != hipSuccess || hipDeviceGetAttribute(&cus, hipDeviceAttributeMultiprocessorCount, dev) != hipSuccess) { grid = -1; return; }
        if (hipFuncSetAttribute((const void*)yoco_fwd, hipFuncAttributeMaxDynamicSharedMemorySize, LDS_BYTES) != hipSuccess) { fprintf(stderr, "kernel_launch: hipFuncSetAttribute failed\n"); grid = -1; return; }
        (void)hipGetLastError();
        grid = cus;
    }
    if (grid < 0) return;
    if (hipMemsetAsync((char*)d_ws + WS_CTL, 0, CTL_ZERO_BYTES, stream) != hipSuccess) return;
    Args a{};
    for (int i = 0; i < 17; ++i) a.in[i] = (const float*)d_in[i];
    a.out = (float*)d_out; a.ws = (unsigned char*)d_ws;
    if (N_LAUNCHES == 1) {
        a.ph_lo = 0; a.ph_hi = NPH; a.li = 0;
        hipLaunchKernelGGL(yoco_fwd, dim3(grid), dim3(NWAVES * 64), LDS_BYTES, stream, a);
    } else {
        for (int p = 0; p < NPH; ++p) { a.ph_lo = p; a.ph_hi = p + 1; a.li = 0;
            hipLaunchKernelGGL(yoco_fwd, dim3(grid), dim3(NWAVES * 64), LDS_BYTES, stream, a); }
    }
}
```

```cpp
#include <hip/hip_runtime.h>
#include <cstdio>
#include <cstdint>

#ifndef PROBE_SEL
#define PROBE_SEL 0
#endif
#ifndef PROBE_MUL
#define PROBE_MUL 1
#endif
#ifndef MK_N_LAUNCHES
#define MK_N_LAUNCHES 1
#endif

namespace pg8 {
#define PG8_LAS __attribute__((address_space(3)))
typedef unsigned short bf16_t;
typedef short bf16x8 __attribute__((ext_vector_type(8)));
typedef float f32x4 __attribute__((ext_vector_type(4)));
typedef unsigned u32x4 __attribute__((ext_vector_type(4)));
typedef unsigned u32x2 __attribute__((ext_vector_type(2)));
constexpr int BM = 256, BK = 64, HALF = 128, HTB = HALF * BK * 2, STAGE_BYTES = 8 * HTB, NXCD = 8, WGM = 8;

__host__ __device__ __forceinline__ int lds_byte(int r, int c) { const int st = (r >> 4) * 2 + (c >> 5), rr = r & 15, cc = c & 31, ob = rr * 64 + cc * 2; return st * 1024 + (ob ^ (((ob >> 9) & 1) << 5)); }
__host__ __device__ __forceinline__ void stage_rc(int b, int& R, int& C) { const int st = b / 1024, sb = b % 1024, swz = sb ^ (((sb >> 9) & 1) << 5); R = (st >> 1) * 16 + swz / 64; C = (st & 1) * 32 + (swz % 64) / 2; }
__host__ __device__ __forceinline__ int perm32(int rho) { const int n = rho >> 4, i = rho & 15; return 8 * (i >> 2) + 4 * n + (i & 3); }

struct Unit { int pm, pn; };
struct Gemm { const bf16_t* A; const bf16_t* Bt; int M, N, K, lda; };

struct StaticOrder {
    int nM, nN, nwg, G, c;
    __host__ __device__ void init(int M, int N, int G_, int c_) { nM = M / BM; nN = N / BM; nwg = nM * nN; G = G_; c = c_; }
    __host__ __device__ bool next(int i, Unit& u) const {
        const long L = (long)i * G + c; if (L >= nwg) return false;
        int wgid = (int)L; { const int q = nwg / NXCD, r = nwg % NXCD, xcd = wgid % NXCD, off = wgid / NXCD; wgid = (xcd < r ? xcd * (q + 1) : r * (q + 1) + (xcd - r) * q) + off; }
        const int nig = WGM * nN, gid = wgid / nig, fm = gid * WGM, gsz = (nM - fm) < WGM ? (nM - fm) : WGM;
        u.pm = fm + ((wgid % nig) % gsz); u.pn = (wgid % nig) / gsz; return true;
    }
    __device__ __forceinline__ void a_ready(const Unit&) const {}
    __device__ __forceinline__ void done(const Unit&) const {}
};

__device__ __forceinline__ unsigned cvt_pk_bf16(float lo, float hi) { unsigned r; asm volatile("v_cvt_pk_bf16_f32 %0, %1, %2" : "=v"(r) : "v"(lo), "v"(hi)); return r; }

constexpr int MROWS = 16384;
__device__ __forceinline__ float row_rstd(const float* ssq, int row) { const float s = (ssq[row] + ssq[MROWS + row]) + (ssq[2 * MROWS + row] + ssq[3 * MROWS + row]); return 1.0f / sqrtf(s * (1.0f / 1024.0f) + 1e-6f); }

__device__ __forceinline__ unsigned dpp_ror8(unsigned v) { return (unsigned)__builtin_amdgcn_mov_dpp((int)v, 0x128, 0xf, 0xf, false); }
__device__ __forceinline__ float dpp_ror8f(float v) { return __builtin_bit_cast(float, __builtin_amdgcn_mov_dpp(__builtin_bit_cast(int, v), 0x128, 0xf, 0xf, false)); }

struct EpiScale {
    static constexpr bool PERM = true, AFTER_DRAIN = false;
    bf16_t* O; int ldc; bf16_t* O2; int ldc2; int split_col; const float* ssq; int act; const PG8_LAS float* rtab; int tab_pm;
    __device__ __forceinline__ void operator()(const f32x4 (&acc)[2][2][4][2], const Unit& u, int wr, int wc, int fr, int fq) const {
        int colt = u.pn * BM; bf16_t* base = O; int ld = ldc;
        if (colt >= split_col) { base = O2; colt -= split_col; ld = ldc2; }
        const bool lo = fr < 8;
        const int col0 = colt + wc * 64 + (fr >> 3) * 32 + 8 * fq;
        const __amdgpu_buffer_rsrc_t rsrc = __builtin_amdgcn_make_buffer_rsrc((void*)base, 0, 0x7fffffff, 0x00020000);
        float rs[2][4];
        if (u.pm == tab_pm) {
#pragma unroll
            for (int ai = 0; ai < 2; ++ai)
#pragma unroll
                for (int m = 0; m < 4; ++m) rs[ai][m] = rtab[wr * 64 + ai * HALF + m * 16 + fr];
        } else {
#pragma unroll
            for (int ai = 0; ai < 2; ++ai)
#pragma unroll
                for (int m = 0; m < 4; ++m) rs[ai][m] = row_rstd(ssq, u.pm * BM + wr * 64 + ai * HALF + m * 16 + fr);
        }
#pragma unroll
        for (int ai = 0; ai < 2; ++ai)
#pragma unroll
            for (int m = 0; m < 4; ++m) { const float r = rs[ai][m]; u32x4 Y[2];
#pragma unroll
                for (int bj = 0; bj < 2; ++bj) { f32x4 v0 = acc[ai][bj][m][0] * r, v1 = acc[ai][bj][m][1] * r;
                    if (act == 1) {
#pragma unroll
                        for (int e = 0; e < 4; ++e) { float a = fmaxf(v0[e], 0.f); v0[e] = a * a; float b = fmaxf(v1[e], 0.f); v1[e] = b * b; } }
                    Y[bj].x = cvt_pk_bf16(v0[0], v0[1]); Y[bj].y = cvt_pk_bf16(v0[2], v0[3]); Y[bj].z = cvt_pk_bf16(v1[0], v1[1]); Y[bj].w = cvt_pk_bf16(v1[2], v1[3]); }
                u32x4 keep, send, recv;
#pragma unroll
                for (int e = 0; e < 4; ++e) { keep[e] = lo ? Y[0][e] : Y[1][e]; send[e] = lo ? Y[1][e] : Y[0][e]; }
#pragma unroll
                for (int e = 0; e < 4; ++e) recv[e] = dpp_ror8(send[e]);
                u32x4 d1, d2;
#pragma unroll
                for (int e = 0; e < 4; ++e) { d1[e] = lo ? keep[e] : recv[e]; d2[e] = lo ? recv[e] : keep[e]; }
                const int row1 = u.pm * BM + wr * 64 + ai * HALF + m * 16 + (fr & 7);
                const unsigned b1 = (unsigned)(row1 * ld + col0) * 2u, b2 = b1 + (unsigned)(8 * ld) * 2u;
                __builtin_amdgcn_raw_buffer_store_b128(d1, rsrc, b1, 0, 16);
                __builtin_amdgcn_raw_buffer_store_b128(d2, rsrc, b2, 0, 16); }
    }
};

struct EpiResid {
    static constexpr bool PERM = true, AFTER_DRAIN = true;
    bf16_t* hb; float* ssq;
    __device__ __forceinline__ void fused(const f32x4 (&acc)[2][2][4][2], const Unit& u, int wr, int wc, int fr, int fq, PG8_LAS unsigned char* lds, int tid) const {
        PG8_LAS float* P = (PG8_LAS float*)lds;
        const bool lo = fr < 8;
        const int col0 = u.pn * BM + wc * 64 + (fr >> 3) * 32 + 8 * fq, rloc = wr * 64 + (fr & 7);
        const __amdgpu_buffer_rsrc_t rsrc = __builtin_amdgcn_make_buffer_rsrc((void*)hb, 0, 0x7fffffff, 0x00020000);
        u32x4 h1[2][4], h2[2][4];
#pragma unroll
        for (int ai = 0; ai < 2; ++ai)
#pragma unroll
            for (int m = 0; m < 4; ++m) { const size_t o1 = (size_t)(u.pm * BM + rloc + ai * HALF + m * 16) * 1024 + col0; h1[ai][m] = *(const u32x4*)(hb + o1); h2[ai][m] = *(const u32x4*)(hb + o1 + 8 * 1024); }
        asm volatile("" ::: "memory");
#pragma unroll
        for (int ai = 0; ai < 2; ++ai)
#pragma unroll
            for (int m = 0; m < 4; ++m) {
                float keep[8], send[8], recv[8];
#pragma unroll
                for (int e = 0; e < 4; ++e) { keep[e] = lo ? acc[ai][0][m][0][e] : acc[ai][1][m][0][e]; keep[4 + e] = lo ? acc[ai][0][m][1][e] : acc[ai][1][m][1][e];
                                              send[e] = lo ? acc[ai][1][m][0][e] : acc[ai][0][m][0][e]; send[4 + e] = lo ? acc[ai][1][m][1][e] : acc[ai][0][m][1][e]; }
#pragma unroll
                for (int e = 0; e < 8; ++e) recv[e] = dpp_ror8f(send[e]);
                float ss1 = 0.f, ss2 = 0.f; u32x4 w1, w2;
#pragma unroll
                for (int e = 0; e < 4; ++e) { const float a0 = lo ? keep[2 * e] : recv[2 * e], a1 = lo ? keep[2 * e + 1] : recv[2 * e + 1], c0 = lo ? recv[2 * e] : keep[2 * e], c1 = lo ? recv[2 * e + 1] : keep[2 * e + 1];
                    const unsigned x = h1[ai][m][e], y = h2[ai][m][e];
                    w1[e] = cvt_pk_bf16(__builtin_bit_cast(float, x << 16) + a0, __builtin_bit_cast(float, x & 0xffff0000u) + a1);
                    w2[e] = cvt_pk_bf16(__builtin_bit_cast(float, y << 16) + c0, __builtin_bit_cast(float, y & 0xffff0000u) + c1);
                    const float p0 = __builtin_bit_cast(float, w1[e] << 16), p1 = __builtin_bit_cast(float, w1[e] & 0xffff0000u), q0 = __builtin_bit_cast(float, w2[e] << 16), q1 = __builtin_bit_cast(float, w2[e] & 0xffff0000u);
                    ss1 += p0 * p0 + p1 * p1; ss2 += q0 * q0 + q1 * q1; }
                const int rl = rloc + ai * HALF + m * 16; const unsigned b1 = (unsigned)((u.pm * BM + rl) * 1024 + col0) * 2u;
                __builtin_amdgcn_raw_buffer_store_b128(w1, rsrc, b1, 0, 16);
                __builtin_amdgcn_raw_buffer_store_b128(w2, rsrc, b1 + 8 * 1024 * 2, 0, 16);
                ss1 += __shfl_xor(ss1, 8); ss1 += __shfl_xor(ss1, 16); ss1 += __shfl_xor(ss1, 32);
                ss2 += __shfl_xor(ss2, 8); ss2 += __shfl_xor(ss2, 16); ss2 += __shfl_xor(ss2, 32);
                if (lo && fq == 0) { P[rl * 4 + wc] = ss1; P[(rl + 8) * 4 + wc] = ss2; } }
        asm volatile("s_waitcnt lgkmcnt(0)" ::: "memory"); __builtin_amdgcn_s_barrier(); asm volatile("" ::: "memory");
        if (tid < 256) { const PG8_LAS f32x4* p4 = (const PG8_LAS f32x4*)P + tid; const f32x4 v = *p4; ssq[(size_t)u.pn * MROWS + u.pm * BM + tid] = (v[0] + v[1]) + (v[2] + v[3]); }
    }
};

template <class Epi, class Sched, bool ALIGN_EPI = false, bool SP2 = false>
__device__ __forceinline__ void gemm_phase(PG8_LAS unsigned char* lds, const Gemm g, const Sched& S, const Epi& E) {
    int tid_ = threadIdx.x; asm volatile("" : "+v"(tid_)); const int tid = tid_, wid = __builtin_amdgcn_readfirstlane(tid >> 6), lane = tid & 63, wr = wid >> 2, wc = wid & 3, fr = lane & 15, fq = lane >> 4;
    const int K = g.K, nt = K / BK, lda = g.lda;
    unsigned voffA[2], voffB[2];
#pragma unroll
    for (int i = 0; i < 2; ++i) { int R, C; stage_rc(tid * 16 + i * 8192, R, C); const int Rb = Epi::PERM ? (64 * (R >> 5) + perm32(R & 31)) : R;
        voffA[i] = (unsigned)(R * lda + C) * 2u; voffB[i] = (unsigned)(Rb * K + C) * 2u; }
    const size_t kstep = (size_t)(BK * 2);
    const size_t hstepA = (size_t)HALF * lda * 2, hstepB = (size_t)(Epi::PERM ? 32 : HALF) * K * 2;
    const size_t tstepA = 2 * hstepA, tstepB = (size_t)BM * K * 2;
    const unsigned ldsw = (unsigned)wid * 1024u;
    const int aoff = lds_byte(wr * 64 + fr, fq * 8), boff = lds_byte(wc * 32 + fr, fq * 8);
#define PG8_SA(b, h) (((b) * 2 + (h)) * HTB)
#define PG8_SB(b, h) ((4 + (b) * 2 + (h)) * HTB)
#define PG8_STAGE(bufoff, gbase, voff) do { _Pragma("unroll") for (int _i = 0; _i < 2; ++_i) \
        __builtin_amdgcn_global_load_lds((const unsigned*)((const char*)(gbase) + (voff)[_i]), (PG8_LAS unsigned*)(lds + (bufoff) + ldsw + _i * 8192), 16, 0, 0); } while (0)
#define PG8_LDA(dst, b, h) do { _Pragma("unroll") for (int m = 0; m < 4; ++m) _Pragma("unroll") for (int k = 0; k < 2; ++k) dst[m][k] = *(const PG8_LAS bf16x8*)(lds + PG8_SA(b, h) + aoff + m * 2048 + k * 1024); } while (0)
#define PG8_LDB(dst, b, h) do { _Pragma("unroll") for (int n = 0; n < 2; ++n) _Pragma("unroll") for (int k = 0; k < 2; ++k) dst[n][k] = *(const PG8_LAS bf16x8*)(lds + PG8_SB(b, h) + boff + n * 2048 + k * 1024); } while (0)
#define PG8_MMA(ai, bj, At, Bt) do { __builtin_amdgcn_s_setprio(1); _Pragma("unroll") for (int m = 0; m < 4; ++m) _Pragma("unroll") for (int n = 0; n < 2; ++n) _Pragma("unroll") for (int k = 0; k < 2; ++k) \
        acc[ai][bj][m][n] = __builtin_amdgcn_mfma_f32_16x16x32_bf16(Bt[n][k], At[m][k], acc[ai][bj][m][n], 0, 0, 0); __builtin_amdgcn_s_setprio(0); } while (0)
#define PG8_WAIT_V(n) asm volatile("s_waitcnt vmcnt(" #n ")" ::: "memory")
#define PG8_WAIT_L(n) asm volatile("s_waitcnt lgkmcnt(" #n ")" ::: "memory")
#define PG8_BAR __builtin_amdgcn_s_barrier()
#define PG8_SCHED __builtin_amdgcn_sched_barrier(0)
    Unit cur, nxt; int ui = 0;
    if (!S.next(0, cur)) return;
    f32x4 acc[2][2][4][2];
#pragma unroll
    for (int a = 0; a < 2; ++a)
#pragma unroll
        for (int b = 0; b < 2; ++b)
#pragma unroll
            for (int m = 0; m < 4; ++m)
#pragma unroll
                for (int n = 0; n < 2; ++n) acc[a][b][m][n] = (f32x4){0.f, 0.f, 0.f, 0.f};
    bf16x8 At[4][2], B0[2][2], B1[2][2];
    const char* cA = (const char*)g.A + (size_t)cur.pm * tstepA; const char* cB = (const char*)g.Bt + (size_t)cur.pn * tstepB;
    S.a_ready(cur);
    if constexpr (SP2) {
        PG8_STAGE(PG8_SB(0, 0), cB, voffB); PG8_STAGE(PG8_SB(0, 1), cB + hstepB, voffB); PG8_STAGE(PG8_SA(0, 0), cA, voffA); PG8_STAGE(PG8_SA(0, 1), cA + hstepA, voffA);
        if (wr == 1) PG8_BAR;
        PG8_WAIT_V(2); PG8_BAR;
        PG8_STAGE(PG8_SB(1, 0), cB + kstep, voffB); PG8_STAGE(PG8_SA(1, 0), cA + kstep, voffA); PG8_STAGE(PG8_SB(1, 1), cB + hstepB + kstep, voffB);
        PG8_WAIT_V(6); PG8_BAR;
    } else {
        PG8_STAGE(PG8_SB(0, 0), cB, voffB); PG8_STAGE(PG8_SA(0, 0), cA, voffA); PG8_STAGE(PG8_SB(0, 1), cB + hstepB, voffB); PG8_STAGE(PG8_SA(0, 1), cA + hstepA, voffA);
        if (wr == 1) PG8_BAR;
        PG8_WAIT_V(4); PG8_BAR;
        PG8_STAGE(PG8_SB(1, 0), cB + kstep, voffB); PG8_STAGE(PG8_SA(1, 0), cA + kstep, voffA); PG8_STAGE(PG8_SB(1, 1), cB + hstepB + kstep, voffB);
        PG8_WAIT_V(6); PG8_BAR;
    }
    for (;;) {
        const bool has_next = S.next(ui + 1, nxt);
        const char* nA = has_next ? (const char*)g.A + (size_t)nxt.pm * tstepA : cA; const char* nB = has_next ? (const char*)g.Bt + (size_t)nxt.pn * tstepB : cB;
        for (int t = 0; t < nt; t += 2) {
            const bool last = (t == nt - 2);
            const char* a1 = cA + (size_t)(t + 1) * kstep;
            const char* a2 = last ? nA : cA + (size_t)(t + 2) * kstep; const char* b2 = last ? nB : cB + (size_t)(t + 2) * kstep;
            const char* a3 = a2 + kstep; const char* b3 = b2 + kstep;
            if (last && has_next) S.a_ready(nxt);
            if constexpr (SP2) {
            PG8_LDB(B0, 0, 0); PG8_LDB(B1, 0, 1); PG8_SCHED; PG8_LDA(At, 0, 0); PG8_STAGE(PG8_SA(1, 1), a1 + hstepA, voffA);
            PG8_WAIT_V(8); PG8_WAIT_L(0); PG8_BAR; PG8_MMA(0, 0, At, B0); PG8_MMA(0, 1, At, B1); PG8_BAR; PG8_SCHED;
            PG8_LDA(At, 0, 1); PG8_STAGE(PG8_SB(0, 0), b2, voffB); PG8_STAGE(PG8_SB(0, 1), b2 + hstepB, voffB); PG8_STAGE(PG8_SA(0, 0), a2, voffA);
            PG8_WAIT_V(8); PG8_WAIT_L(0); PG8_BAR; PG8_MMA(1, 0, At, B0); PG8_MMA(1, 1, At, B1); PG8_BAR; PG8_SCHED;
            PG8_LDB(B0, 1, 0); PG8_LDB(B1, 1, 1); PG8_SCHED; PG8_LDA(At, 1, 0); PG8_STAGE(PG8_SA(0, 1), a2 + hstepA, voffA);
            PG8_WAIT_V(8); PG8_WAIT_L(0); PG8_BAR; PG8_MMA(0, 0, At, B0); PG8_MMA(0, 1, At, B1); PG8_BAR; PG8_SCHED;
            PG8_LDA(At, 1, 1); PG8_STAGE(PG8_SB(1, 0), b3, voffB); PG8_STAGE(PG8_SB(1, 1), b3 + hstepB, voffB); PG8_STAGE(PG8_SA(1, 0), a3, voffA);
            PG8_WAIT_V(8); PG8_WAIT_L(0); PG8_BAR; PG8_MMA(1, 0, At, B0); PG8_MMA(1, 1, At, B1); PG8_BAR; PG8_SCHED;
            } else {
            PG8_LDB(B0, 0, 0); PG8_SCHED; PG8_LDA(At, 0, 0); PG8_STAGE(PG8_SA(1, 1), a1 + hstepA, voffA);
            PG8_WAIT_L(8); PG8_BAR; PG8_WAIT_L(0); PG8_MMA(0, 0, At, B0); PG8_BAR; PG8_SCHED;
            PG8_LDB(B1, 0, 1); PG8_STAGE(PG8_SB(0, 0), b2, voffB);
            PG8_BAR; PG8_WAIT_L(0); PG8_MMA(0, 1, At, B1); PG8_BAR;
            PG8_LDA(At, 0, 1); PG8_STAGE(PG8_SA(0, 0), a2, voffA);
            PG8_BAR; PG8_WAIT_L(0); PG8_MMA(1, 0, At, B0); PG8_BAR; PG8_SCHED;
            PG8_STAGE(PG8_SB(0, 1), b2 + hstepB, voffB);
            PG8_WAIT_V(6); PG8_BAR; PG8_MMA(1, 1, At, B1); PG8_BAR;
            PG8_LDB(B0, 1, 0); PG8_SCHED; PG8_LDA(At, 1, 0); PG8_STAGE(PG8_SA(0, 1), a2 + hstepA, voffA);
            PG8_WAIT_L(8); PG8_BAR; PG8_WAIT_L(0); PG8_MMA(0, 0, At, B0); PG8_BAR; PG8_SCHED;
            PG8_LDB(B1, 1, 1); PG8_STAGE(PG8_SB(1, 0), b3, voffB);
            PG8_BAR; PG8_WAIT_L(0); PG8_MMA(0, 1, At, B1); PG8_BAR;
            PG8_LDA(At, 1, 1); PG8_STAGE(PG8_SA(1, 0), a3, voffA);
            PG8_BAR; PG8_WAIT_L(0); PG8_MMA(1, 0, At, B0); PG8_BAR; PG8_SCHED;
            PG8_STAGE(PG8_SB(1, 1), b3 + hstepB, voffB);
            PG8_WAIT_V(6); PG8_BAR; PG8_MMA(1, 1, At, B1); PG8_BAR;
            }
        }
        if constexpr (ALIGN_EPI) { if (wr == 0) PG8_BAR; }
        if constexpr (!Epi::AFTER_DRAIN) { E(acc, cur, wr, wc, fr, fq); S.done(cur); }
        if (!has_next) break;
#pragma unroll
        for (int a = 0; a < 2; ++a)
#pragma unroll
            for (int b = 0; b < 2; ++b)
#pragma unroll
                for (int m = 0; m < 4; ++m)
#pragma unroll
                    for (int n = 0; n < 2; ++n) acc[a][b][m][n] = (f32x4){0.f, 0.f, 0.f, 0.f};
        cur = nxt; cA = nA; cB = nB; ++ui;
        if constexpr (ALIGN_EPI) { if (wr == 1) PG8_BAR; }
    }
    PG8_WAIT_V(0);
    if constexpr (!ALIGN_EPI) { if (wr == 0) PG8_BAR; }
    PG8_BAR;
    if constexpr (Epi::AFTER_DRAIN) { E.fused(acc, cur, wr, wc, fr, fq, lds, tid); S.done(cur); }
#undef PG8_SA
#undef PG8_SB
#undef PG8_STAGE
#undef PG8_LDA
#undef PG8_LDB
#undef PG8_MMA
#undef PG8_WAIT_V
#undef PG8_WAIT_L
#undef PG8_BAR
#undef PG8_SCHED
}
}

constexpr int NWAVES = 8;
constexpr int N_LAUNCHES = MK_N_LAUNCHES;
constexpr int NPH = 26;
constexpr int M = 16384, D = 1024, T = 4096, FF = 4096, NIN = 3072, APROJ = 3088, KD = 512;
constexpr float EPS = 1e-6f, LOG2E = 1.4426950408889634f;

constexpr size_t MiB = 1u << 20;
constexpr size_t WS_CTL = 0, CTL_ZERO_BYTES = 1 * MiB;
constexpr size_t WS_SSQ = 1 * MiB;
constexpr size_t WS_WG = 2 * MiB;
constexpr size_t WS_BEND = 2 * MiB + 65536;
constexpr size_t WS_WIN = 3 * MiB;
constexpr size_t WS_KV = 3 * MiB;
constexpr size_t WS_WAO = 15 * MiB;
constexpr size_t WS_WUP = 19 * MiB;
constexpr size_t WS_WDN = 51 * MiB;
constexpr size_t WS_WQ = 83 * MiB;
constexpr size_t WS_WQ1 = WS_WQ + (size_t)1280 * 1024 * 2;
constexpr size_t WS_WBO = 88 * MiB;
constexpr size_t WS_HB = 92 * MiB;
constexpr size_t WS_U = 124 * MiB;
constexpr size_t WS_BCUM = WS_U + 96 * MiB;
constexpr size_t WS_END = 252 * MiB;
constexpr int CW_BAR = 4096;

constexpr int LDS_BYTES = 147456;
constexpr int RING_BYTES = 131072, LDSCTL_OFF = 143360, MISC_OFF = LDSCTL_OFF + 320;

#define GAS __attribute__((address_space(1)))
#define LAS __attribute__((address_space(3)))
typedef unsigned short bf16;
typedef unsigned v4u __attribute__((ext_vector_type(4)));
typedef unsigned v2u __attribute__((ext_vector_type(2)));
typedef float f32x4 __attribute__((ext_vector_type(4)));
typedef GAS unsigned gu32;
typedef short bf16x8 __attribute__((ext_vector_type(8)));
typedef short s16x4 __attribute__((ext_vector_type(4)));
__device__ __forceinline__ s16x4 tr_read(const LAS unsigned char* p) { return __builtin_bit_cast(s16x4, __builtin_amdgcn_ds_read_tr16_b64_v4i16((LAS s16x4*)p)); }
#define RLX_AGENT __ATOMIC_RELAXED, __HIP_MEMORY_SCOPE_AGENT
#define LDS_WAIT() asm volatile("s_waitcnt lgkmcnt(0)" ::: "memory")
#define VM_WAIT() asm volatile("s_waitcnt vmcnt(0)" ::: "memory")
__device__ __forceinline__ unsigned f2bf(float f) { unsigned u = __builtin_bit_cast(unsigned, f); return (u + 0x7fffu + ((u >> 16) & 1u)) >> 16; }
__device__ __forceinline__ unsigned pk2(float lo, float hi) { return f2bf(lo) | (f2bf(hi) << 16); }
__device__ __forceinline__ float bf2f(unsigned short b) { return __builtin_bit_cast(float, (unsigned)b << 16); }
__device__ __forceinline__ float bflo(unsigned w) { return __builtin_bit_cast(float, w << 16); }
__device__ __forceinline__ float bfhi(unsigned w) { return __builtin_bit_cast(float, w & 0xffff0000u); }

#define XB_TMO      128
#define XB_XCNT(j)  (256  + 64 * (j))
#define XB_XSUB(j)  (1280 + 64 * (j))
#define XB_XGEN(j)  (2304 + 64 * (j))
#define XB_TOP      3328
#define XB_TOPGEN   3392
#define XCD_BAR_WORDS 3456
#define XB_SPIN_CAP (1u << 18)
__device__ __forceinline__ unsigned xb_ld(unsigned* p)              { return __hip_atomic_load(p, __ATOMIC_RELAXED, __HIP_MEMORY_SCOPE_AGENT); }
__device__ __forceinline__ unsigned xb_add(unsigned* p, unsigned v) { return __hip_atomic_fetch_add(p, v, __ATOMIC_RELAXED, __HIP_MEMORY_SCOPE_AGENT); }
__device__ __forceinline__ unsigned xb_xcc_id() { return (unsigned)__builtin_amdgcn_s_getreg((3 << 11) | 20) & 0xFu; }
#define XB_SPIN(cond, bar) do { unsigned _sp = 0; while (cond) { __builtin_amdgcn_s_sleep(1); \
    if ((++_sp & 255u) == 0u) { if (xb_ld(&(bar)[XB_TMO])) break; if (_sp > XB_SPIN_CAP) { atomicAdd(&(bar)[XB_TMO], 1u); break; } } } } while (0)
struct XcdBarrier { unsigned* bar; unsigned x; volatile LAS unsigned* st; };
__device__ __forceinline__ XcdBarrier xcd_barrier_post(unsigned* bar, volatile LAS unsigned* st) {
    XcdBarrier b; b.bar = bar; b.x = xb_xcc_id(); b.st = st;
    if (threadIdx.x == 0) (void)xb_add(&bar[XB_XCNT(b.x)], 1u);
    return b;
}
__device__ __forceinline__ void xcd_barrier_complete(unsigned* bar, unsigned x, unsigned& nloc, unsigned& nx) {
    const unsigned G = gridDim.x * gridDim.y * gridDim.z;
    unsigned sum, cnt, mine, sp = 0u;
    for (;;) {
        sum = 0u; cnt = 0u; mine = 0u;
#pragma unroll
        for (unsigned j = 0; j < 16; ++j) { const unsigned c = xb_ld(&bar[XB_XCNT(j)]); sum += c; cnt += (c > 0u) ? 1u : 0u; mine = (j == x) ? c : mine; }
        if (sum == G) break;
        __builtin_amdgcn_s_sleep(1);
        if ((++sp & 255u) == 0u) { if (xb_ld(&bar[XB_TMO])) break; if (sp > XB_SPIN_CAP) { atomicAdd(&bar[XB_TMO], 1u); break; } }
    }
    nloc = mine > 0u ? mine : 1u; nx = cnt > 0u ? cnt : 1u;
}
__device__ __forceinline__ void xcd_barrier(const XcdBarrier& b) {
    asm volatile("s_waitcnt vmcnt(0)" ::: "memory");
    __syncthreads();
    if (threadIdx.x == 0) {
        unsigned* bar = b.bar;
        __builtin_amdgcn_s_waitcnt(0);
        unsigned nloc = b.st[0], nx = b.st[1];
        if (nloc == 0u) { xcd_barrier_complete(bar, b.x, nloc, nx); b.st[0] = nloc; b.st[1] = nx; }
        const unsigned old = xb_add(&bar[XB_XSUB(b.x)], 1u);
        const unsigned gen = old / nloc;
        if (old + 1u == (gen + 1u) * nloc) {
            __builtin_amdgcn_fence(__ATOMIC_RELEASE, "agent");
            asm volatile("s_waitcnt vmcnt(0)" ::: "memory");
            const unsigned og = xb_add(&bar[XB_TOP], 1u);
            const unsigned tg = og / nx;
            if (og + 1u == (tg + 1u) * nx) xb_add(&bar[XB_TOPGEN], 1u);
            else XB_SPIN(xb_ld(&bar[XB_TOPGEN]) == tg, bar);
            __builtin_amdgcn_fence(__ATOMIC_ACQUIRE, "agent");
            xb_add(&bar[XB_XGEN(b.x)], 1u);
            asm volatile("s_waitcnt vmcnt(0)" ::: "memory");
        } else {
            XB_SPIN(xb_ld(&bar[XB_XGEN(b.x)]) == gen, bar);
            __builtin_amdgcn_fence(__ATOMIC_ACQUIRE, "agent");
            asm volatile("s_waitcnt vmcnt(0)" ::: "memory");
        }
    }
    __syncthreads();
}

__device__ __forceinline__ float wave_sum(float v) {
#pragma unroll
    for (int o = 1; o < 64; o <<= 1) v += __shfl_xor(v, o);
    return v;
}

struct P0Item { const float* W; int ldw, K, nblk; bf16* WT; const float* gain; float scale; int nscale, item; };
__device__ __forceinline__ void p0_load(const P0Item& d, int lane, f32x4 (&v)[8], float (&gn)[8]) {
    const GAS float* W = (const GAS float*)d.W;
    const int kb = d.item / d.nblk, nb = d.item % d.nblk, k0 = 64 * kb, n0 = 32 * nb, n4 = (lane & 7) * 4, kr = lane >> 3;
#pragma unroll
    for (int i = 0; i < 8; ++i) { v[i] = *(const GAS f32x4*)(W + (size_t)(k0 + kr + 8 * i) * d.ldw + n0 + n4); gn[i] = d.gain ? d.gain[k0 + kr + 8 * i] : 1.0f; }
}
__device__ __forceinline__ void p0_finish(const P0Item& d, int lane, const f32x4 (&v)[8], const float (&gn)[8], LAS float* scr) {
    const int kb = d.item / d.nblk, nb = d.item % d.nblk, k0 = 64 * kb, n0 = 32 * nb, n4 = (lane & 7) * 4, kr = lane >> 3;
    const float sc = (n0 + n4) < d.nscale ? d.scale : 1.0f;
#pragma unroll
    for (int i = 0; i < 8; ++i) { const float m = gn[i] * sc; LAS float* p = scr + (kr + 8 * i) * 33 + n4; p[0] = v[i][0] * m; p[1] = v[i][1] * m; p[2] = v[i][2] * m; p[3] = v[i][3] * m; }
    LDS_WAIT(); asm volatile("" ::: "memory");
    const int c = lane & 7;
#pragma unroll
    for (int j = 0; j < 4; ++j) { const int n = (lane >> 3) + 8 * j; const LAS float* s = scr + (8 * c) * 33 + n;
        v4u o; o.x = pk2(s[0 * 33], s[1 * 33]); o.y = pk2(s[2 * 33], s[3 * 33]); o.z = pk2(s[4 * 33], s[5 * 33]); o.w = pk2(s[6 * 33], s[7 * 33]);
        *(GAS v4u*)(d.WT + (size_t)(n0 + n) * d.K + k0 + 8 * c) = o; }
    LDS_WAIT(); asm volatile("" ::: "memory");
}

struct Args { const float* in[17]; float* out; unsigned char* ws; int ph_lo, ph_hi, li, pad; };

__device__ __forceinline__ float logsigmoidf(float z) { return fminf(z, 0.f) - log1pf(__expf(-fabsf(z))); }

__global__ void __launch_bounds__(NWAVES * 64, 2) yoco_fwd(Args args) {
    extern __shared__ __attribute__((aligned(16))) unsigned char lds[];
    LAS unsigned char* ldsl = (LAS unsigned char*)lds;
    volatile LAS unsigned* MISC = (volatile LAS unsigned*)(ldsl + MISC_OFF);
    const int tid0 = threadIdx.x, lane0 = tid0 & 63, wave0 = __builtin_amdgcn_readfirstlane(tid0 >> 6);
#define PHASE_IDS int tid = threadIdx.x; asm volatile("" : "+v"(tid)); const int lane = tid & 63, wave = __builtin_amdgcn_readfirstlane(tid >> 6); (void)lane; (void)wave;
    const int G = gridDim.x; const int bx = blockIdx.x; const int vcu = (G % 8 == 0) ? (bx % 8) * (G / 8) + bx / 8 : bx;
    unsigned char* ws = args.ws;
    gu32* ctl = (gu32*)(ws + WS_CTL);
    const float* x = args.in[0]; const float* a_w_in = args.in[1]; const float* a_w_gk2 = args.in[2]; const float* a_b_gk = args.in[3]; const float* a_onorm = args.in[4];
    const float* a_w_out = args.in[5]; const float* kv_norm = args.in[6]; const float* w_kv = args.in[7]; const float* b_w_q = args.in[8]; const float* b_sinks = args.in[9];
    const float* b_w_out = args.in[10]; const float* rel_table = args.in[11]; const float* ln_mix = args.in[12]; const float* ln_mlp = args.in[13];
    const float* w_up = args.in[14]; const float* w_down = args.in[15]; const float* ln_final = args.in[16];
    float* out = args.out;
    float* ssq = (float*)(ws + WS_SSQ);
    bf16* Wg_t = (bf16*)(ws + WS_WG); float* BendG = (float*)(ws + WS_BEND);
    bf16* Win_t = (bf16*)(ws + WS_WIN); bf16* KVb = (bf16*)(ws + WS_KV); bf16* Wao_t = (bf16*)(ws + WS_WAO); bf16* Wup_t = (bf16*)(ws + WS_WUP); bf16* Wdn_t = (bf16*)(ws + WS_WDN);
    bf16* Wq0_t = (bf16*)(ws + WS_WQ); bf16* Wq1_t = (bf16*)(ws + WS_WQ1); bf16* Wbo_t = (bf16*)(ws + WS_WBO);
    bf16* HB = (bf16*)(ws + WS_HB); bf16* Sst = (bf16*)out;
    bf16* U = (bf16*)(ws + WS_U); bf16* QKVG = (bf16*)(ws + WS_U); bf16* Qb = (bf16*)(ws + WS_U); float* BCUM = (float*)(ws + WS_BCUM);

    for (int u = tid0; u < (LDS_BYTES - LDSCTL_OFF) / 4; u += NWAVES * 64) ((LAS unsigned*)(ldsl + LDSCTL_OFF))[u] = 0u;
    __syncthreads();
    XcdBarrier bar; bar.bar = (unsigned*)(ctl + CW_BAR) + args.li * XCD_BAR_WORDS; bar.x = 0; bar.st = nullptr;
    if (N_LAUNCHES != NPH) bar = xcd_barrier_post((unsigned*)(ctl + CW_BAR) + args.li * XCD_BAR_WORDS, MISC + 8);
#if PROBE_SEL
    unsigned long long pr_acc = 0, pr_t0 = 0, pr_tb = 0;
#define TIC() do { pr_t0 = __builtin_amdgcn_s_memrealtime(); } while (0)
#define TOC(cls) do { if ((PROBE_SEL >> (cls)) & 1) pr_acc += __builtin_amdgcn_s_memrealtime() - pr_t0; } while (0)
#define GRID_BAR(cls) do { if (N_LAUNCHES != NPH) { pr_tb = __builtin_amdgcn_s_memrealtime(); xcd_barrier(bar); if (((PROBE_SEL >> 12) & 1) || ((PROBE_SEL >> (16 + (cls))) & 1)) pr_acc += __builtin_amdgcn_s_memrealtime() - pr_tb; } } while (0)
#else
#define TIC() do { } while (0)
#define TOC(cls) do { } while (0)
#define GRID_BAR(cls) do { if (N_LAUNCHES != NPH) xcd_barrier(bar); } while (0)
#endif
    const int lo = args.ph_lo, hi = args.ph_hi;
#define IN(k) (lo <= (k) && (k) < hi)
#define BOTH(k) (IN(k) && IN((k) + 1))

    if (IN(0)) { PHASE_IDS TIC();
        LAS float* scr = (LAS float*)(ldsl + wave * 16896);
        const int gw = vcu * NWAVES + wave, NGW = G * NWAVES;
        constexpr int I_IN = 16 * 96, I_SQ = 16 * 32, I_UP = 16 * 128, I_DN = 64 * 32, I_KV = 16 * 8;
        constexpr int NITEMS = 2 * I_IN + 2 * I_SQ + 4 * I_UP + 4 * I_DN + 2 * I_SQ + I_KV + 2 * I_SQ;
#define P0_DECODE(dst, itv) do { int r = (itv); \
            if (r < 2 * I_IN) { const int l = r / I_IN; dst = P0Item{a_w_in + (size_t)l * D * APROJ, APROJ, D, 96, Win_t + (size_t)l * NIN * D, ln_mix + l * D, 0.08838834764831845f, 512, r % I_IN}; break; } r -= 2 * I_IN; \
            if (r < 2 * I_SQ) { const int l = r / I_SQ; dst = P0Item{a_w_out + (size_t)l * D * D, D, D, 32, Wao_t + (size_t)l * D * D, nullptr, 1.f, 0, r % I_SQ}; break; } r -= 2 * I_SQ; \
            if (r < 4 * I_UP) { const int l = r / I_UP; dst = P0Item{w_up + (size_t)l * D * FF, FF, D, 128, Wup_t + (size_t)l * FF * D, ln_mlp + l * D, 1.f, 0, r % I_UP}; break; } r -= 4 * I_UP; \
            if (r < 4 * I_DN) { const int l = r / I_DN; dst = P0Item{w_down + (size_t)l * FF * D, D, FF, 32, Wdn_t + (size_t)l * D * FF, nullptr, 1.f, 0, r % I_DN}; break; } r -= 4 * I_DN; \
            if (r < 2 * I_SQ) { const int j = r / I_SQ; dst = P0Item{b_w_q + (size_t)j * D * D, D, D, 32, j == 0 ? Wq0_t : Wq1_t, ln_mix + (2 + j) * D, 0.125f * LOG2E, 1024, r % I_SQ}; break; } r -= 2 * I_SQ; \
            if (r < I_KV) { dst = P0Item{w_kv, 256, D, 8, Wq0_t + (size_t)1024 * D, kv_norm, 1.f, 0, r}; break; } r -= I_KV; \
            { const int j = r / I_SQ; dst = P0Item{b_w_out + (size_t)j * D * D, D, D, 32, Wbo_t + (size_t)j * D * D, nullptr, 1.f, 0, r % I_SQ}; } } while (0)
        for (int it = gw; it < NITEMS; it += 2 * NGW) {
            const bool two = it + NGW < NITEMS;
            P0Item da, db; P0_DECODE(da, it); P0_DECODE(db, two ? it + NGW : it);
            f32x4 va[8], vb[8]; float ga[8], gb[8];
            p0_load(da, lane, va, ga); p0_load(db, lane, vb, gb);
            p0_finish(da, lane, va, ga, scr);
            if (two) p0_finish(db, lane, vb, gb, scr + 64 * 33);
        }
#undef P0_DECODE
        for (int e = vcu * 512 + tid; e < 2 * 16 * 1024; e += G * 512) { const int l = e >> 14, n = (e >> 10) & 15, k = e & 1023;
            Wg_t[e] = (bf16)f2bf(a_w_in[((size_t)l * D + k) * APROJ + NIN + n] * ln_mix[l * D + k]); }
        for (int m = gw; m < M; m += NGW) {
            const GAS f32x4* xr = (const GAS f32x4*)(x + (size_t)m * D) + lane; f32x4 v[4]; float s = 0.f;
#pragma unroll
            for (int j = 0; j < 4; ++j) { v[j] = xr[64 * j]; s += (v[j].x * v[j].x + v[j].y * v[j].y) + (v[j].z * v[j].z + v[j].w * v[j].w); }
            s = wave_sum(s);
            GAS unsigned long long* o8 = (GAS unsigned long long*)(HB + (size_t)m * D) + lane;
#pragma unroll
            for (int j = 0; j < 4; ++j) o8[64 * j] = (unsigned long long)pk2(v[j].x, v[j].y) | ((unsigned long long)pk2(v[j].z, v[j].w) << 32);
            if (lane < 4) ssq[(size_t)lane * M + m] = lane == 0 ? s : 0.f;
        }
        TOC(0); if (BOTH(0)) GRID_BAR(0);
    }

    for (int L = 0; L < 4; ++L) {
        const bool gla = L < 2; const int jb = L - 2;
        const int base = gla ? 1 + 7 * L : 15 + 5 * jb;
        const int pG1 = gla ? base + 4 : base + 2;
        if (IN(base)) { PHASE_IDS TIC();
            pg8::Gemm g; pg8::EpiScale E; E.ssq = ssq; E.act = 0;
            if (gla) { g = pg8::Gemm{HB, Win_t + (size_t)L * NIN * D, M, NIN, D, D}; E.O = QKVG; E.ldc = NIN; E.O2 = nullptr; E.ldc2 = 0; E.split_col = 1 << 30; }
            else if (jb == 0) { g = pg8::Gemm{HB, Wq0_t, M, 1280, D, D}; E.O = Qb; E.ldc = D; E.O2 = KVb; E.ldc2 = 256; E.split_col = 1024; }
            else { g = pg8::Gemm{HB, Wq1_t, M, 1024, D, D}; E.O = Qb; E.ldc = D; E.O2 = nullptr; E.ldc2 = 0; E.split_col = 1 << 30; }
            pg8::StaticOrder S; S.init(M, g.N, G, (int)blockIdx.x);
            { pg8::Unit u0; const bool has = S.next(0, u0); LAS float* rtab = (LAS float*)(ldsl + RING_BYTES);
              if (has && tid < 256) rtab[tid] = pg8::row_rstd(ssq, u0.pm * 256 + tid);
              __syncthreads(); E.rtab = rtab; E.tab_pm = has ? u0.pm : -1; }
            pg8::gemm_phase<pg8::EpiScale, pg8::StaticOrder, true, true>(ldsl, g, S, E);
            TOC(gla ? 1 : 6); TIC();
            if (gla) {
                LAS float* part = (LAS float*)ldsl;
                LAS float* glr_s = (LAS float*)(ldsl + 8192);
                const GAS bf16* Wg = (const GAS bf16*)(Wg_t + (size_t)L * 16 * 1024);
                const int g4 = lane >> 4, l15 = lane & 15, mt = wave & 3, kh = wave >> 2;
                for (int c = vcu; c < M / 64; c += G) {
                    __syncthreads();
                    { const GAS bf16* ap = (const GAS bf16*)HB + (size_t)(c * 64 + 16 * mt + l15) * D + 512 * kh + 8 * g4; const GAS bf16* bp = Wg + (size_t)l15 * D + 512 * kh + 8 * g4;
                      f32x4 acc = (f32x4){0.f, 0.f, 0.f, 0.f};
#pragma unroll
                      for (int kb = 0; kb < 2; ++kb) { bf16x8 av[8], bv[8];
#pragma unroll
                          for (int ks = 0; ks < 8; ++ks) { av[ks] = *(const GAS bf16x8*)(ap + 256 * kb + 32 * ks); bv[ks] = *(const GAS bf16x8*)(bp + 256 * kb + 32 * ks); }
#pragma unroll
                          for (int ks = 0; ks < 8; ++ks) acc = __builtin_amdgcn_mfma_f32_16x16x32_bf16(av[ks], bv[ks], acc, 0, 0, 0); }
#pragma unroll
                      for (int r = 0; r < 4; ++r) part[(kh * 64 + 16 * mt + 4 * g4 + r) * 16 + l15] = acc[r]; }
                    __syncthreads();
                    { const int r = tid >> 3, n2 = (tid & 7) * 2; const float rs = pg8::row_rstd(ssq, c * 64 + r);
                      glr_s[r * 16 + n2] = (part[r * 16 + n2] + part[(64 + r) * 16 + n2]) * rs; glr_s[r * 16 + n2 + 1] = (part[r * 16 + n2 + 1] + part[(64 + r) * 16 + n2 + 1]) * rs; }
                    __syncthreads();
                    { const int kd = tid; float w2[16];
#pragma unroll
                      for (int r = 0; r < 16; ++r) w2[r] = a_w_gk2[((size_t)L * 16 + r) * KD + kd];
                      const float bb = a_b_gk[L * KD + kd]; float run = 0.f; GAS float* bo = (GAS float*)BCUM + (size_t)(c * 64) * KD + kd;
#pragma unroll 4
                      for (int t = 0; t < 64; ++t) { const LAS f32x4* gp = (const LAS f32x4*)(glr_s + t * 16); const f32x4 g0 = gp[0], g1 = gp[1], g2 = gp[2], g3 = gp[3];
                          float z = bb + ((g0[0] * w2[0] + g0[1] * w2[1]) + (g0[2] * w2[2] + g0[3] * w2[3])) + ((g1[0] * w2[4] + g1[1] * w2[5]) + (g1[2] * w2[6] + g1[3] * w2[7]))
                                       + ((g2[0] * w2[8] + g2[1] * w2[9]) + (g2[2] * w2[10] + g2[3] * w2[11])) + ((g3[0] * w2[12] + g3[1] * w2[13]) + (g3[2] * w2[14] + g3[3] * w2[15]));
                          const float ls = fminf(z, 0.f) - __logf(1.0f + __expf(-fabsf(z)));
                          run += ls * (1.0f / 16.0f); bo[(size_t)t * KD] = run; } }
                }
                __syncthreads();
            }
            TOC(2); if (BOTH(base)) GRID_BAR(gla ? 2 : 6);
        }
        if (gla) {
            if (IN(base + 1)) { PHASE_IDS
                TIC(); constexpr int KD_OFF = 0, KD_RS = 288, V_OFF = 36864, V_RS = 544;
                const int g = lane >> 4, q4 = (lane & 15) >> 2, p4 = lane & 3, wk = wave >> 2, wv = wave & 3;
                for (int un = vcu; un < 512; un += G) {
                    const int seq = un >> 5, sc = un & 31, b = seq >> 2, h = seq & 3; const size_t t0 = (size_t)b * T + sc * 128;
                    __syncthreads();
                    { const int k8 = (tid & 15) * 8; const GAS float* bcb = (const GAS float*)BCUM + t0 * KD + h * 128 + k8; const GAS bf16* kb = (const GAS bf16*)QKVG + t0 * NIN + 512 + h * 128 + k8;
                      const GAS bf16* vb = (const GAS bf16*)QKVG + t0 * NIN + 1024 + h * 256;
                      const f32x4 l0a = *(const GAS f32x4*)(bcb + 63 * KD), l0b = *(const GAS f32x4*)(bcb + 63 * KD + 4), l1a = *(const GAS f32x4*)(bcb + 127 * KD), l1b = *(const GAS f32x4*)(bcb + 127 * KD + 4);
                      v4u kv[4]; f32x4 b0[4], b1[4]; v4u vv[8];
#pragma unroll
                      for (int i = 0; i < 4; ++i) { const int t = (tid >> 4) + 32 * i; kv[i] = *(const GAS v4u*)(kb + (size_t)t * NIN); b0[i] = *(const GAS f32x4*)(bcb + (size_t)t * KD); b1[i] = *(const GAS f32x4*)(bcb + (size_t)t * KD + 4); }
#pragma unroll
                      for (int i = 0; i < 8; ++i) { const int c = tid + 512 * i, t = c >> 5, v8 = (c & 31) * 8; vv[i] = *(const GAS v4u*)(vb + (size_t)t * NIN + v8); }
                      float last0[8], bend[8];
#pragma unroll
                      for (int e = 0; e < 4; ++e) { last0[e] = l0a[e]; last0[4 + e] = l0b[e]; bend[e] = l0a[e] + l1a[e]; bend[4 + e] = l0b[e] + l1b[e]; }
                      if (tid < 16) {
#pragma unroll
                          for (int e = 0; e < 8; ++e) BendG[(size_t)un * 128 + k8 + e] = bend[e]; }
#pragma unroll
                      for (int i = 0; i < 4; ++i) { const int t = (tid >> 4) + 32 * i; float r[8];
#pragma unroll
                          for (int e = 0; e < 8; ++e) { const float kk = (e & 1) ? bfhi(kv[i][e >> 1]) : bflo(kv[i][e >> 1]); const float bc = (e < 4 ? b0[i][e] : b1[i][e - 4]) + (t >= 64 ? last0[e] : 0.f); r[e] = kk * __expf(bend[e] - bc); }
                          v4u o; o.x = pk2(r[0], r[1]); o.y = pk2(r[2], r[3]); o.z = pk2(r[4], r[5]); o.w = pk2(r[6], r[7]);
                          *(LAS v4u*)(ldsl + KD_OFF + t * KD_RS + k8 * 2) = o; }
#pragma unroll
                      for (int i = 0; i < 8; ++i) { const int c = tid + 512 * i, t = c >> 5, v8 = (c & 31) * 8; *(LAS v4u*)(ldsl + V_OFF + t * V_RS + v8 * 2) = vv[i]; } }
                    __syncthreads();
                    f32x4 acc[4][4];
#pragma unroll
                    for (int a = 0; a < 4; ++a)
#pragma unroll
                        for (int c = 0; c < 4; ++c) acc[a][c] = (f32x4){0.f, 0.f, 0.f, 0.f};
#pragma unroll
                    for (int s = 0; s < 4; ++s) { const int rowb = 32 * s + 4 * g + q4;
                        bf16x8 af[4], bfr[4];
#pragma unroll
                        for (int kt = 0; kt < 4; ++kt) { const LAS unsigned char* ap = ldsl + KD_OFF + rowb * KD_RS + (64 * wk + 16 * kt + 4 * p4) * 2; const s16x4 lo = tr_read(ap), hi = tr_read(ap + 16 * KD_RS);
                            af[kt] = (bf16x8){lo[0], lo[1], lo[2], lo[3], hi[0], hi[1], hi[2], hi[3]}; }
#pragma unroll
                        for (int vt = 0; vt < 4; ++vt) { const LAS unsigned char* bp = ldsl + V_OFF + rowb * V_RS + (64 * wv + 16 * vt + 4 * p4) * 2; const s16x4 lo = tr_read(bp), hi = tr_read(bp + 16 * V_RS);
                            bfr[vt] = (bf16x8){lo[0], lo[1], lo[2], lo[3], hi[0], hi[1], hi[2], hi[3]}; }
#pragma unroll
                        for (int kt = 0; kt < 4; ++kt)
#pragma unroll
                            for (int vt = 0; vt < 4; ++vt) acc[kt][vt] = __builtin_amdgcn_mfma_f32_16x16x32_bf16(af[kt], bfr[vt], acc[kt][vt], 0, 0, 0); }
#pragma unroll
                    for (int kt = 0; kt < 4; ++kt)
#pragma unroll
                        for (int vt = 0; vt < 4; ++vt) { const int vd = 64 * wv + 16 * vt + (lane & 15), kd = 64 * wk + 16 * kt + 4 * g;
                            v2u w; w.x = pk2(acc[kt][vt][0], acc[kt][vt][1]); w.y = pk2(acc[kt][vt][2], acc[kt][vt][3]);
                            *(v2u*)(Sst + ((size_t)un * 256 + vd) * 128 + kd) = w; }
                }
                TOC(3); if (BOTH(base + 1)) GRID_BAR(3);
            }
            if (IN(base + 2)) { PHASE_IDS TIC();
                for (int w = vcu * 512 + tid; w < 16 * 8192; w += G * 512) { const int seq = w >> 13, e4 = (w & 8191) * 4, kd = e4 & 127; float run[4] = {0.f, 0.f, 0.f, 0.f};
                    for (int sc = 0; sc < 32; ++sc) { const int un = seq * 32 + sc; bf16* p = Sst + (size_t)un * 32768 + e4; const v2u tv = *(const v2u*)p;
                        const f32x4 be = *(const f32x4*)(BendG + (size_t)un * 128 + kd);
                        v2u o; o.x = pk2(run[0], run[1]); o.y = pk2(run[2], run[3]); *(v2u*)p = o;
                        run[0] = run[0] * __expf(be[0]) + bflo(tv.x); run[1] = run[1] * __expf(be[1]) + bfhi(tv.x); run[2] = run[2] * __expf(be[2]) + bflo(tv.y); run[3] = run[3] * __expf(be[3]) + bfhi(tv.y); } }
                TOC(4); if (BOTH(base + 2)) GRID_BAR(4);
            }
            if (IN(base + 3)) { PHASE_IDS TIC();
                constexpr int A_OFF = 0, A_RS = 288, B_OFF = 73728, B_RS = 544;
                const int g = lane >> 4, l15 = lane & 15, q4 = l15 >> 2, p4 = lane & 3;
                const int grp = wave < 4 ? wave : 11 - wave;
                for (int un = vcu; un < 512; un += G) {
                    const int seq = un >> 5, sc = un & 31, b = seq >> 2, h = seq & 3; const size_t t0 = (size_t)b * T + sc * 128;
                    const int k8 = (tid & 15) * 8, q = 16 * grp + l15;
                    v4u sv[8], vv[8], kv[4], qv[4]; f32x4 kb0[4], kb1[4], qb0[4], qb1[4], qc0[4], qc1[4];
                    { const GAS bf16* sb = (const GAS bf16*)Sst + (size_t)un * 32768; const GAS bf16* vb = (const GAS bf16*)QKVG + t0 * NIN + 1024 + h * 256;
#pragma unroll
                      for (int i = 0; i < 8; ++i) { const int c = tid + 512 * i; sv[i] = *(const GAS v4u*)(sb + (size_t)c * 8); vv[i] = *(const GAS v4u*)(vb + (size_t)(c >> 5) * NIN + (c & 31) * 8); } }
                    const GAS float* bcb = (const GAS float*)BCUM + t0 * KD + h * 128 + k8;
                    const f32x4 l0a = *(const GAS f32x4*)(bcb + 63 * KD), l0b = *(const GAS f32x4*)(bcb + 63 * KD + 4);
                    { const GAS bf16* kb = (const GAS bf16*)QKVG + t0 * NIN + 512 + h * 128 + k8;
#pragma unroll
                      for (int i = 0; i < 4; ++i) { const int t = (tid >> 4) + 32 * i; kv[i] = *(const GAS v4u*)(kb + (size_t)t * NIN); kb0[i] = *(const GAS f32x4*)(bcb + (size_t)t * KD); kb1[i] = *(const GAS f32x4*)(bcb + (size_t)t * KD + 4); } }
                    __syncthreads();
#pragma unroll
                    for (int i = 0; i < 8; ++i) { const int c = tid + 512 * i; *(LAS v4u*)(ldsl + A_OFF + (c >> 4) * A_RS + (c & 15) * 16) = sv[i]; *(LAS v4u*)(ldsl + B_OFF + (c >> 5) * B_RS + (c & 31) * 16) = vv[i]; }
                    asm volatile("" ::: "memory");
                    { const size_t tok = t0 + q; const GAS bf16* qb = (const GAS bf16*)QKVG + tok * NIN + h * 128 + 8 * g; const GAS float* bq = (const GAS float*)BCUM + tok * KD + h * 128 + 8 * g; const GAS float* lq = (const GAS float*)BCUM + (t0 + 63) * KD + h * 128 + 8 * g;
#pragma unroll
                      for (int ks = 0; ks < 4; ++ks) { qv[ks] = *(const GAS v4u*)(qb + 32 * ks); qb0[ks] = *(const GAS f32x4*)(bq + 32 * ks); qb1[ks] = *(const GAS f32x4*)(bq + 32 * ks + 4); qc0[ks] = *(const GAS f32x4*)(lq + 32 * ks); qc1[ks] = *(const GAS f32x4*)(lq + 32 * ks + 4); } }
                    v4u kreg[4];
#pragma unroll
                    for (int i = 0; i < 4; ++i) { const int t = (tid >> 4) + 32 * i; float r[8];
#pragma unroll
                        for (int e = 0; e < 8; ++e) { const float kk = (e & 1) ? bfhi(kv[i][e >> 1]) : bflo(kv[i][e >> 1]); const float bc = (e < 4 ? kb0[i][e] : kb1[i][e - 4]) + (t >= 64 ? (e < 4 ? l0a[e] : l0b[e - 4]) : 0.f); r[e] = kk * __expf(-bc); }
                        kreg[i].x = pk2(r[0], r[1]); kreg[i].y = pk2(r[2], r[3]); kreg[i].z = pk2(r[4], r[5]); kreg[i].w = pk2(r[6], r[7]); }
                    bf16x8 qf[4];
                    { const float lm = q >= 64 ? 1.0f : 0.0f;
#pragma unroll
                      for (int ks = 0; ks < 4; ++ks) { float r[8];
#pragma unroll
                          for (int e = 0; e < 8; ++e) { const float qq = (e & 1) ? bfhi(qv[ks][e >> 1]) : bflo(qv[ks][e >> 1]); r[e] = qq * __expf(e < 4 ? qb0[ks][e] + lm * qc0[ks][e] : qb1[ks][e - 4] + lm * qc1[ks][e - 4]); }
                          v4u o; o.x = pk2(r[0], r[1]); o.y = pk2(r[2], r[3]); o.z = pk2(r[4], r[5]); o.w = pk2(r[6], r[7]);
                          qf[ks] = __builtin_bit_cast(bf16x8, o); } }
                    GAS bf16* gp = (GAS bf16*)QKVG + (t0 + q) * NIN + 2048 + h * 256 + 4 * g;
                    v2u gv[16];
#pragma unroll
                    for (int vt = 0; vt < 16; ++vt) gv[vt] = *(const GAS v2u*)(gp + 16 * vt);
                    __syncthreads();
                    f32x4 acc[16];
#pragma unroll
                    for (int vt = 0; vt < 16; ++vt) acc[vt] = (f32x4){0.f, 0.f, 0.f, 0.f};
#pragma unroll
                    for (int vt = 0; vt < 16; ++vt)
#pragma unroll
                        for (int ks = 0; ks < 4; ++ks) { const bf16x8 a = *(const LAS bf16x8*)(ldsl + A_OFF + (16 * vt + l15) * A_RS + (32 * ks + 8 * g) * 2);
                            acc[vt] = __builtin_amdgcn_mfma_f32_16x16x32_bf16(a, qf[ks], acc[vt], 0, 0, 0); }
                    __syncthreads();
#pragma unroll
                    for (int i = 0; i < 4; ++i) { const int t = (tid >> 4) + 32 * i; *(LAS v4u*)(ldsl + A_OFF + t * A_RS + k8 * 2) = kreg[i]; }
                    __syncthreads();
                    const int nsteps = (grp >> 1) + 1;
                    for (int s = 0; s < nsteps; ++s) {
                        f32x4 pt[2];
#pragma unroll
                        for (int tt = 0; tt < 2; ++tt) { pt[tt] = (f32x4){0.f, 0.f, 0.f, 0.f};
#pragma unroll
                            for (int ks = 0; ks < 4; ++ks) { const bf16x8 a = *(const LAS bf16x8*)(ldsl + A_OFF + (32 * s + 16 * tt + l15) * A_RS + (32 * ks + 8 * g) * 2);
                                pt[tt] = __builtin_amdgcn_mfma_f32_16x16x32_bf16(a, qf[ks], pt[tt], 0, 0, 0); }
#pragma unroll
                            for (int r = 0; r < 4; ++r) { const int j = 32 * s + 16 * tt + 4 * g + r; if (j > q) pt[tt][r] = 0.f; } }
                        v4u pw; pw.x = pk2(pt[0][0], pt[0][1]); pw.y = pk2(pt[0][2], pt[0][3]); pw.z = pk2(pt[1][0], pt[1][1]); pw.w = pk2(pt[1][2], pt[1][3]);
                        const bf16x8 pf = __builtin_bit_cast(bf16x8, pw);
#pragma unroll
                        for (int vt = 0; vt < 16; ++vt) { const LAS unsigned char* vp = ldsl + B_OFF + (32 * s + 4 * g + q4) * B_RS + (16 * vt + 4 * p4) * 2; const s16x4 lo = tr_read(vp), hi = tr_read(vp + 16 * B_RS);
                            const bf16x8 a = (bf16x8){lo[0], lo[1], lo[2], lo[3], hi[0], hi[1], hi[2], hi[3]};
                            acc[vt] = __builtin_amdgcn_mfma_f32_16x16x32_bf16(a, pf, acc[vt], 0, 0, 0); }
                    }
                    { float ss = 0.f;
#pragma unroll
                      for (int vt = 0; vt < 16; ++vt) ss += (acc[vt][0] * acc[vt][0] + acc[vt][1] * acc[vt][1]) + (acc[vt][2] * acc[vt][2] + acc[vt][3] * acc[vt][3]);
                      ss += __shfl_xor(ss, 16); ss += __shfl_xor(ss, 32);
                      const float rs = 1.0f / sqrtf(ss * (1.0f / 256.0f) + EPS);
                      const GAS float* gonp = (const GAS float*)a_onorm + L * 256 + 4 * g;
#pragma unroll
                      for (int vt = 0; vt < 16; ++vt) { const f32x4 gon = *(const GAS f32x4*)(gonp + 16 * vt);
                          const float g0 = bflo(gv[vt].x), g1 = bfhi(gv[vt].x), g2 = bflo(gv[vt].y), g3 = bfhi(gv[vt].y);
                          const float r0 = acc[vt][0] * rs * gon[0] * (g0 / (1.0f + __expf(-g0))), r1 = acc[vt][1] * rs * gon[1] * (g1 / (1.0f + __expf(-g1)));
                          const float r2 = acc[vt][2] * rs * gon[2] * (g2 / (1.0f + __expf(-g2))), r3 = acc[vt][3] * rs * gon[3] * (g3 / (1.0f + __expf(-g3)));
                          v2u w; w.x = pk2(r0, r1); w.y = pk2(r2, r3); *(GAS v2u*)(gp + 16 * vt) = w; } }
                }
                TOC(5); if (BOTH(base + 3)) GRID_BAR(5);
            }
        } else {
            if (IN(base + 1)) { PHASE_IDS
                TIC(); constexpr int K_OFF = 0, V_OFF = 40960, RS = 160, BIAS_OFF = 81920;
                const int g = lane >> 4, l15 = lane & 15, q4 = l15 >> 2, p4 = lane & 3;
                LAS float* bias_s = (LAS float*)(ldsl + BIAS_OFF);
                for (int un = vcu; un < 256; un += G) {
                    const int b = un >> 6, nb = (un >> 1) & 31, kvh = un & 1; const size_t tq0 = (size_t)b * T + nb * 128;
                    __syncthreads();
                    { v4u kv[4], vv[4]; const GAS bf16* kvb = (const GAS bf16*)KVb + (tq0 - (nb == 0 ? 0 : 128)) * 256 + kvh * 64;
#pragma unroll
                      for (int i = 0; i < 4; ++i) { const int c = tid + 512 * i, j = c >> 3, d8 = (c & 7) * 8; const int jj = nb == 0 ? (j & 127) : j;
                          kv[i] = *(const GAS v4u*)(kvb + (size_t)jj * 256 + d8); vv[i] = *(const GAS v4u*)(kvb + (size_t)jj * 256 + 128 + d8); }
#pragma unroll
                      for (int i = 0; i < 4; ++i) { const int c = tid + 512 * i, j = c >> 3, d8 = (c & 7) * 8; const bool pad = nb == 0 && j < 128;
                          *(LAS v4u*)(ldsl + K_OFF + j * RS + d8 * 2) = pad ? (v4u){0u, 0u, 0u, 0u} : kv[i]; *(LAS v4u*)(ldsl + V_OFF + j * RS + d8 * 2) = pad ? (v4u){0u, 0u, 0u, 0u} : vv[i]; } }
                    for (int e = tid; e < 1024; e += 512) { const int hg = e >> 7, dist = e & 127;
                        int bk = dist; if (dist >= 16) { bk = 16 + (dist >= 19) + (dist >= 21) + (dist >= 24) + (dist >= 27) + (dist >= 31) + (dist >= 35) + (dist >= 40) + (dist >= 46) + (dist >= 52) + (dist >= 59) + (dist >= 67) + (dist >= 77) + (dist >= 87) + (dist >= 99) + (dist >= 113); }
                        bias_s[e] = rel_table[bk * 16 + kvh * 8 + hg] * LOG2E; }
                    __syncthreads();
                    const int head = kvh * 8 + wave; const float sink2 = b_sinks[jb * 16 + head] * LOG2E;
                    GAS bf16* qbase = (GAS bf16*)Qb + (tq0 + l15) * D + head * 64;
                    bf16x8 qn0 = *(const GAS bf16x8*)(qbase + 8 * g), qn1 = *(const GAS bf16x8*)(qbase + 32 + 8 * g);
#pragma unroll 1
                    for (int qg = 0; qg < 8; ++qg) {
                        const int qi = 16 * qg + l15; GAS bf16* qp = qbase + (size_t)(16 * qg) * D;
                        const bf16x8 qf0 = qn0, qf1 = qn1;
                        if (qg < 7) { qn0 = *(const GAS bf16x8*)(qp + 16 * D + 8 * g); qn1 = *(const GAS bf16x8*)(qp + 16 * D + 32 + 8 * g); }
                        const int ts0 = qg & ~1;
                        f32x4 sc[10];
#pragma unroll
                        for (int tt = 0; tt < 10; ++tt) { const LAS unsigned char* kp = ldsl + K_OFF + (16 * (ts0 + tt) + l15) * RS + (8 * g) * 2;
                            const bf16x8 a0 = *(const LAS bf16x8*)kp, a1 = *(const LAS bf16x8*)(kp + 64);
                            sc[tt] = __builtin_amdgcn_mfma_f32_16x16x32_bf16(a0, qf0, (f32x4){0.f, 0.f, 0.f, 0.f}, 0, 0, 0);
                            sc[tt] = __builtin_amdgcn_mfma_f32_16x16x32_bf16(a1, qf1, sc[tt], 0, 0, 0); }
                        float m = sink2;
#pragma unroll
                        for (int tt = 0; tt < 10; ++tt)
#pragma unroll
                            for (int r = 0; r < 4; ++r) { const int j = 16 * (ts0 + tt) + 4 * g + r, dist = qi + 128 - j; const bool valid = (dist >= 0) && (dist < 128) && !(nb == 0 && j < 128);
                                const float s = valid ? sc[tt][r] + bias_s[wave * 128 + (dist & 127)] : -1e30f; sc[tt][r] = s; m = fmaxf(m, s); }
                        m = fmaxf(m, __shfl_xor(m, 16)); m = fmaxf(m, __shfl_xor(m, 32));
                        float l = 0.f;
#pragma unroll
                        for (int tt = 0; tt < 10; ++tt)
#pragma unroll
                            for (int r = 0; r < 4; ++r) { const float pe = __builtin_amdgcn_exp2f(sc[tt][r] - m); sc[tt][r] = pe; l += pe; }
                        l += __shfl_xor(l, 16); l += __shfl_xor(l, 32); l += __builtin_amdgcn_exp2f(sink2 - m);
                        f32x4 o[4];
#pragma unroll
                        for (int dt = 0; dt < 4; ++dt) o[dt] = (f32x4){0.f, 0.f, 0.f, 0.f};
#pragma unroll
                        for (int s5 = 0; s5 < 5; ++s5) { v4u pw; pw.x = pk2(sc[2 * s5][0], sc[2 * s5][1]); pw.y = pk2(sc[2 * s5][2], sc[2 * s5][3]); pw.z = pk2(sc[2 * s5 + 1][0], sc[2 * s5 + 1][1]); pw.w = pk2(sc[2 * s5 + 1][2], sc[2 * s5 + 1][3]);
                            const bf16x8 pf = __builtin_bit_cast(bf16x8, pw);
#pragma unroll
                            for (int dt = 0; dt < 4; ++dt) { const LAS unsigned char* vp = ldsl + V_OFF + (16 * (ts0 + 2 * s5) + 4 * g + q4) * RS + (16 * dt + 4 * p4) * 2; const s16x4 lo = tr_read(vp), hi = tr_read(vp + 16 * RS);
                                const bf16x8 a = (bf16x8){lo[0], lo[1], lo[2], lo[3], hi[0], hi[1], hi[2], hi[3]};
                                o[dt] = __builtin_amdgcn_mfma_f32_16x16x32_bf16(a, pf, o[dt], 0, 0, 0); } }
                        const float il = 1.0f / l;
#pragma unroll
                        for (int dt = 0; dt < 4; ++dt) { v2u w; w.x = pk2(o[dt][0] * il, o[dt][1] * il); w.y = pk2(o[dt][2] * il, o[dt][3] * il); *(GAS v2u*)(qp + 16 * dt + 4 * g) = w; }
                    }
                }
                TOC(7); if (BOTH(base + 1)) GRID_BAR(7);
            }
        }
        if (IN(pG1)) { TIC();
            pg8::Gemm g; pg8::EpiResid E; E.hb = HB; E.ssq = ssq;
            if (gla) g = pg8::Gemm{QKVG + 2048, Wao_t + (size_t)L * D * D, M, D, D, NIN};
            else g = pg8::Gemm{Qb, Wbo_t + (size_t)jb * D * D, M, D, D, D};
            pg8::StaticOrder S; S.init(M, D, G, (int)blockIdx.x);
            pg8::gemm_phase<pg8::EpiResid, pg8::StaticOrder, false, true>(ldsl, g, S, E);
            TOC(8); if (BOTH(pG1)) GRID_BAR(8);
        }
        if (IN(pG1 + 1)) { PHASE_IDS TIC();
            pg8::Gemm g{HB, Wup_t + (size_t)L * FF * D, M, FF, D, D};
            pg8::EpiScale E; E.O = U; E.ldc = FF; E.O2 = nullptr; E.ldc2 = 0; E.split_col = 1 << 30; E.ssq = ssq; E.act = 1;
            pg8::StaticOrder S; S.init(M, FF, G, (int)blockIdx.x);
            { pg8::Unit u0; const bool has = S.next(0, u0); LAS float* rtab = (LAS float*)(ldsl + RING_BYTES);
              if (has && tid < 256) rtab[tid] = pg8::row_rstd(ssq, u0.pm * 256 + tid);
              __syncthreads(); E.rtab = rtab; E.tab_pm = has ? u0.pm : -1; }
            pg8::gemm_phase<pg8::EpiScale, pg8::StaticOrder, true, true>(ldsl, g, S, E);
            TOC(9); if (BOTH(pG1 + 1)) GRID_BAR(9);
        }
        if (IN(pG1 + 2)) { TIC();
            pg8::Gemm g{U, Wdn_t + (size_t)L * D * FF, M, D, FF, FF};
            pg8::EpiResid E; E.hb = HB; E.ssq = ssq;
            pg8::StaticOrder S; S.init(M, D, G, (int)blockIdx.x);
            pg8::gemm_phase<pg8::EpiResid, pg8::StaticOrder, false, true>(ldsl, g, S, E);
            TOC(10); if (BOTH(pG1 + 2)) GRID_BAR(10);
        }
    }
    if (IN(25)) { PHASE_IDS TIC();
        const int gw = vcu * NWAVES + wave, NGW = G * NWAVES;
        for (int m = gw; m < M; m += NGW) {
            const float rs = pg8::row_rstd(ssq, m);
            const GAS v2u* hr = (const GAS v2u*)(HB + (size_t)m * D) + lane; GAS f32x4* orow = (GAS f32x4*)(out + (size_t)m * D) + lane; const f32x4* gr = (const f32x4*)ln_final + lane;
            v2u hvv[4];
#pragma unroll
            for (int j = 0; j < 4; ++j) hvv[j] = hr[64 * j];
#pragma unroll
            for (int j = 0; j < 4; ++j) { const f32x4 gg = gr[64 * j]; orow[64 * j] = (f32x4){bflo(hvv[j].x) * rs * gg[0], bfhi(hvv[j].x) * rs * gg[1], bflo(hvv[j].y) * rs * gg[2], bfhi(hvv[j].y) * rs * gg[3]}; }
        }
    TOC(11); }
#if PROBE_SEL
    if (blockIdx.x == 0) { const unsigned long long te = __builtin_amdgcn_s_memrealtime(); while (__builtin_amdgcn_s_memrealtime() - te < pr_acc * PROBE_MUL) __builtin_amdgcn_s_sleep(8); }
#endif
#undef IN
#undef BOTH
#undef GRID_BAR
}

extern "C" void kernel_launch(void* const* d_in, const int* in_sizes, int n_in, void* d_out, int out_size, void* d_ws, size_t ws_size, hipStream_t stream) {
    static int grid = 0;
    if (grid == 0) {
        if (n_in != 17 || in_sizes[0] != M * D || out_size != M * D || ws_size < WS_END) { fprintf(stderr, "kernel_launch: unexpected shapes (n_in %d, in0 %d, out %d, ws %zu)\n", n_in, n_in > 0 ? in_sizes[0] : -1, out_size, ws_size); grid = -1; return; }
        int dev = 0, cus = 0;
        if (hipGetDevice(&dev) != hipSuccess || hipDeviceGetAttribute(&cus, hipDeviceAttributeMultiprocessorCount, dev) != hipSuccess) { grid = -1; return; }
        if (hipFuncSetAttribute((const void*)yoco_fwd, hipFuncAttributeMaxDynamicSharedMemorySize, LDS_BYTES) != hipSuccess) { fprintf(stderr, "kernel_launch: hipFuncSetAttribute failed\n"); grid = -1; return; }
        (void)hipGetLastError();
        grid = cus;
    }
    if (grid < 0) return;
    if (hipMemsetAsync((char*)d_ws + WS_CTL, 0, CTL_ZERO_BYTES, stream) != hipSuccess) return;
    Args a{};
    for (int i = 0; i < 17; ++i) a.in[i] = (const float*)d_in[i];
    a.out = (float*)d_out; a.ws = (unsigned char*)d_ws;
    if (N_LAUNCHES == 1) {
        a.ph_lo = 0; a.ph_hi = NPH; a.li = 0;
        hipLaunchKernelGGL(yoco_fwd, dim3(grid), dim3(NWAVES * 64), LDS_BYTES, stream, a);
    } else {
        for (int p = 0; p < NPH; ++p) { a.ph_lo = p; a.ph_hi = p + 1; a.li = 0;
            hipLaunchKernelGGL(yoco_fwd, dim3(grid), dim3(NWAVES * 64), LDS_BYTES, stream, a); }
    }
}
```

```cpp
#include <hip/hip_runtime.h>
#include <cstdio>
#include <cstdint>

#ifndef PROBE_SEL
#define PROBE_SEL 0
#endif
#ifndef PROBE_MUL
#define PROBE_MUL 1
#endif
#ifndef MK_N_LAUNCHES
#define MK_N_LAUNCHES 1
#endif

namespace pg8 {
#define PG8_LAS __attribute__((address_space(3)))
typedef unsigned short bf16_t;
typedef short bf16x8 __attribute__((ext_vector_type(8)));
typedef float f32x4 __attribute__((ext_vector_type(4)));
typedef unsigned u32x4 __attribute__((ext_vector_type(4)));
typedef unsigned u32x2 __attribute__((ext_vector_type(2)));
constexpr int BM = 256, BK = 64, HALF = 128, HTB = HALF * BK * 2, STAGE_BYTES = 8 * HTB, NXCD = 8, WGM = 8;

__host__ __device__ __forceinline__ int lds_byte(int r, int c) { const int st = (r >> 4) * 2 + (c >> 5), rr = r & 15, cc = c & 31, ob = rr * 64 + cc * 2; return st * 1024 + (ob ^ (((ob >> 9) & 1) << 5)); }
__host__ __device__ __forceinline__ void stage_rc(int b, int& R, int& C) { const int st = b / 1024, sb = b % 1024, swz = sb ^ (((sb >> 9) & 1) << 5); R = (st >> 1) * 16 + swz / 64; C = (st & 1) * 32 + (swz % 64) / 2; }
__host__ __device__ __forceinline__ int perm32(int rho) { const int n = rho >> 4, i = rho & 15; return 8 * (i >> 2) + 4 * n + (i & 3); }

struct Unit { int pm, pn; };
struct Gemm { const bf16_t* A; const bf16_t* Bt; int M, N, K, lda; };

struct StaticOrder {
    int nM, nN, nwg, G, c;
    __host__ __device__ void init(int M, int N, int G_, int c_) { nM = M / BM; nN = N / BM; nwg = nM * nN; G = G_; c = c_; }
    __host__ __device__ bool next(int i, Unit& u) const {
        const long L = (long)i * G + c; if (L >= nwg) return false;
        int wgid = (int)L; { const int q = nwg / NXCD, r = nwg % NXCD, xcd = wgid % NXCD, off = wgid / NXCD; wgid = (xcd < r ? xcd * (q + 1) : r * (q + 1) + (xcd - r) * q) + off; }
        const int nig = WGM * nN, gid = wgid / nig, fm = gid * WGM, gsz = (nM - fm) < WGM ? (nM - fm) : WGM;
        u.pm = fm + ((wgid % nig) % gsz); u.pn = (wgid % nig) / gsz; return true;
    }
    __device__ __forceinline__ void a_ready(const Unit&) const {}
    __device__ __forceinline__ void done(const Unit&) const {}
};

__device__ __forceinline__ unsigned cvt_pk_bf16(float lo, float hi) { unsigned r; asm volatile("v_cvt_pk_bf16_f32 %0, %1, %2" : "=v"(r) : "v"(lo), "v"(hi)); return r; }

constexpr int MROWS = 16384;
__device__ __forceinline__ float row_rstd(const float* ssq, int row) { const float s = (ssq[row] + ssq[MROWS + row]) + (ssq[2 * MROWS + row] + ssq[3 * MROWS + row]); return 1.0f / sqrtf(s * (1.0f / 1024.0f) + 1e-6f); }

__device__ __forceinline__ unsigned dpp_ror8(unsigned v) { return (unsigned)__builtin_amdgcn_mov_dpp((int)v, 0x128, 0xf, 0xf, false); }
__device__ __forceinline__ float dpp_ror8f(float v) { return __builtin_bit_cast(float, __builtin_amdgcn_mov_dpp(__builtin_bit_cast(int, v), 0x128, 0xf, 0xf, false)); }

struct EpiScale {
    static constexpr bool PERM = true, AFTER_DRAIN = false;
    bf16_t* O; int ldc; bf16_t* O2; int ldc2; int split_col; const float* ssq; int act; const PG8_LAS float* rtab; int tab_pm;
    __device__ __forceinline__ void operator()(const f32x4 (&acc)[2][2][4][2], const Unit& u, int wr, int wc, int fr, int fq) const {
        int colt = u.pn * BM; bf16_t* base = O; int ld = ldc;
        if (colt >= split_col) { base = O2; colt -= split_col; ld = ldc2; }
        const bool lo = fr < 8;
        const int col0 = colt + wc * 64 + (fr >> 3) * 32 + 8 * fq;
        const __amdgpu_buffer_rsrc_t rsrc = __builtin_amdgcn_make_buffer_rsrc((void*)base, 0, 0x7fffffff, 0x00020000);
        float rs[2][4];
        if (u.pm == tab_pm) {
#pragma unroll
            for (int ai = 0; ai < 2; ++ai)
#pragma unroll
                for (int m = 0; m < 4; ++m) rs[ai][m] = rtab[wr * 64 + ai * HALF + m * 16 + fr];
        } else {
#pragma unroll
            for (int ai = 0; ai < 2; ++ai)
#pragma unroll
                for (int m = 0; m < 4; ++m) rs[ai][m] = row_rstd(ssq, u.pm * BM + wr * 64 + ai * HALF + m * 16 + fr);
        }
#pragma unroll
        for (int ai = 0; ai < 2; ++ai)
#pragma unroll
            for (int m = 0; m < 4; ++m) { const float r = rs[ai][m]; u32x4 Y[2];
#pragma unroll
                for (int bj = 0; bj < 2; ++bj) { f32x4 v0 = acc[ai][bj][m][0] * r, v1 = acc[ai][bj][m][1] * r;
                    if (act == 1) {
#pragma unroll
                        for (int e = 0; e < 4; ++e) { float a = fmaxf(v0[e], 0.f); v0[e] = a * a; float b = fmaxf(v1[e], 0.f); v1[e] = b * b; } }
                    Y[bj].x = cvt_pk_bf16(v0[0], v0[1]); Y[bj].y = cvt_pk_bf16(v0[2], v0[3]); Y[bj].z = cvt_pk_bf16(v1[0], v1[1]); Y[bj].w = cvt_pk_bf16(v1[2], v1[3]); }
                u32x4 keep, send, recv;
#pragma unroll
                for (int e = 0; e < 4; ++e) { keep[e] = lo ? Y[0][e] : Y[1][e]; send[e] = lo ? Y[1][e] : Y[0][e]; }
#pragma unroll
                for (int e = 0; e < 4; ++e) recv[e] = dpp_ror8(send[e]);
                u32x4 d1, d2;
#pragma unroll
                for (int e = 0; e < 4; ++e) { d1[e] = lo ? keep[e] : recv[e]; d2[e] = lo ? recv[e] : keep[e]; }
                const int row1 = u.pm * BM + wr * 64 + ai * HALF + m * 16 + (fr & 7);
                const unsigned b1 = (unsigned)(row1 * ld + col0) * 2u, b2 = b1 + (unsigned)(8 * ld) * 2u;
                __builtin_amdgcn_raw_buffer_store_b128(d1, rsrc, b1, 0, 16);
                __builtin_amdgcn_raw_buffer_store_b128(d2, rsrc, b2, 0, 16); }
    }
};

struct EpiResid {
    static constexpr bool PERM = true, AFTER_DRAIN = true;
    bf16_t* hb; float* ssq;
    __device__ __forceinline__ void fused(const f32x4 (&acc)[2][2][4][2], const Unit& u, int wr, int wc, int fr, int fq, PG8_LAS unsigned char* lds, int tid) const {
        PG8_LAS float* P = (PG8_LAS float*)lds;
        const bool lo = fr < 8;
        const int col0 = u.pn * BM + wc * 64 + (fr >> 3) * 32 + 8 * fq, rloc = wr * 64 + (fr & 7);
        const __amdgpu_buffer_rsrc_t rsrc = __builtin_amdgcn_make_buffer_rsrc((void*)hb, 0, 0x7fffffff, 0x00020000);
        u32x4 h1[2][4], h2[2][4];
#pragma unroll
        for (int ai = 0; ai < 2; ++ai)
#pragma unroll
            for (int m = 0; m < 4; ++m) { const size_t o1 = (size_t)(u.pm * BM + rloc + ai * HALF + m * 16) * 1024 + col0; h1[ai][m] = *(const u32x4*)(hb + o1); h2[ai][m] = *(const u32x4*)(hb + o1 + 8 * 1024); }
        asm volatile("" ::: "memory");
#pragma unroll
        for (int ai = 0; ai < 2; ++ai)
#pragma unroll
            for (int m = 0; m < 4; ++m) {
                float keep[8], send[8], recv[8];
#pragma unroll
                for (int e = 0; e < 4; ++e) { keep[e] = lo ? acc[ai][0][m][0][e] : acc[ai][1][m][0][e]; keep[4 + e] = lo ? acc[ai][0][m][1][e] : acc[ai][1][m][1][e];
                                              send[e] = lo ? acc[ai][1][m][0][e] : acc[ai][0][m][0][e]; send[4 + e] = lo ? acc[ai][1][m][1][e] : acc[ai][0][m][1][e]; }
#pragma unroll
                for (int e = 0; e < 8; ++e) recv[e] = dpp_ror8f(send[e]);
                float ss1 = 0.f, ss2 = 0.f; u32x4 w1, w2;
#pragma unroll
                for (int e = 0; e < 4; ++e) { const float a0 = lo ? keep[2 * e] : recv[2 * e], a1 = lo ? keep[2 * e + 1] : recv[2 * e + 1], c0 = lo ? recv[2 * e] : keep[2 * e], c1 = lo ? recv[2 * e + 1] : keep[2 * e + 1];
                    const unsigned x = h1[ai][m][e], y = h2[ai][m][e];
                    w1[e] = cvt_pk_bf16(__builtin_bit_cast(float, x << 16) + a0, __builtin_bit_cast(float, x & 0xffff0000u) + a1);
                    w2[e] = cvt_pk_bf16(__builtin_bit_cast(float, y << 16) + c0, __builtin_bit_cast(float, y & 0xffff0000u) + c1);
                    const float p0 = __builtin_bit_cast(float, w1[e] << 16), p1 = __builtin_bit_cast(float, w1[e] & 0xffff0000u), q0 = __builtin_bit_cast(float, w2[e] << 16), q1 = __builtin_bit_cast(float, w2[e] & 0xffff0000u);
                    ss1 += p0 * p0 + p1 * p1; ss2 += q0 * q0 + q1 * q1; }
                const int rl = rloc + ai * HALF + m * 16; const unsigned b1 = (unsigned)((u.pm * BM + rl) * 1024 + col0) * 2u;
                __builtin_amdgcn_raw_buffer_store_b128(w1, rsrc, b1, 0, 16);
                __builtin_amdgcn_raw_buffer_store_b128(w2, rsrc, b1 + 8 * 1024 * 2, 0, 16);
                ss1 += __shfl_xor(ss1, 8); ss1 += __shfl_xor(ss1, 16); ss1 += __shfl_xor(ss1, 32);
                ss2 += __shfl_xor(ss2, 8); ss2 += __shfl_xor(ss2, 16); ss2 += __shfl_xor(ss2, 32);
                if (lo && fq == 0) { P[rl * 4 + wc] = ss1; P[(rl + 8) * 4 + wc] = ss2; } }
        asm volatile("s_waitcnt lgkmcnt(0)" ::: "memory"); __builtin_amdgcn_s_barrier(); asm volatile("" ::: "memory");
        if (tid < 256) { const PG8_LAS f32x4* p4 = (const PG8_LAS f32x4*)P + tid; const f32x4 v = *p4; ssq[(size_t)u.pn * MROWS + u.pm * BM + tid] = (v[0] + v[1]) + (v[2] + v[3]); }
    }
};

template <class Epi, class Sched, bool ALIGN_EPI = false, bool SP2 = false>
__device__ __forceinline__ void gemm_phase(PG8_LAS unsigned char* lds, const Gemm g, const Sched& S, const Epi& E) {
    int tid_ = threadIdx.x; asm volatile("" : "+v"(tid_)); const int tid = tid_, wid = __builtin_amdgcn_readfirstlane(tid >> 6), lane = tid & 63, wr = wid >> 2, wc = wid & 3, fr = lane & 15, fq = lane >> 4;
    const int K = g.K, nt = K / BK, lda = g.lda;
    unsigned voffA[2], voffB[2];
#pragma unroll
    for (int i = 0; i < 2; ++i) { int R, C; stage_rc(tid * 16 + i * 8192, R, C); const int Rb = Epi::PERM ? (64 * (R >> 5) + perm32(R & 31)) : R;
        voffA[i] = (unsigned)(R * lda + C) * 2u; voffB[i] = (unsigned)(Rb * K + C) * 2u; }
    const size_t kstep = (size_t)(BK * 2);
    const size_t hstepA = (size_t)HALF * lda * 2, hstepB = (size_t)(Epi::PERM ? 32 : HALF) * K * 2;
    const size_t tstepA = 2 * hstepA, tstepB = (size_t)BM * K * 2;
    const unsigned ldsw = (unsigned)wid * 1024u;
    const int aoff = lds_byte(wr * 64 + fr, fq * 8), boff = lds_byte(wc * 32 + fr, fq * 8);
#define PG8_SA(b, h) (((b) * 2 + (h)) * HTB)
#define PG8_SB(b, h) ((4 + (b) * 2 + (h)) * HTB)
#define PG8_STAGE(bufoff, gbase, voff) do { _Pragma("unroll") for (int _i = 0; _i < 2; ++_i) \
        __builtin_amdgcn_global_load_lds((const unsigned*)((const char*)(gbase) + (voff)[_i]), (PG8_LAS unsigned*)(lds + (bufoff) + ldsw + _i * 8192), 16, 0, 0); } while (0)
#define PG8_LDA(dst, b, h) do { _Pragma("unroll") for (int m = 0; m < 4; ++m) _Pragma("unroll") for (int k = 0; k < 2; ++k) dst[m][k] = *(const PG8_LAS bf16x8*)(lds + PG8_SA(b, h) + aoff + m * 2048 + k * 1024); } while (0)
#define PG8_LDB(dst, b, h) do { _Pragma("unroll") for (int n = 0; n < 2; ++n) _Pragma("unroll") for (int k = 0; k < 2; ++k) dst[n][k] = *(const PG8_LAS bf16x8*)(lds + PG8_SB(b, h) + boff + n * 2048 + k * 1024); } while (0)
#define PG8_MMA(ai, bj, At, Bt) do { __builtin_amdgcn_s_setprio(1); _Pragma("unroll") for (int m = 0; m < 4; ++m) _Pragma("unroll") for (int n = 0; n < 2; ++n) _Pragma("unroll") for (int k = 0; k < 2; ++k) \
        acc[ai][bj][m][n] = __builtin_amdgcn_mfma_f32_16x16x32_bf16(Bt[n][k], At[m][k], acc[ai][bj][m][n], 0, 0, 0); __builtin_amdgcn_s_setprio(0); } while (0)
#define PG8_WAIT_V(n) asm volatile("s_waitcnt vmcnt(" #n ")" ::: "memory")
#define PG8_WAIT_L(n) asm volatile("s_waitcnt lgkmcnt(" #n ")" ::: "memory")
#define PG8_BAR __builtin_amdgcn_s_barrier()
#define PG8_SCHED __builtin_amdgcn_sched_barrier(0)
    Unit cur, nxt; int ui = 0;
    if (!S.next(0, cur)) return;
    f32x4 acc[2][2][4][2];
#pragma unroll
    for (int a = 0; a < 2; ++a)
#pragma unroll
        for (int b = 0; b < 2; ++b)
#pragma unroll
            for (int m = 0; m < 4; ++m)
#pragma unroll
                for (int n = 0; n < 2; ++n) acc[a][b][m][n] = (f32x4){0.f, 0.f, 0.f, 0.f};
    bf16x8 At[4][2], B0[2][2], B1[2][2];
    const char* cA = (const char*)g.A + (size_t)cur.pm * tstepA; const char* cB = (const char*)g.Bt + (size_t)cur.pn * tstepB;
    S.a_ready(cur);
    if constexpr (SP2) {
        PG8_STAGE(PG8_SB(0, 0), cB, voffB); PG8_STAGE(PG8_SB(0, 1), cB + hstepB, voffB); PG8_STAGE(PG8_SA(0, 0), cA, voffA); PG8_STAGE(PG8_SA(0, 1), cA + hstepA, voffA);
        if (wr == 1) PG8_BAR;
        PG8_WAIT_V(2); PG8_BAR;
        PG8_STAGE(PG8_SB(1, 0), cB + kstep, voffB); PG8_STAGE(PG8_SA(1, 0), cA + kstep, voffA); PG8_STAGE(PG8_SB(1, 1), cB + hstepB + kstep, voffB);
        PG8_WAIT_V(6); PG8_BAR;
    } else {
        PG8_STAGE(PG8_SB(0, 0), cB, voffB); PG8_STAGE(PG8_SA(0, 0), cA, voffA); PG8_STAGE(PG8_SB(0, 1), cB + hstepB, voffB); PG8_STAGE(PG8_SA(0, 1), cA + hstepA, voffA);
        if (wr == 1) PG8_BAR;
        PG8_WAIT_V(4); PG8_BAR;
        PG8_STAGE(PG8_SB(1, 0), cB + kstep, voffB); PG8_STAGE(PG8_SA(1, 0), cA + kstep, voffA); PG8_STAGE(PG8_SB(1, 1), cB + hstepB + kstep, voffB);
        PG8_WAIT_V(6); PG8_BAR;
    }
    for (;;) {
        const bool has_next = S.next(ui + 1, nxt);
        const char* nA = has_next ? (const char*)g.A + (size_t)nxt.pm * tstepA : cA; const char* nB = has_next ? (const char*)g.Bt + (size_t)nxt.pn * tstepB : cB;
        for (int t = 0; t < nt; t += 2) {
            const bool last = (t == nt - 2);
            const char* a1 = cA + (size_t)(t + 1) * kstep;
            const char* a2 = last ? nA : cA + (size_t)(t + 2) * kstep; const char* b2 = last ? nB : cB + (size_t)(t + 2) * kstep;
            const char* a3 = a2 + kstep; const char* b3 = b2 + kstep;
            if (last && has_next) S.a_ready(nxt);
            if constexpr (SP2) {
            PG8_LDB(B0, 0, 0); PG8_LDB(B1, 0, 1); PG8_SCHED; PG8_LDA(At, 0, 0); PG8_STAGE(PG8_SA(1, 1), a1 + hstepA, voffA);
            PG8_WAIT_V(8); PG8_WAIT_L(0); PG8_BAR; PG8_MMA(0, 0, At, B0); PG8_MMA(0, 1, At, B1); PG8_BAR; PG8_SCHED;
            PG8_LDA(At, 0, 1); PG8_STAGE(PG8_SB(0, 0), b2, voffB); PG8_STAGE(PG8_SB(0, 1), b2 + hstepB, voffB); PG8_STAGE(PG8_SA(0, 0), a2, voffA);
            PG8_WAIT_V(8); PG8_WAIT_L(0); PG8_BAR; PG8_MMA(1, 0, At, B0); PG8_MMA(1, 1, At, B1); PG8_BAR; PG8_SCHED;
            PG8_LDB(B0, 1, 0); PG8_LDB(B1, 1, 1); PG8_SCHED; PG8_LDA(At, 1, 0); PG8_STAGE(PG8_SA(0, 1), a2 + hstepA, voffA);
            PG8_WAIT_V(8); PG8_WAIT_L(0); PG8_BAR; PG8_MMA(0, 0, At, B0); PG8_MMA(0, 1, At, B1); PG8_BAR; PG8_SCHED;
            PG8_LDA(At, 1, 1); PG8_STAGE(PG8_SB(1, 0), b3, voffB); PG8_STAGE(PG8_SB(1, 1), b3 + hstepB, voffB); PG8_STAGE(PG8_SA(1, 0), a3, voffA);
            PG8_WAIT_V(8); PG8_WAIT_L(0); PG8_BAR; PG8_MMA(1, 0, At, B0); PG8_MMA(1, 1, At, B1); PG8_BAR; PG8_SCHED;
            } else {
            PG8_LDB(B0, 0, 0); PG8_SCHED; PG8_LDA(At, 0, 0); PG8_STAGE(PG8_SA(1, 1), a1 + hstepA, voffA);
            PG8_WAIT_L(8); PG8_BAR; PG8_WAIT_L(0); PG8_MMA(0, 0, At, B0); PG8_BAR; PG8_SCHED;
            PG8_LDB(B1, 0, 1); PG8_STAGE(PG8_SB(0, 0), b2, voffB);
            PG8_BAR; PG8_WAIT_L(0); PG8_MMA(0, 1, At, B1); PG8_BAR;
            PG8_LDA(At, 0, 1); PG8_STAGE(PG8_SA(0, 0), a2, voffA);
            PG8_BAR; PG8_WAIT_L(0); PG8_MMA(1, 0, At, B0); PG8_BAR; PG8_SCHED;
            PG8_STAGE(PG8_SB(0, 1), b2 + hstepB, voffB);
            PG8_WAIT_V(6); PG8_BAR; PG8_MMA(1, 1, At, B1); PG8_BAR;
            PG8_LDB(B0, 1, 0); PG8_SCHED; PG8_LDA(At, 1, 0); PG8_STAGE(PG8_SA(0, 1), a2 + hstepA, voffA);
            PG8_WAIT_L(8); PG8_BAR; PG8_WAIT_L(0); PG8_MMA(0, 0, At, B0); PG8_BAR; PG8_SCHED;
            PG8_LDB(B1, 1, 1); PG8_STAGE(PG8_SB(1, 0), b3, voffB);
            PG8_BAR; PG8_WAIT_L(0); PG8_MMA(0, 1, At, B1); PG8_BAR;
            PG8_LDA(At, 1, 1); PG8_STAGE(PG8_SA(1, 0), a3, voffA);
            PG8_BAR; PG8_WAIT_L(0); PG8_MMA(1, 0, At, B0); PG8_BAR; PG8_SCHED;
            PG8_STAGE(PG8_SB(1, 1), b3 + hstepB, voffB);
            PG8_WAIT_V(6); PG8_BAR; PG8_MMA(1, 1, At, B1); PG8_BAR;
            }
        }
        if constexpr (ALIGN_EPI) { if (wr == 0) PG8_BAR; }
        if constexpr (!Epi::AFTER_DRAIN) { E(acc, cur, wr, wc, fr, fq); S.done(cur); }
        if (!has_next) break;
#pragma unroll
        for (int a = 0; a < 2; ++a)
#pragma unroll
            for (int b = 0; b < 2; ++b)
#pragma unroll
                for (int m = 0; m < 4; ++m)
#pragma unroll
                    for (int n = 0; n < 2; ++n) acc[a][b][m][n] = (f32x4){0.f, 0.f, 0.f, 0.f};
        cur = nxt; cA = nA; cB = nB; ++ui;
        if constexpr (ALIGN_EPI) { if (wr == 1) PG8_BAR; }
    }
    PG8_WAIT_V(0);
    if constexpr (!ALIGN_EPI) { if (wr == 0) PG8_BAR; }
    PG8_BAR;
    if constexpr (Epi::AFTER_DRAIN) { E.fused(acc, cur, wr, wc, fr, fq, lds, tid); S.done(cur); }
#undef PG8_SA
#undef PG8_SB
#undef PG8_STAGE
#undef PG8_LDA
#undef PG8_LDB
#undef PG8_MMA
#undef PG8_WAIT_V
#undef PG8_WAIT_L
#undef PG8_BAR
#undef PG8_SCHED
}
}

constexpr int NWAVES = 8;
constexpr int N_LAUNCHES = MK_N_LAUNCHES;
constexpr int NPH = 26;
constexpr int M = 16384, D = 1024, T = 4096, FF = 4096, NIN = 3072, APROJ = 3088, KD = 512;
constexpr float EPS = 1e-6f, LOG2E = 1.4426950408889634f;

constexpr size_t MiB = 1u << 20;
constexpr size_t WS_CTL = 0, CTL_ZERO_BYTES = 1 * MiB;
constexpr size_t WS_SSQ = 1 * MiB;
constexpr size_t WS_WG = 2 * MiB;
constexpr size_t WS_BEND = 2 * MiB + 65536;
constexpr size_t WS_WIN = 3 * MiB;
constexpr size_t WS_KV = 3 * MiB;
constexpr size_t WS_WAO = 15 * MiB;
constexpr size_t WS_WUP = 19 * MiB;
constexpr size_t WS_WDN = 51 * MiB;
constexpr size_t WS_WQ = 83 * MiB;
constexpr size_t WS_WQ1 = WS_WQ + (size_t)1280 * 1024 * 2;
constexpr size_t WS_WBO = 88 * MiB;
constexpr size_t WS_HB = 92 * MiB;
constexpr size_t WS_U = 124 * MiB;
constexpr size_t WS_BCUM = WS_U + 96 * MiB;
constexpr size_t WS_END = 252 * MiB;
constexpr int CW_BAR = 4096;

constexpr int LDS_BYTES = 147456;
constexpr int RING_BYTES = 131072, LDSCTL_OFF = 143360, MISC_OFF = LDSCTL_OFF + 320;

#define GAS __attribute__((address_space(1)))
#define LAS __attribute__((address_space(3)))
typedef unsigned short bf16;
typedef unsigned v4u __attribute__((ext_vector_type(4)));
typedef unsigned v2u __attribute__((ext_vector_type(2)));
typedef float f32x4 __attribute__((ext_vector_type(4)));
typedef GAS unsigned gu32;
typedef short bf16x8 __attribute__((ext_vector_type(8)));
typedef short s16x4 __attribute__((ext_vector_type(4)));
__device__ __forceinline__ s16x4 tr_read(const LAS unsigned char* p) { return __builtin_bit_cast(s16x4, __builtin_amdgcn_ds_read_tr16_b64_v4i16((LAS s16x4*)p)); }
#define RLX_AGENT __ATOMIC_RELAXED, __HIP_MEMORY_SCOPE_AGENT
#define LDS_WAIT() asm volatile("s_waitcnt lgkmcnt(0)" ::: "memory")
#define VM_WAIT() asm volatile("s_waitcnt vmcnt(0)" ::: "memory")
__device__ __forceinline__ unsigned f2bf(float f) { unsigned u = __builtin_bit_cast(unsigned, f); return (u + 0x7fffu + ((u >> 16) & 1u)) >> 16; }
__device__ __forceinline__ unsigned pk2(float lo, float hi) { return f2bf(lo) | (f2bf(hi) << 16); }
__device__ __forceinline__ float bf2f(unsigned short b) { return __builtin_bit_cast(float, (unsigned)b << 16); }
__device__ __forceinline__ float bflo(unsigned w) { return __builtin_bit_cast(float, w << 16); }
__device__ __forceinline__ float bfhi(unsigned w) { return __builtin_bit_cast(float, w & 0xffff0000u); }

#define XB_TMO      128
#define XB_XCNT(j)  (256  + 64 * (j))
#define XB_XSUB(j)  (1280 + 64 * (j))
#define XB_XGEN(j)  (2304 + 64 * (j))
#define XB_TOP      3328
#define XB_TOPGEN   3392
#define XCD_BAR_WORDS 3456
#define XB_SPIN_CAP (1u << 18)
__device__ __forceinline__ unsigned xb_ld(unsigned* p)              { return __hip_atomic_load(p, __ATOMIC_RELAXED, __HIP_MEMORY_SCOPE_AGENT); }
__device__ __forceinline__ unsigned xb_add(unsigned* p, unsigned v) { return __hip_atomic_fetch_add(p, v, __ATOMIC_RELAXED, __HIP_MEMORY_SCOPE_AGENT); }
__device__ __forceinline__ unsigned xb_xcc_id() { return (unsigned)__builtin_amdgcn_s_getreg((3 << 11) | 20) & 0xFu; }
#define XB_SPIN(cond, bar) do { unsigned _sp = 0; while (cond) { __builtin_amdgcn_s_sleep(1); \
    if ((++_sp & 255u) == 0u) { if (xb_ld(&(bar)[XB_TMO])) break; if (_sp > XB_SPIN_CAP) { atomicAdd(&(bar)[XB_TMO], 1u); break; } } } } while (0)
struct XcdBarrier { unsigned* bar; unsigned x; volatile LAS unsigned* st; };
__device__ __forceinline__ XcdBarrier xcd_barrier_post(unsigned* bar, volatile LAS unsigned* st) {
    XcdBarrier b; b.bar = bar; b.x = xb_xcc_id(); b.st = st;
    if (threadIdx.x == 0) (void)xb_add(&bar[XB_XCNT(b.x)], 1u);
    return b;
}
__device__ __forceinline__ void xcd_barrier_complete(unsigned* bar, unsigned x, unsigned& nloc, unsigned& nx) {
    const unsigned G = gridDim.x * gridDim.y * gridDim.z;
    unsigned sum, cnt, mine, sp = 0u;
    for (;;) {
        sum = 0u; cnt = 0u; mine = 0u;
#pragma unroll
        for (unsigned j = 0; j < 16; ++j) { const unsigned c = xb_ld(&bar[XB_XCNT(j)]); sum += c; cnt += (c > 0u) ? 1u : 0u; mine = (j == x) ? c : mine; }
        if (sum == G) break;
        __builtin_amdgcn_s_sleep(1);
        if ((++sp & 255u) == 0u) { if (xb_ld(&bar[XB_TMO])) break; if (sp > XB_SPIN_CAP) { atomicAdd(&bar[XB_TMO], 1u); break; } }
    }
    nloc = mine > 0u ? mine : 1u; nx = cnt > 0u ? cnt : 1u;
}
__device__ __forceinline__ void xcd_barrier(const XcdBarrier& b) {
    asm volatile("s_waitcnt vmcnt(0)" ::: "memory");
    __syncthreads();
    if (threadIdx.x == 0) {
        unsigned* bar = b.bar;
        __builtin_amdgcn_s_waitcnt(0);
        unsigned nloc = b.st[0], nx = b.st[1];
        if (nloc == 0u) { xcd_barrier_complete(bar, b.x, nloc, nx); b.st[0] = nloc; b.st[1] = nx; }
        const unsigned old = xb_add(&bar[XB_XSUB(b.x)], 1u);
        const unsigned gen = old / nloc;
        if (old + 1u == (gen + 1u) * nloc) {
            __builtin_amdgcn_fence(__ATOMIC_RELEASE, "agent");
            asm volatile("s_waitcnt vmcnt(0)" ::: "memory");
            const unsigned og = xb_add(&bar[XB_TOP], 1u);
            const unsigned tg = og / nx;
            if (og + 1u == (tg + 1u) * nx) xb_add(&bar[XB_TOPGEN], 1u);
            else XB_SPIN(xb_ld(&bar[XB_TOPGEN]) == tg, bar);
            __builtin_amdgcn_fence(__ATOMIC_ACQUIRE, "agent");
            xb_add(&bar[XB_XGEN(b.x)], 1u);
            asm volatile("s_waitcnt vmcnt(0)" ::: "memory");
        } else {
            XB_SPIN(xb_ld(&bar[XB_XGEN(b.x)]) == gen, bar);
            __builtin_amdgcn_fence(__ATOMIC_ACQUIRE, "agent");
            asm volatile("s_waitcnt vmcnt(0)" ::: "memory");
        }
    }
    __syncthreads();
}

__device__ __forceinline__ void bc_unpack(v4u w, f32x4& a, f32x4& b) { const float s = 1.0f / 2048.0f;
    a[0] = (float)(short)(w.x & 0xffffu) * s; a[1] = (float)((int)w.x >> 16) * s; a[2] = (float)(short)(w.y & 0xffffu) * s; a[3] = (float)((int)w.y >> 16) * s;
    b[0] = (float)(short)(w.z & 0xffffu) * s; b[1] = (float)((int)w.z >> 16) * s; b[2] = (float)(short)(w.w & 0xffffu) * s; b[3] = (float)((int)w.w >> 16) * s; }
__device__ __forceinline__ float wave_sum(float v) {
#pragma unroll
    for (int o = 1; o < 64; o <<= 1) v += __shfl_xor(v, o);
    return v;
}

struct P0Item { const float* W; int ldw, K, nblk; bf16* WT; const float* gain; float scale; int nscale, item; };
__device__ __forceinline__ void p0_load(const P0Item& d, int lane, f32x4 (&v)[8], float (&gn)[4]) {
    const GAS float* W = (const GAS float*)d.W;
    const int kb = d.item / d.nblk, nb = d.item % d.nblk, k0 = 64 * kb, n0 = 32 * nb, l15 = lane & 15, g = lane >> 4;
#pragma unroll
    for (int t = 0; t < 4; ++t) { const int k = k0 + 8 * (l15 >> 2) + 4 * (t & 1) + (l15 & 3) + 32 * (t >> 1); const GAS float* p = W + (size_t)k * d.ldw + n0 + 4 * g;
        v[2 * t] = *(const GAS f32x4*)p; v[2 * t + 1] = *(const GAS f32x4*)(p + 16); gn[t] = d.gain ? d.gain[k] : 1.0f; }
}
__device__ __forceinline__ void p0_finish(const P0Item& d, int lane, const f32x4 (&v)[8], const float (&gn)[4], bf16x8 B1, bf16x8 B2) {
    const int kb = d.item / d.nblk, nb = d.item % d.nblk, k0 = 64 * kb, n0 = 32 * nb, l15 = lane & 15, g = lane >> 4;
    const float sc = n0 < d.nscale ? d.scale : 1.0f;
    f32x4 D1[4], D2[4];
#pragma unroll
    for (int t = 0; t < 4; ++t) { const float m = gn[t] * sc; v4u a; a.x = pk2(v[2 * t][0] * m, v[2 * t][1] * m); a.y = pk2(v[2 * t][2] * m, v[2 * t][3] * m); a.z = pk2(v[2 * t + 1][0] * m, v[2 * t + 1][1] * m); a.w = pk2(v[2 * t + 1][2] * m, v[2 * t + 1][3] * m);
        const bf16x8 af = __builtin_bit_cast(bf16x8, a);
        D1[t] = __builtin_amdgcn_mfma_f32_16x16x32_bf16(af, B1, (f32x4){0.f, 0.f, 0.f, 0.f}, 0, 0, 0); D2[t] = __builtin_amdgcn_mfma_f32_16x16x32_bf16(af, B2, (f32x4){0.f, 0.f, 0.f, 0.f}, 0, 0, 0); }
    GAS bf16* o1 = (GAS bf16*)d.WT + (size_t)(n0 + l15) * d.K + k0 + 8 * g; GAS bf16* o2 = o1 + (size_t)16 * d.K;
    v4u w;
    w.x = pk2(D1[0][0], D1[0][1]); w.y = pk2(D1[0][2], D1[0][3]); w.z = pk2(D1[1][0], D1[1][1]); w.w = pk2(D1[1][2], D1[1][3]); *(GAS v4u*)o1 = w;
    w.x = pk2(D1[2][0], D1[2][1]); w.y = pk2(D1[2][2], D1[2][3]); w.z = pk2(D1[3][0], D1[3][1]); w.w = pk2(D1[3][2], D1[3][3]); *(GAS v4u*)(o1 + 32) = w;
    w.x = pk2(D2[0][0], D2[0][1]); w.y = pk2(D2[0][2], D2[0][3]); w.z = pk2(D2[1][0], D2[1][1]); w.w = pk2(D2[1][2], D2[1][3]); *(GAS v4u*)o2 = w;
    w.x = pk2(D2[2][0], D2[2][1]); w.y = pk2(D2[2][2], D2[2][3]); w.z = pk2(D2[3][0], D2[3][1]); w.w = pk2(D2[3][2], D2[3][3]); *(GAS v4u*)(o2 + 32) = w;
}

struct Args { const float* in[17]; float* out; unsigned char* ws; int ph_lo, ph_hi, li, pad; };

__device__ __forceinline__ float logsigmoidf(float z) { return fminf(z, 0.f) - log1pf(__expf(-fabsf(z))); }

__global__ void __launch_bounds__(NWAVES * 64, 2) yoco_fwd(Args args) {
    extern __shared__ __attribute__((aligned(16))) unsigned char lds[];
    LAS unsigned char* ldsl = (LAS unsigned char*)lds;
    volatile LAS unsigned* MISC = (volatile LAS unsigned*)(ldsl + MISC_OFF);
    const int tid0 = threadIdx.x, lane0 = tid0 & 63, wave0 = __builtin_amdgcn_readfirstlane(tid0 >> 6);
#define PHASE_IDS int tid = threadIdx.x; asm volatile("" : "+v"(tid)); const int lane = tid & 63, wave = __builtin_amdgcn_readfirstlane(tid >> 6); (void)lane; (void)wave;
    const int G = gridDim.x; const int bx = blockIdx.x; const int vcu = (G % 8 == 0) ? (bx % 8) * (G / 8) + bx / 8 : bx;
    unsigned char* ws = args.ws;
    gu32* ctl = (gu32*)(ws + WS_CTL);
    const float* x = args.in[0]; const float* a_w_in = args.in[1]; const float* a_w_gk2 = args.in[2]; const float* a_b_gk = args.in[3]; const float* a_onorm = args.in[4];
    const float* a_w_out = args.in[5]; const float* kv_norm = args.in[6]; const float* w_kv = args.in[7]; const float* b_w_q = args.in[8]; const float* b_sinks = args.in[9];
    const float* b_w_out = args.in[10]; const float* rel_table = args.in[11]; const float* ln_mix = args.in[12]; const float* ln_mlp = args.in[13];
    const float* w_up = args.in[14]; const float* w_down = args.in[15]; const float* ln_final = args.in[16];
    float* out = args.out;
    float* ssq = (float*)(ws + WS_SSQ);
    bf16* Wg_t = (bf16*)(ws + WS_WG); float* BendG = (float*)(ws + WS_BEND);
    bf16* Win_t = (bf16*)(ws + WS_WIN); bf16* KVb = (bf16*)(ws + WS_KV); bf16* Wao_t = (bf16*)(ws + WS_WAO); bf16* Wup_t = (bf16*)(ws + WS_WUP); bf16* Wdn_t = (bf16*)(ws + WS_WDN);
    bf16* Wq0_t = (bf16*)(ws + WS_WQ); bf16* Wq1_t = (bf16*)(ws + WS_WQ1); bf16* Wbo_t = (bf16*)(ws + WS_WBO);
    bf16* HB = (bf16*)(ws + WS_HB); bf16* Sst = (bf16*)out;
    bf16* U = (bf16*)(ws + WS_U); bf16* QKVG = (bf16*)(ws + WS_U); bf16* Qb = (bf16*)(ws + WS_U); short* BCUM = (short*)(ws + WS_BCUM);

    for (int u = tid0; u < (LDS_BYTES - LDSCTL_OFF) / 4; u += NWAVES * 64) ((LAS unsigned*)(ldsl + LDSCTL_OFF))[u] = 0u;
    __syncthreads();
    XcdBarrier bar; bar.bar = (unsigned*)(ctl + CW_BAR) + args.li * XCD_BAR_WORDS; bar.x = 0; bar.st = nullptr;
    if (N_LAUNCHES != NPH) bar = xcd_barrier_post((unsigned*)(ctl + CW_BAR) + args.li * XCD_BAR_WORDS, MISC + 8);
#if PROBE_SEL
    unsigned long long pr_acc = 0, pr_t0 = 0, pr_tb = 0;
#define TIC() do { pr_t0 = __builtin_amdgcn_s_memrealtime(); } while (0)
#define TOC(cls) do { if ((PROBE_SEL >> (cls)) & 1) pr_acc += __builtin_amdgcn_s_memrealtime() - pr_t0; } while (0)
#define GRID_BAR(cls) do { if (N_LAUNCHES != NPH) { pr_tb = __builtin_amdgcn_s_memrealtime(); xcd_barrier(bar); if (((PROBE_SEL >> 12) & 1) || ((PROBE_SEL >> (16 + (cls))) & 1)) pr_acc += __builtin_amdgcn_s_memrealtime() - pr_tb; } } while (0)
#else
#define TIC() do { } while (0)
#define TOC(cls) do { } while (0)
#define GRID_BAR(cls) do { if (N_LAUNCHES != NPH) xcd_barrier(bar); } while (0)
#endif
    const int lo = args.ph_lo, hi = args.ph_hi;
#define IN(k) (lo <= (k) && (k) < hi)
#define BOTH(k) (IN(k) && IN((k) + 1))

    if (IN(0)) { PHASE_IDS TIC();
        const int gw = vcu * NWAVES + wave, NGW = G * NWAVES;
        constexpr int I_IN = 4 * 96, I_SQ = 4 * 32, I_UP = 4 * 128, I_DN = 16 * 32, I_KV = 4 * 8;
        constexpr int NITEMS = 2 * I_IN + 2 * I_SQ + 4 * I_UP + 4 * I_DN + 2 * I_SQ + I_KV + 2 * I_SQ;
#define P0_ITEM(r, nblk) ((4 * ((r) / (nblk))) * (nblk) + (r) % (nblk))
#define P0_DECODE(dst, itv) do { int r = (itv); \
            if (r < 2 * I_IN) { const int l = r / I_IN; r %= I_IN; dst = P0Item{a_w_in + (size_t)l * D * APROJ, APROJ, D, 96, Win_t + (size_t)l * NIN * D, ln_mix + l * D, 0.08838834764831845f, 512, P0_ITEM(r, 96)}; break; } r -= 2 * I_IN; \
            if (r < 2 * I_SQ) { const int l = r / I_SQ; r %= I_SQ; dst = P0Item{a_w_out + (size_t)l * D * D, D, D, 32, Wao_t + (size_t)l * D * D, nullptr, 1.f, 0, P0_ITEM(r, 32)}; break; } r -= 2 * I_SQ; \
            if (r < 4 * I_UP) { const int l = r / I_UP; r %= I_UP; dst = P0Item{w_up + (size_t)l * D * FF, FF, D, 128, Wup_t + (size_t)l * FF * D, ln_mlp + l * D, 1.f, 0, P0_ITEM(r, 128)}; break; } r -= 4 * I_UP; \
            if (r < 4 * I_DN) { const int l = r / I_DN; r %= I_DN; dst = P0Item{w_down + (size_t)l * FF * D, D, FF, 32, Wdn_t + (size_t)l * D * FF, nullptr, 1.f, 0, P0_ITEM(r, 32)}; break; } r -= 4 * I_DN; \
            if (r < 2 * I_SQ) { const int j = r / I_SQ; r %= I_SQ; dst = P0Item{b_w_q + (size_t)j * D * D, D, D, 32, j == 0 ? Wq0_t : Wq1_t, ln_mix + (2 + j) * D, 0.125f * LOG2E, 1024, P0_ITEM(r, 32)}; break; } r -= 2 * I_SQ; \
            if (r < I_KV) { dst = P0Item{w_kv, 256, D, 8, Wq0_t + (size_t)1024 * D, kv_norm, 1.f, 0, P0_ITEM(r, 8)}; break; } r -= I_KV; \
            { const int j = r / I_SQ; r %= I_SQ; dst = P0Item{b_w_out + (size_t)j * D * D, D, D, 32, Wbo_t + (size_t)j * D * D, nullptr, 1.f, 0, P0_ITEM(r, 32)}; } } while (0)
        bf16x8 B1, B2;
        { const int l15 = lane & 15, g = lane >> 4; const bool on = g == (l15 >> 2); const int jsel = l15 & 3;
#pragma unroll
          for (int j = 0; j < 8; ++j) { B1[j] = (on && j == jsel) ? (short)0x3F80 : (short)0; B2[j] = (on && j == 4 + jsel) ? (short)0x3F80 : (short)0; } }
        for (int it = gw; it < NITEMS; it += NGW) {
            P0Item d0; P0_DECODE(d0, it); P0Item d1 = d0, d2 = d0, d3 = d0; d1.item += d0.nblk; d2.item += 2 * d0.nblk; d3.item += 3 * d0.nblk;
            f32x4 v0[8], v1[8], v2[8], v3[8]; float g0[4], g1[4], g2[4], g3[4];
            p0_load(d0, lane, v0, g0); p0_load(d1, lane, v1, g1); p0_load(d2, lane, v2, g2); p0_load(d3, lane, v3, g3);
            p0_finish(d0, lane, v0, g0, B1, B2); p0_finish(d1, lane, v1, g1, B1, B2); p0_finish(d2, lane, v2, g2, B1, B2); p0_finish(d3, lane, v3, g3, B1, B2);
        }
#undef P0_DECODE
#undef P0_ITEM
        for (int e = vcu * 512 + tid; e < 2 * 16 * 1024; e += G * 512) { const int l = e >> 14, n = (e >> 10) & 15, k = e & 1023;
            Wg_t[e] = (bf16)f2bf(a_w_in[((size_t)l * D + k) * APROJ + NIN + n] * ln_mix[l * D + k]); }
        for (int m0 = gw * 4; m0 < M; m0 += NGW * 4) {
            f32x4 v[4][4];
#pragma unroll
            for (int r = 0; r < 4; ++r) { const GAS f32x4* xr = (const GAS f32x4*)(x + (size_t)(m0 + r) * D) + lane;
#pragma unroll
                for (int j = 0; j < 4; ++j) v[r][j] = xr[64 * j]; }
#pragma unroll
            for (int r = 0; r < 4; ++r) { float s = 0.f;
#pragma unroll
                for (int j = 0; j < 4; ++j) s += (v[r][j].x * v[r][j].x + v[r][j].y * v[r][j].y) + (v[r][j].z * v[r][j].z + v[r][j].w * v[r][j].w);
                s = wave_sum(s);
                GAS unsigned long long* o8 = (GAS unsigned long long*)(HB + (size_t)(m0 + r) * D) + lane;
#pragma unroll
                for (int j = 0; j < 4; ++j) o8[64 * j] = (unsigned long long)pk2(v[r][j].x, v[r][j].y) | ((unsigned long long)pk2(v[r][j].z, v[r][j].w) << 32);
                if (lane < 4) ssq[(size_t)lane * M + m0 + r] = lane == 0 ? s : 0.f; }
        }
        TOC(0); if (BOTH(0)) GRID_BAR(0);
    }

    for (int L = 0; L < 4; ++L) {
        const bool gla = L < 2; const int jb = L - 2;
        const int base = gla ? 1 + 7 * L : 15 + 5 * jb;
        const int pG1 = gla ? base + 4 : base + 2;
        if (IN(base)) { PHASE_IDS TIC();
            pg8::Gemm g; pg8::EpiScale E; E.ssq = ssq; E.act = 0;
            if (gla) { g = pg8::Gemm{HB, Win_t + (size_t)L * NIN * D, M, NIN, D, D}; E.O = QKVG; E.ldc = NIN; E.O2 = nullptr; E.ldc2 = 0; E.split_col = 1 << 30; }
            else if (jb == 0) { g = pg8::Gemm{HB, Wq0_t, M, 1280, D, D}; E.O = Qb; E.ldc = D; E.O2 = KVb; E.ldc2 = 256; E.split_col = 1024; }
            else { g = pg8::Gemm{HB, Wq1_t, M, 1024, D, D}; E.O = Qb; E.ldc = D; E.O2 = nullptr; E.ldc2 = 0; E.split_col = 1 << 30; }
            pg8::StaticOrder S; S.init(M, g.N, G, (int)blockIdx.x);
            { pg8::Unit u0; const bool has = S.next(0, u0); LAS float* rtab = (LAS float*)(ldsl + RING_BYTES);
              if (has && tid < 256) rtab[tid] = pg8::row_rstd(ssq, u0.pm * 256 + tid);
              __syncthreads(); E.rtab = rtab; E.tab_pm = has ? u0.pm : -1; }
            pg8::gemm_phase<pg8::EpiScale, pg8::StaticOrder, true, true>(ldsl, g, S, E);
            TOC(gla ? 1 : 6); TIC();
            if (gla) {
                LAS float* part = (LAS float*)ldsl;
                LAS float* glr_s = (LAS float*)(ldsl + 8192);
                const GAS bf16* Wg = (const GAS bf16*)(Wg_t + (size_t)L * 16 * 1024);
                const int g4 = lane >> 4, l15 = lane & 15, mt = wave & 3, kh = wave >> 2;
                for (int c = vcu; c < M / 64; c += G) {
                    __syncthreads();
                    { const GAS bf16* ap = (const GAS bf16*)HB + (size_t)(c * 64 + 16 * mt + l15) * D + 512 * kh + 8 * g4; const GAS bf16* bp = Wg + (size_t)l15 * D + 512 * kh + 8 * g4;
                      f32x4 acc = (f32x4){0.f, 0.f, 0.f, 0.f};
#pragma unroll
                      for (int kb = 0; kb < 2; ++kb) { bf16x8 av[8], bv[8];
#pragma unroll
                          for (int ks = 0; ks < 8; ++ks) { av[ks] = *(const GAS bf16x8*)(ap + 256 * kb + 32 * ks); bv[ks] = *(const GAS bf16x8*)(bp + 256 * kb + 32 * ks); }
#pragma unroll
                          for (int ks = 0; ks < 8; ++ks) acc = __builtin_amdgcn_mfma_f32_16x16x32_bf16(av[ks], bv[ks], acc, 0, 0, 0); }
#pragma unroll
                      for (int r = 0; r < 4; ++r) part[(kh * 64 + 16 * mt + 4 * g4 + r) * 16 + l15] = acc[r]; }
                    __syncthreads();
                    { const int r = tid >> 3, n2 = (tid & 7) * 2; const float rs = pg8::row_rstd(ssq, c * 64 + r);
                      glr_s[r * 16 + n2] = (part[r * 16 + n2] + part[(64 + r) * 16 + n2]) * rs; glr_s[r * 16 + n2 + 1] = (part[r * 16 + n2 + 1] + part[(64 + r) * 16 + n2 + 1]) * rs; }
                    __syncthreads();
                    { const int kd = tid; float w2[16];
#pragma unroll
                      for (int r = 0; r < 16; ++r) w2[r] = a_w_gk2[((size_t)L * 16 + r) * KD + kd];
                      const float bb = a_b_gk[L * KD + kd]; float run = 0.f; GAS short* bo = (GAS short*)BCUM + (size_t)(c * 64) * KD + kd;
#pragma unroll 4
                      for (int t = 0; t < 64; ++t) { const LAS f32x4* gp = (const LAS f32x4*)(glr_s + t * 16); const f32x4 g0 = gp[0], g1 = gp[1], g2 = gp[2], g3 = gp[3];
                          float z = bb + ((g0[0] * w2[0] + g0[1] * w2[1]) + (g0[2] * w2[2] + g0[3] * w2[3])) + ((g1[0] * w2[4] + g1[1] * w2[5]) + (g1[2] * w2[6] + g1[3] * w2[7]))
                                       + ((g2[0] * w2[8] + g2[1] * w2[9]) + (g2[2] * w2[10] + g2[3] * w2[11])) + ((g3[0] * w2[12] + g3[1] * w2[13]) + (g3[2] * w2[14] + g3[3] * w2[15]));
                          const float ls = fminf(z, 0.f) - __logf(1.0f + __expf(-fabsf(z)));
                          run += ls * (1.0f / 16.0f); bo[(size_t)t * KD] = (short)fmaxf(rintf(run * 2048.0f), -32768.0f); } }
                }
                __syncthreads();
            }
            TOC(2); if (BOTH(base)) GRID_BAR(gla ? 2 : 6);
        }
        if (gla) {
            if (IN(base + 1)) { PHASE_IDS
                TIC(); constexpr int KD_OFF = 0, KD_RS = 288, V_OFF = 36864, V_RS = 544;
                const int g = lane >> 4, q4 = (lane & 15) >> 2, p4 = lane & 3, wk = wave >> 2, wv = wave & 3;
                for (int un = vcu; un < 512; un += G) {
                    const int seq = un >> 5, sc = un & 31, b = seq >> 2, h = seq & 3; const size_t t0 = (size_t)b * T + sc * 128;
                    __syncthreads();
                    { const int k8 = (tid & 15) * 8; const GAS short* bcb = (const GAS short*)BCUM + t0 * KD + h * 128 + k8; const GAS bf16* kb = (const GAS bf16*)QKVG + t0 * NIN + 512 + h * 128 + k8;
                      const GAS bf16* vb = (const GAS bf16*)QKVG + t0 * NIN + 1024 + h * 256;
                      const v4u l0w = *(const GAS v4u*)(bcb + 63 * KD), l1w = *(const GAS v4u*)(bcb + 127 * KD);
                      v4u kv[4], bw[4]; v4u vv[8];
#pragma unroll
                      for (int i = 0; i < 4; ++i) { const int t = (tid >> 4) + 32 * i; kv[i] = *(const GAS v4u*)(kb + (size_t)t * NIN); bw[i] = *(const GAS v4u*)(bcb + (size_t)t * KD); }
#pragma unroll
                      for (int i = 0; i < 8; ++i) { const int c = tid + 512 * i, t = c >> 5, v8 = (c & 31) * 8; vv[i] = *(const GAS v4u*)(vb + (size_t)t * NIN + v8); }
                      f32x4 l0a, l0b, l1a, l1b; bc_unpack(l0w, l0a, l0b); bc_unpack(l1w, l1a, l1b);
                      float last0[8], bend[8];
#pragma unroll
                      for (int e = 0; e < 4; ++e) { last0[e] = l0a[e]; last0[4 + e] = l0b[e]; bend[e] = l0a[e] + l1a[e]; bend[4 + e] = l0b[e] + l1b[e]; }
                      if (tid < 16) {
#pragma unroll
                          for (int e = 0; e < 8; ++e) BendG[(size_t)un * 128 + k8 + e] = bend[e]; }
#pragma unroll
                      for (int i = 0; i < 4; ++i) { const int t = (tid >> 4) + 32 * i; float r[8]; f32x4 b0, b1; bc_unpack(bw[i], b0, b1);
#pragma unroll
                          for (int e = 0; e < 8; ++e) { const float kk = (e & 1) ? bfhi(kv[i][e >> 1]) : bflo(kv[i][e >> 1]); const float bc = (e < 4 ? b0[e] : b1[e - 4]) + (t >= 64 ? last0[e] : 0.f); r[e] = kk * __expf(bend[e] - bc); }
                          v4u o; o.x = pk2(r[0], r[1]); o.y = pk2(r[2], r[3]); o.z = pk2(r[4], r[5]); o.w = pk2(r[6], r[7]);
                          *(LAS v4u*)(ldsl + KD_OFF + t * KD_RS + k8 * 2) = o; }
#pragma unroll
                      for (int i = 0; i < 8; ++i) { const int c = tid + 512 * i, t = c >> 5, v8 = (c & 31) * 8; *(LAS v4u*)(ldsl + V_OFF + t * V_RS + v8 * 2) = vv[i]; } }
                    __syncthreads();
                    f32x4 acc[4][4];
#pragma unroll
                    for (int a = 0; a < 4; ++a)
#pragma unroll
                        for (int c = 0; c < 4; ++c) acc[a][c] = (f32x4){0.f, 0.f, 0.f, 0.f};
#pragma unroll
                    for (int s = 0; s < 4; ++s) { const int rowb = 32 * s + 4 * g + q4;
                        bf16x8 af[4], bfr[4];
#pragma unroll
                        for (int kt = 0; kt < 4; ++kt) { const LAS unsigned char* ap = ldsl + KD_OFF + rowb * KD_RS + (64 * wk + 16 * kt + 4 * p4) * 2; const s16x4 lo = tr_read(ap), hi = tr_read(ap + 16 * KD_RS);
                            af[kt] = (bf16x8){lo[0], lo[1], lo[2], lo[3], hi[0], hi[1], hi[2], hi[3]}; }
#pragma unroll
                        for (int vt = 0; vt < 4; ++vt) { const LAS unsigned char* bp = ldsl + V_OFF + rowb * V_RS + (64 * wv + 16 * vt + 4 * p4) * 2; const s16x4 lo = tr_read(bp), hi = tr_read(bp + 16 * V_RS);
                            bfr[vt] = (bf16x8){lo[0], lo[1], lo[2], lo[3], hi[0], hi[1], hi[2], hi[3]}; }
#pragma unroll
                        for (int kt = 0; kt < 4; ++kt)
#pragma unroll
                            for (int vt = 0; vt < 4; ++vt) acc[kt][vt] = __builtin_amdgcn_mfma_f32_16x16x32_bf16(af[kt], bfr[vt], acc[kt][vt], 0, 0, 0); }
#pragma unroll
                    for (int kt = 0; kt < 4; ++kt)
#pragma unroll
                        for (int vt = 0; vt < 4; ++vt) { const int vd = 64 * wv + 16 * vt + (lane & 15), kd = 64 * wk + 16 * kt + 4 * g;
                            v2u w; w.x = pk2(acc[kt][vt][0], acc[kt][vt][1]); w.y = pk2(acc[kt][vt][2], acc[kt][vt][3]);
                            *(v2u*)(Sst + ((size_t)un * 256 + vd) * 128 + kd) = w; }
                }
                TOC(3); if (BOTH(base + 1)) GRID_BAR(3);
            }
            if (IN(base + 2)) { PHASE_IDS TIC();
                for (int w = vcu * 512 + tid; w < 16 * 8192; w += G * 512) { const int seq = w >> 13, e4 = (w & 8191) * 4, kd = e4 & 127; float run[4] = {0.f, 0.f, 0.f, 0.f};
                    for (int sc = 0; sc < 32; ++sc) { const int un = seq * 32 + sc; bf16* p = Sst + (size_t)un * 32768 + e4; const v2u tv = *(const v2u*)p;
                        const f32x4 be = *(const f32x4*)(BendG + (size_t)un * 128 + kd);
                        v2u o; o.x = pk2(run[0], run[1]); o.y = pk2(run[2], run[3]); *(v2u*)p = o;
                        run[0] = run[0] * __expf(be[0]) + bflo(tv.x); run[1] = run[1] * __expf(be[1]) + bfhi(tv.x); run[2] = run[2] * __expf(be[2]) + bflo(tv.y); run[3] = run[3] * __expf(be[3]) + bfhi(tv.y); } }
                TOC(4); if (BOTH(base + 2)) GRID_BAR(4);
            }
            if (IN(base + 3)) { PHASE_IDS TIC();
                constexpr int A_OFF = 0, A_RS = 288, B_OFF = 73728, B_RS = 544;
                const int g = lane >> 4, l15 = lane & 15, q4 = l15 >> 2, p4 = lane & 3;
                const int grp = wave < 4 ? wave : 11 - wave;
                for (int un = vcu; un < 512; un += G) {
                    const int seq = un >> 5, sc = un & 31, b = seq >> 2, h = seq & 3; const size_t t0 = (size_t)b * T + sc * 128;
                    const int k8 = (tid & 15) * 8, q = 16 * grp + l15;
                    v4u sv[8], vv[8], kv[4], qv[4], kbw[4], qbw[4], qcw[4];
                    { const GAS bf16* sb = (const GAS bf16*)Sst + (size_t)un * 32768; const GAS bf16* vb = (const GAS bf16*)QKVG + t0 * NIN + 1024 + h * 256;
#pragma unroll
                      for (int i = 0; i < 8; ++i) { const int c = tid + 512 * i; sv[i] = *(const GAS v4u*)(sb + (size_t)c * 8); vv[i] = *(const GAS v4u*)(vb + (size_t)(c >> 5) * NIN + (c & 31) * 8); } }
                    const GAS short* bcb = (const GAS short*)BCUM + t0 * KD + h * 128 + k8;
                    const v4u l0w = *(const GAS v4u*)(bcb + 63 * KD);
                    { const GAS bf16* kb = (const GAS bf16*)QKVG + t0 * NIN + 512 + h * 128 + k8;
#pragma unroll
                      for (int i = 0; i < 4; ++i) { const int t = (tid >> 4) + 32 * i; kv[i] = *(const GAS v4u*)(kb + (size_t)t * NIN); kbw[i] = *(const GAS v4u*)(bcb + (size_t)t * KD); } }
                    __syncthreads();
#pragma unroll
                    for (int i = 0; i < 8; ++i) { const int c = tid + 512 * i; *(LAS v4u*)(ldsl + A_OFF + (c >> 4) * A_RS + (c & 15) * 16) = sv[i]; *(LAS v4u*)(ldsl + B_OFF + (c >> 5) * B_RS + (c & 31) * 16) = vv[i]; }
                    asm volatile("" ::: "memory");
                    { const size_t tok = t0 + q; const GAS bf16* qb = (const GAS bf16*)QKVG + tok * NIN + h * 128 + 8 * g; const GAS short* bq = (const GAS short*)BCUM + tok * KD + h * 128 + 8 * g; const GAS short* lq = (const GAS short*)BCUM + (t0 + 63) * KD + h * 128 + 8 * g;
#pragma unroll
                      for (int ks = 0; ks < 4; ++ks) { qv[ks] = *(const GAS v4u*)(qb + 32 * ks); qbw[ks] = *(const GAS v4u*)(bq + 32 * ks); qcw[ks] = *(const GAS v4u*)(lq + 32 * ks); } }
                    v4u kreg[4];
                    f32x4 l0a, l0b; bc_unpack(l0w, l0a, l0b);
#pragma unroll
                    for (int i = 0; i < 4; ++i) { const int t = (tid >> 4) + 32 * i; float r[8]; f32x4 kb0, kb1; bc_unpack(kbw[i], kb0, kb1);
#pragma unroll
                        for (int e = 0; e < 8; ++e) { const float kk = (e & 1) ? bfhi(kv[i][e >> 1]) : bflo(kv[i][e >> 1]); const float bc = (e < 4 ? kb0[e] : kb1[e - 4]) + (t >= 64 ? (e < 4 ? l0a[e] : l0b[e - 4]) : 0.f); r[e] = kk * __expf(-bc); }
                        kreg[i].x = pk2(r[0], r[1]); kreg[i].y = pk2(r[2], r[3]); kreg[i].z = pk2(r[4], r[5]); kreg[i].w = pk2(r[6], r[7]); }
                    bf16x8 qf[4];
                    { const float lm = q >= 64 ? 1.0f : 0.0f;
#pragma unroll
                      for (int ks = 0; ks < 4; ++ks) { float r[8]; f32x4 qb0, qb1, qc0, qc1; bc_unpack(qbw[ks], qb0, qb1); bc_unpack(qcw[ks], qc0, qc1);
#pragma unroll
                          for (int e = 0; e < 8; ++e) { const float qq = (e & 1) ? bfhi(qv[ks][e >> 1]) : bflo(qv[ks][e >> 1]); r[e] = qq * __expf(e < 4 ? qb0[e] + lm * qc0[e] : qb1[e - 4] + lm * qc1[e - 4]); }
                          v4u o; o.x = pk2(r[0], r[1]); o.y = pk2(r[2], r[3]); o.z = pk2(r[4], r[5]); o.w = pk2(r[6], r[7]);
                          qf[ks] = __builtin_bit_cast(bf16x8, o); } }
                    GAS bf16* gp = (GAS bf16*)QKVG + (t0 + q) * NIN + 2048 + h * 256 + 4 * g;
                    v2u gv[16];
#pragma unroll
                    for (int vt = 0; vt < 16; ++vt) gv[vt] = *(const GAS v2u*)(gp + 16 * vt);
                    __syncthreads();
                    f32x4 acc[16];
#pragma unroll
                    for (int vt = 0; vt < 16; ++vt) acc[vt] = (f32x4){0.f, 0.f, 0.f, 0.f};
#pragma unroll
                    for (int vt = 0; vt < 16; ++vt)
#pragma unroll
                        for (int ks = 0; ks < 4; ++ks) { const bf16x8 a = *(const LAS bf16x8*)(ldsl + A_OFF + (16 * vt + l15) * A_RS + (32 * ks + 8 * g) * 2);
                            acc[vt] = __builtin_amdgcn_mfma_f32_16x16x32_bf16(a, qf[ks], acc[vt], 0, 0, 0); }
                    __syncthreads();
#pragma unroll
                    for (int i = 0; i < 4; ++i) { const int t = (tid >> 4) + 32 * i; *(LAS v4u*)(ldsl + A_OFF + t * A_RS + k8 * 2) = kreg[i]; }
                    __syncthreads();
                    const int nsteps = (grp >> 1) + 1;
                    for (int s = 0; s < nsteps; ++s) {
                        f32x4 pt[2];
#pragma unroll
                        for (int tt = 0; tt < 2; ++tt) { pt[tt] = (f32x4){0.f, 0.f, 0.f, 0.f};
#pragma unroll
                            for (int ks = 0; ks < 4; ++ks) { const bf16x8 a = *(const LAS bf16x8*)(ldsl + A_OFF + (32 * s + 16 * tt + l15) * A_RS + (32 * ks + 8 * g) * 2);
                                pt[tt] = __builtin_amdgcn_mfma_f32_16x16x32_bf16(a, qf[ks], pt[tt], 0, 0, 0); }
#pragma unroll
                            for (int r = 0; r < 4; ++r) { const int j = 32 * s + 16 * tt + 4 * g + r; if (j > q) pt[tt][r] = 0.f; } }
                        v4u pw; pw.x = pk2(pt[0][0], pt[0][1]); pw.y = pk2(pt[0][2], pt[0][3]); pw.z = pk2(pt[1][0], pt[1][1]); pw.w = pk2(pt[1][2], pt[1][3]);
                        const bf16x8 pf = __builtin_bit_cast(bf16x8, pw);
#pragma unroll
                        for (int vt = 0; vt < 16; ++vt) { const LAS unsigned char* vp = ldsl + B_OFF + (32 * s + 4 * g + q4) * B_RS + (16 * vt + 4 * p4) * 2; const s16x4 lo = tr_read(vp), hi = tr_read(vp + 16 * B_RS);
                            const bf16x8 a = (bf16x8){lo[0], lo[1], lo[2], lo[3], hi[0], hi[1], hi[2], hi[3]};
                            acc[vt] = __builtin_amdgcn_mfma_f32_16x16x32_bf16(a, pf, acc[vt], 0, 0, 0); }
                    }
                    { float ss = 0.f;
#pragma unroll
                      for (int vt = 0; vt < 16; ++vt) ss += (acc[vt][0] * acc[vt][0] + acc[vt][1] * acc[vt][1]) + (acc[vt][2] * acc[vt][2] + acc[vt][3] * acc[vt][3]);
                      ss += __shfl_xor(ss, 16); ss += __shfl_xor(ss, 32);
                      const float rs = 1.0f / sqrtf(ss * (1.0f / 256.0f) + EPS);
                      const GAS float* gonp = (const GAS float*)a_onorm + L * 256 + 4 * g;
#pragma unroll
                      for (int vt = 0; vt < 16; ++vt) { const f32x4 gon = *(const GAS f32x4*)(gonp + 16 * vt);
                          const float g0 = bflo(gv[vt].x), g1 = bfhi(gv[vt].x), g2 = bflo(gv[vt].y), g3 = bfhi(gv[vt].y);
                          const float r0 = acc[vt][0] * rs * gon[0] * (g0 / (1.0f + __expf(-g0))), r1 = acc[vt][1] * rs * gon[1] * (g1 / (1.0f + __expf(-g1)));
                          const float r2 = acc[vt][2] * rs * gon[2] * (g2 / (1.0f + __expf(-g2))), r3 = acc[vt][3] * rs * gon[3] * (g3 / (1.0f + __expf(-g3)));
                          v2u w; w.x = pk2(r0, r1); w.y = pk2(r2, r3); *(GAS v2u*)(gp + 16 * vt) = w; } }
                }
                TOC(5); if (BOTH(base + 3)) GRID_BAR(5);
            }
        } else {
            if (IN(base + 1)) { PHASE_IDS
                TIC(); constexpr int K_OFF = 0, V_OFF = 40960, RS = 160, BIAS_OFF = 81920;
                const int g = lane >> 4, l15 = lane & 15, q4 = l15 >> 2, p4 = lane & 3;
                LAS float* bias_s = (LAS float*)(ldsl + BIAS_OFF);
                for (int un = vcu; un < 256; un += G) {
                    const int b = un >> 6, nb = (un >> 1) & 31, kvh = un & 1; const size_t tq0 = (size_t)b * T + nb * 128;
                    __syncthreads();
                    { v4u kv[4], vv[4]; const GAS bf16* kvb = (const GAS bf16*)KVb + (tq0 - (nb == 0 ? 0 : 128)) * 256 + kvh * 64;
#pragma unroll
                      for (int i = 0; i < 4; ++i) { const int c = tid + 512 * i, j = c >> 3, d8 = (c & 7) * 8; const int jj = nb == 0 ? (j & 127) : j;
                          kv[i] = *(const GAS v4u*)(kvb + (size_t)jj * 256 + d8); vv[i] = *(const GAS v4u*)(kvb + (size_t)jj * 256 + 128 + d8); }
#pragma unroll
                      for (int i = 0; i < 4; ++i) { const int c = tid + 512 * i, j = c >> 3, d8 = (c & 7) * 8; const bool pad = nb == 0 && j < 128;
                          *(LAS v4u*)(ldsl + K_OFF + j * RS + d8 * 2) = pad ? (v4u){0u, 0u, 0u, 0u} : kv[i]; *(LAS v4u*)(ldsl + V_OFF + j * RS + d8 * 2) = pad ? (v4u){0u, 0u, 0u, 0u} : vv[i]; } }
                    for (int e = tid; e < 1024; e += 512) { const int hg = e >> 7, dist = e & 127;
                        int bk = dist; if (dist >= 16) { bk = 16 + (dist >= 19) + (dist >= 21) + (dist >= 24) + (dist >= 27) + (dist >= 31) + (dist >= 35) + (dist >= 40) + (dist >= 46) + (dist >= 52) + (dist >= 59) + (dist >= 67) + (dist >= 77) + (dist >= 87) + (dist >= 99) + (dist >= 113); }
                        bias_s[e] = rel_table[bk * 16 + kvh * 8 + hg] * LOG2E; }
                    __syncthreads();
                    const int head = kvh * 8 + wave; const float sink2 = b_sinks[jb * 16 + head] * LOG2E;
                    GAS bf16* qbase = (GAS bf16*)Qb + (tq0 + l15) * D + head * 64;
                    bf16x8 qn0 = *(const GAS bf16x8*)(qbase + 8 * g), qn1 = *(const GAS bf16x8*)(qbase + 32 + 8 * g);
#pragma unroll 1
                    for (int qg = 0; qg < 8; ++qg) {
                        const int qi = 16 * qg + l15; GAS bf16* qp = qbase + (size_t)(16 * qg) * D;
                        const bf16x8 qf0 = qn0, qf1 = qn1;
                        if (qg < 7) { qn0 = *(const GAS bf16x8*)(qp + 16 * D + 8 * g); qn1 = *(const GAS bf16x8*)(qp + 16 * D + 32 + 8 * g); }
                        const int ts0 = qg & ~1;
                        f32x4 sc[10];
#pragma unroll
                        for (int tt = 0; tt < 10; ++tt) { const LAS unsigned char* kp = ldsl + K_OFF + (16 * (ts0 + tt) + l15) * RS + (8 * g) * 2;
                            const bf16x8 a0 = *(const LAS bf16x8*)kp, a1 = *(const LAS bf16x8*)(kp + 64);
                            sc[tt] = __builtin_amdgcn_mfma_f32_16x16x32_bf16(a0, qf0, (f32x4){0.f, 0.f, 0.f, 0.f}, 0, 0, 0);
                            sc[tt] = __builtin_amdgcn_mfma_f32_16x16x32_bf16(a1, qf1, sc[tt], 0, 0, 0); }
                        float m = sink2;
#pragma unroll
                        for (int tt = 0; tt < 10; ++tt)
#pragma unroll
                            for (int r = 0; r < 4; ++r) { const int j = 16 * (ts0 + tt) + 4 * g + r, dist = qi + 128 - j; const bool valid = (dist >= 0) && (dist < 128) && !(nb == 0 && j < 128);
                                const float s = valid ? sc[tt][r] + bias_s[wave * 128 + (dist & 127)] : -1e30f; sc[tt][r] = s; m = fmaxf(m, s); }
                        m = fmaxf(m, __shfl_xor(m, 16)); m = fmaxf(m, __shfl_xor(m, 32));
                        float l = 0.f;
#pragma unroll
                        for (int tt = 0; tt < 10; ++tt)
#pragma unroll
                            for (int r = 0; r < 4; ++r) { const float pe = __builtin_amdgcn_exp2f(sc[tt][r] - m); sc[tt][r] = pe; l += pe; }
                        l += __shfl_xor(l, 16); l += __shfl_xor(l, 32); l += __builtin_amdgcn_exp2f(sink2 - m);
                        f32x4 o[4];
#pragma unroll
                        for (int dt = 0; dt < 4; ++dt) o[dt] = (f32x4){0.f, 0.f, 0.f, 0.f};
#pragma unroll
                        for (int s5 = 0; s5 < 5; ++s5) { v4u pw; pw.x = pk2(sc[2 * s5][0], sc[2 * s5][1]); pw.y = pk2(sc[2 * s5][2], sc[2 * s5][3]); pw.z = pk2(sc[2 * s5 + 1][0], sc[2 * s5 + 1][1]); pw.w = pk2(sc[2 * s5 + 1][2], sc[2 * s5 + 1][3]);
                            const bf16x8 pf = __builtin_bit_cast(bf16x8, pw);
#pragma unroll
                            for (int dt = 0; dt < 4; ++dt) { const LAS unsigned char* vp = ldsl + V_OFF + (16 * (ts0 + 2 * s5) + 4 * g + q4) * RS + (16 * dt + 4 * p4) * 2; const s16x4 lo = tr_read(vp), hi = tr_read(vp + 16 * RS);
                                const bf16x8 a = (bf16x8){lo[0], lo[1], lo[2], lo[3], hi[0], hi[1], hi[2], hi[3]};
                                o[dt] = __builtin_amdgcn_mfma_f32_16x16x32_bf16(a, pf, o[dt], 0, 0, 0); } }
                        const float il = 1.0f / l;
#pragma unroll
                        for (int dt = 0; dt < 4; ++dt) { v2u w; w.x = pk2(o[dt][0] * il, o[dt][1] * il); w.y = pk2(o[dt][2] * il, o[dt][3] * il); *(GAS v2u*)(qp + 16 * dt + 4 * g) = w; }
                    }
                }
                TOC(7); if (BOTH(base + 1)) GRID_BAR(7);
            }
        }
        if (IN(pG1)) { TIC();
            pg8::Gemm g; pg8::EpiResid E; E.hb = HB; E.ssq = ssq;
            if (gla) g = pg8::Gemm{QKVG + 2048, Wao_t + (size_t)L * D * D, M, D, D, NIN};
            else g = pg8::Gemm{Qb, Wbo_t + (size_t)jb * D * D, M, D, D, D};
            pg8::StaticOrder S; S.init(M, D, G, (int)blockIdx.x);
            pg8::gemm_phase<pg8::EpiResid, pg8::StaticOrder, false, true>(ldsl, g, S, E);
            TOC(8); if (BOTH(pG1)) GRID_BAR(8);
        }
        if (IN(pG1 + 1)) { PHASE_IDS TIC();
            pg8::Gemm g{HB, Wup_t + (size_t)L * FF * D, M, FF, D, D};
            pg8::EpiScale E; E.O = U; E.ldc = FF; E.O2 = nullptr; E.ldc2 = 0; E.split_col = 1 << 30; E.ssq = ssq; E.act = 1;
            pg8::StaticOrder S; S.init(M, FF, G, (int)blockIdx.x);
            { pg8::Unit u0; const bool has = S.next(0, u0); LAS float* rtab = (LAS float*)(ldsl + RING_BYTES);
              if (has && tid < 256) rtab[tid] = pg8::row_rstd(ssq, u0.pm * 256 + tid);
              __syncthreads(); E.rtab = rtab; E.tab_pm = has ? u0.pm : -1; }
            pg8::gemm_phase<pg8::EpiScale, pg8::StaticOrder, true, true>(ldsl, g, S, E);
            TOC(9); if (BOTH(pG1 + 1)) GRID_BAR(9);
        }
        if (IN(pG1 + 2)) { TIC();
            pg8::Gemm g{U, Wdn_t + (size_t)L * D * FF, M, D, FF, FF};
            pg8::EpiResid E; E.hb = HB; E.ssq = ssq;
            pg8::StaticOrder S; S.init(M, D, G, (int)blockIdx.x);
            pg8::gemm_phase<pg8::EpiResid, pg8::StaticOrder, false, true>(ldsl, g, S, E);
            TOC(10); if (BOTH(pG1 + 2)) GRID_BAR(10);
        }
    }
    if (IN(25)) { PHASE_IDS TIC();
        const int gw = vcu * NWAVES + wave, NGW = G * NWAVES;
        for (int m = gw; m < M; m += NGW) {
            const float rs = pg8::row_rstd(ssq, m);
            const GAS v2u* hr = (const GAS v2u*)(HB + (size_t)m * D) + lane; GAS f32x4* orow = (GAS f32x4*)(out + (size_t)m * D) + lane; const f32x4* gr = (const f32x4*)ln_final + lane;
            v2u hvv[4];
#pragma unroll
            for (int j = 0; j < 4; ++j) hvv[j] = hr[64 * j];
#pragma unroll
            for (int j = 0; j < 4; ++j) { const f32x4 gg = gr[64 * j]; orow[64 * j] = (f32x4){bflo(hvv[j].x) * rs * gg[0], bfhi(hvv[j].x) * rs * gg[1], bflo(hvv[j].y) * rs * gg[2], bfhi(hvv[j].y) * rs * gg[3]}; }
        }
    TOC(11); }
#if PROBE_SEL
    if (blockIdx.x == 0) { const unsigned long long te = __builtin_amdgcn_s_memrealtime(); while (__builtin_amdgcn_s_memrealtime() - te < pr_acc * PROBE_MUL) __builtin_amdgcn_s_sleep(8); }
#endif
#undef IN
#undef BOTH
#undef GRID_BAR
}

extern "C" void kernel_launch(void* const* d_in, const int* in_sizes, int n_in, void* d_out, int out_size, void* d_ws, size_t ws_size, hipStream_t stream) {
    static int grid = 0;
    if (grid == 0) {
        if (n_in != 17 || in_sizes[0] != M * D || out_size != M * D || ws_size < WS_END) { fprintf(stderr, "kernel_launch: unexpected shapes (n_in %d, in0 %d, out %d, ws %zu)\n", n_in, n_in > 0 ? in_sizes[0] : -1, out_size, ws_size); grid = -1; return; }
        int dev = 0, cus = 0;
        if (hipGetDevice(&dev) != hipSuccess || hipDeviceGetAttribute(&cus, hipDeviceAttributeMultiprocessorCount, dev) != hipSuccess) { grid = -1; return; }
        if (hipFuncSetAttribute((const void*)yoco_fwd, hipFuncAttributeMaxDynamicSharedMemorySize, LDS_BYTES) != hipSuccess) { fprintf(stderr, "kernel_launch: hipFuncSetAttribute failed\n"); grid = -1; return; }
        (void)hipGetLastError();
        grid = cus;
    }
    if (grid < 0) return;
    if (hipMemsetAsync((char*)d_ws + WS_CTL, 0, CTL_ZERO_BYTES, stream) != hipSuccess) return;
    Args a{};
    for (int i = 0; i < 17; ++i) a.in[i] = (const float*)d_in[i];
    a.out = (float*)d_out; a.ws = (unsigned char*)d_ws;
    if (N_LAUNCHES == 1) {
        a.ph_lo = 0; a.ph_hi = NPH; a.li = 0;
        hipLaunchKernelGGL(yoco_fwd, dim3(grid), dim3(NWAVES * 64), LDS_BYTES, stream, a);
    } else {
        for (int p = 0; p < NPH; ++p) { a.ph_lo = p; a.ph_hi = p + 1; a.li = 0;
            hipLaunchKernelGGL(yoco_fwd, dim3(grid), dim3(NWAVES * 64), LDS_BYTES, stream, a); }
    }
}
```

```cpp
#include <hip/hip_runtime.h>
#include <cstdio>
#include <cstdint>

#ifndef PROBE_SEL
#define PROBE_SEL 0
#endif
#ifndef PROBE_MUL
#define PROBE_MUL 1
#endif
#ifndef MK_N_LAUNCHES
#define MK_N_LAUNCHES 1
#endif

namespace pg8 {
#define PG8_LAS __attribute__((address_space(3)))
typedef unsigned short bf16_t;
typedef short bf16x8 __attribute__((ext_vector_type(8)));
typedef float f32x4 __attribute__((ext_vector_type(4)));
typedef unsigned u32x4 __attribute__((ext_vector_type(4)));
typedef unsigned u32x2 __attribute__((ext_vector_type(2)));
constexpr int BM = 256, BK = 64, HALF = 128, HTB = HALF * BK * 2, STAGE_BYTES = 8 * HTB, NXCD = 8, WGM = 8;

__host__ __device__ __forceinline__ int lds_byte(int r, int c) { const int st = (r >> 4) * 2 + (c >> 5), rr = r & 15, cc = c & 31, ob = rr * 64 + cc * 2; return st * 1024 + (ob ^ (((ob >> 9) & 1) << 5)); }
__host__ __device__ __forceinline__ void stage_rc(int b, int& R, int& C) { const int st = b / 1024, sb = b % 1024, swz = sb ^ (((sb >> 9) & 1) << 5); R = (st >> 1) * 16 + swz / 64; C = (st & 1) * 32 + (swz % 64) / 2; }
__host__ __device__ __forceinline__ int perm32(int rho) { const int n = rho >> 4, i = rho & 15; return 8 * (i >> 2) + 4 * n + (i & 3); }

struct Unit { int pm, pn; };
struct Gemm { const bf16_t* A; const bf16_t* Bt; int M, N, K, lda; size_t a_tstep; };

struct StaticOrder {
    int nM, nN, nwg, G, c;
    __host__ __device__ void init(int M, int N, int G_, int c_) { nM = M / BM; nN = N / BM; nwg = nM * nN; G = G_; c = c_; }
    __host__ __device__ bool next(int i, Unit& u) const {
        const long L = (long)i * G + c; if (L >= nwg) return false;
        int wgid = (int)L; { const int q = nwg / NXCD, r = nwg % NXCD, xcd = wgid % NXCD, off = wgid / NXCD; wgid = (xcd < r ? xcd * (q + 1) : r * (q + 1) + (xcd - r) * q) + off; }
        const int nig = WGM * nN, gid = wgid / nig, fm = gid * WGM, gsz = (nM - fm) < WGM ? (nM - fm) : WGM;
        u.pm = fm + ((wgid % nig) % gsz); u.pn = (wgid % nig) / gsz; return true;
    }
    __device__ __forceinline__ void a_ready(const Unit&) const {}
    __device__ __forceinline__ void done(const Unit&) const {}
};

__device__ __forceinline__ unsigned cvt_pk_bf16(float lo, float hi) { unsigned r; asm volatile("v_cvt_pk_bf16_f32 %0, %1, %2" : "=v"(r) : "v"(lo), "v"(hi)); return r; }

constexpr int MROWS = 16384;
__device__ __forceinline__ float row_rstd(const float* ssq, int row) { const float s = (ssq[row] + ssq[MROWS + row]) + (ssq[2 * MROWS + row] + ssq[3 * MROWS + row]); return 1.0f / sqrtf(s * (1.0f / 1024.0f) + 1e-6f); }

__device__ __forceinline__ unsigned dpp_ror8(unsigned v) { return (unsigned)__builtin_amdgcn_mov_dpp((int)v, 0x128, 0xf, 0xf, false); }
__device__ __forceinline__ float dpp_ror8f(float v) { return __builtin_bit_cast(float, __builtin_amdgcn_mov_dpp(__builtin_bit_cast(int, v), 0x128, 0xf, 0xf, false)); }

struct EpiScale {
    static constexpr bool PERM = true, AFTER_DRAIN = false;
    bf16_t* O; int ldc; unsigned tstep; bf16_t* O2; int ldc2; unsigned tstep2; int split_col; const float* ssq; int act; const PG8_LAS float* rtab; int tab_pm;
    __device__ __forceinline__ void operator()(const f32x4 (&acc)[2][2][4][2], const Unit& u, int wr, int wc, int fr, int fq) const {
        int colt = u.pn * BM; bf16_t* base = O; int ld = ldc; unsigned ts = tstep;
        if (colt >= split_col) { base = O2; colt -= split_col; ld = ldc2; ts = tstep2; }
        const bool lo = fr < 8;
        const int col0 = colt + wc * 64 + (fr >> 3) * 32 + 8 * fq;
        const __amdgpu_buffer_rsrc_t rsrc = __builtin_amdgcn_make_buffer_rsrc((void*)base, 0, 0x7fffffff, 0x00020000);
        float rs[2][4];
        if (u.pm == tab_pm) {
#pragma unroll
            for (int ai = 0; ai < 2; ++ai)
#pragma unroll
                for (int m = 0; m < 4; ++m) rs[ai][m] = rtab[wr * 64 + ai * HALF + m * 16 + fr];
        } else {
#pragma unroll
            for (int ai = 0; ai < 2; ++ai)
#pragma unroll
                for (int m = 0; m < 4; ++m) rs[ai][m] = row_rstd(ssq, u.pm * BM + wr * 64 + ai * HALF + m * 16 + fr);
        }
#pragma unroll
        for (int ai = 0; ai < 2; ++ai)
#pragma unroll
            for (int m = 0; m < 4; ++m) { const float r = rs[ai][m]; u32x4 Y[2];
#pragma unroll
                for (int bj = 0; bj < 2; ++bj) { f32x4 v0 = acc[ai][bj][m][0] * r, v1 = acc[ai][bj][m][1] * r;
                    if (act == 1) {
#pragma unroll
                        for (int e = 0; e < 4; ++e) { float a = fmaxf(v0[e], 0.f); v0[e] = a * a; float b = fmaxf(v1[e], 0.f); v1[e] = b * b; } }
                    Y[bj].x = cvt_pk_bf16(v0[0], v0[1]); Y[bj].y = cvt_pk_bf16(v0[2], v0[3]); Y[bj].z = cvt_pk_bf16(v1[0], v1[1]); Y[bj].w = cvt_pk_bf16(v1[2], v1[3]); }
                u32x4 keep, send, recv;
#pragma unroll
                for (int e = 0; e < 4; ++e) { keep[e] = lo ? Y[0][e] : Y[1][e]; send[e] = lo ? Y[1][e] : Y[0][e]; }
#pragma unroll
                for (int e = 0; e < 4; ++e) recv[e] = dpp_ror8(send[e]);
                u32x4 d1, d2;
#pragma unroll
                for (int e = 0; e < 4; ++e) { d1[e] = lo ? keep[e] : recv[e]; d2[e] = lo ? recv[e] : keep[e]; }
                const int rl1 = wr * 64 + ai * HALF + m * 16 + (fr & 7);
                const unsigned b1 = (unsigned)u.pm * ts + (unsigned)(rl1 * ld + col0) * 2u, b2 = b1 + (unsigned)(8 * ld) * 2u;
                __builtin_amdgcn_raw_buffer_store_b128(d1, rsrc, b1, 0, 16);
                __builtin_amdgcn_raw_buffer_store_b128(d2, rsrc, b2, 0, 16); }
    }
};

struct EpiResid {
    static constexpr bool PERM = true, AFTER_DRAIN = true;
    bf16_t* hb; float* ssq;
    __device__ __forceinline__ void fused(const f32x4 (&acc)[2][2][4][2], const Unit& u, int wr, int wc, int fr, int fq, PG8_LAS unsigned char* lds, int tid) const {
        PG8_LAS float* P = (PG8_LAS float*)lds;
        const bool lo = fr < 8;
        const int col0 = u.pn * BM + wc * 64 + (fr >> 3) * 32 + 8 * fq, rloc = wr * 64 + (fr & 7);
        const __amdgpu_buffer_rsrc_t rsrc = __builtin_amdgcn_make_buffer_rsrc((void*)hb, 0, 0x7fffffff, 0x00020000);
        u32x4 h1[2][4], h2[2][4];
#pragma unroll
        for (int ai = 0; ai < 2; ++ai)
#pragma unroll
            for (int m = 0; m < 4; ++m) { const size_t o1 = (size_t)(u.pm * BM + rloc + ai * HALF + m * 16) * 1024 + col0; h1[ai][m] = *(const u32x4*)(hb + o1); h2[ai][m] = *(const u32x4*)(hb + o1 + 8 * 1024); }
        asm volatile("" ::: "memory");
#pragma unroll
        for (int ai = 0; ai < 2; ++ai)
#pragma unroll
            for (int m = 0; m < 4; ++m) {
                float keep[8], send[8], recv[8];
#pragma unroll
                for (int e = 0; e < 4; ++e) { keep[e] = lo ? acc[ai][0][m][0][e] : acc[ai][1][m][0][e]; keep[4 + e] = lo ? acc[ai][0][m][1][e] : acc[ai][1][m][1][e];
                                              send[e] = lo ? acc[ai][1][m][0][e] : acc[ai][0][m][0][e]; send[4 + e] = lo ? acc[ai][1][m][1][e] : acc[ai][0][m][1][e]; }
#pragma unroll
                for (int e = 0; e < 8; ++e) recv[e] = dpp_ror8f(send[e]);
                float ss1 = 0.f, ss2 = 0.f; u32x4 w1, w2;
#pragma unroll
                for (int e = 0; e < 4; ++e) { const float a0 = lo ? keep[2 * e] : recv[2 * e], a1 = lo ? keep[2 * e + 1] : recv[2 * e + 1], c0 = lo ? recv[2 * e] : keep[2 * e], c1 = lo ? recv[2 * e + 1] : keep[2 * e + 1];
                    const unsigned x = h1[ai][m][e], y = h2[ai][m][e];
                    w1[e] = cvt_pk_bf16(__builtin_bit_cast(float, x << 16) + a0, __builtin_bit_cast(float, x & 0xffff0000u) + a1);
                    w2[e] = cvt_pk_bf16(__builtin_bit_cast(float, y << 16) + c0, __builtin_bit_cast(float, y & 0xffff0000u) + c1);
                    const float p0 = __builtin_bit_cast(float, w1[e] << 16), p1 = __builtin_bit_cast(float, w1[e] & 0xffff0000u), q0 = __builtin_bit_cast(float, w2[e] << 16), q1 = __builtin_bit_cast(float, w2[e] & 0xffff0000u);
                    ss1 += p0 * p0 + p1 * p1; ss2 += q0 * q0 + q1 * q1; }
                const int rl = rloc + ai * HALF + m * 16; const unsigned b1 = (unsigned)((u.pm * BM + rl) * 1024 + col0) * 2u;
                __builtin_amdgcn_raw_buffer_store_b128(w1, rsrc, b1, 0, 16);
                __builtin_amdgcn_raw_buffer_store_b128(w2, rsrc, b1 + 8 * 1024 * 2, 0, 16);
                ss1 += __shfl_xor(ss1, 8); ss1 += __shfl_xor(ss1, 16); ss1 += __shfl_xor(ss1, 32);
                ss2 += __shfl_xor(ss2, 8); ss2 += __shfl_xor(ss2, 16); ss2 += __shfl_xor(ss2, 32);
                if (lo && fq == 0) { P[rl * 4 + wc] = ss1; P[(rl + 8) * 4 + wc] = ss2; } }
        asm volatile("s_waitcnt lgkmcnt(0)" ::: "memory"); __builtin_amdgcn_s_barrier(); asm volatile("" ::: "memory");
        if (tid < 256) { const PG8_LAS f32x4* p4 = (const PG8_LAS f32x4*)P + tid; const f32x4 v = *p4; ssq[(size_t)u.pn * MROWS + u.pm * BM + tid] = (v[0] + v[1]) + (v[2] + v[3]); }
    }
};

template <class Epi, class Sched, bool ALIGN_EPI = false, bool SP2 = false>
__device__ __forceinline__ void gemm_phase(PG8_LAS unsigned char* lds, const Gemm g, const Sched& S, const Epi& E) {
    int tid_ = threadIdx.x; asm volatile("" : "+v"(tid_)); const int tid = tid_, wid = __builtin_amdgcn_readfirstlane(tid >> 6), lane = tid & 63, wr = wid >> 2, wc = wid & 3, fr = lane & 15, fq = lane >> 4;
    const int K = g.K, nt = K / BK, lda = g.lda;
    unsigned voffA[2], voffB[2];
#pragma unroll
    for (int i = 0; i < 2; ++i) { int R, C; stage_rc(tid * 16 + i * 8192, R, C); const int Rb = Epi::PERM ? (64 * (R >> 5) + perm32(R & 31)) : R;
        voffA[i] = (unsigned)(R * lda + C) * 2u; voffB[i] = (unsigned)(Rb * K + C) * 2u; }
    const size_t kstep = (size_t)(BK * 2);
    const size_t hstepA = (size_t)HALF * lda * 2, hstepB = (size_t)(Epi::PERM ? 32 : HALF) * K * 2;
    const size_t tstepA = g.a_tstep, tstepB = (size_t)BM * K * 2;
    const unsigned ldsw = (unsigned)wid * 1024u;
    const int aoff = lds_byte(wr * 64 + fr, fq * 8), boff = lds_byte(wc * 32 + fr, fq * 8);
#define PG8_SA(b, h) (((b) * 2 + (h)) * HTB)
#define PG8_SB(b, h) ((4 + (b) * 2 + (h)) * HTB)
#define PG8_STAGE(bufoff, gbase, voff) do { _Pragma("unroll") for (int _i = 0; _i < 2; ++_i) \
        __builtin_amdgcn_global_load_lds((const unsigned*)((const char*)(gbase) + (voff)[_i]), (PG8_LAS unsigned*)(lds + (bufoff) + ldsw + _i * 8192), 16, 0, 0); } while (0)
#define PG8_LDA(dst, b, h) do { _Pragma("unroll") for (int m = 0; m < 4; ++m) _Pragma("unroll") for (int k = 0; k < 2; ++k) dst[m][k] = *(const PG8_LAS bf16x8*)(lds + PG8_SA(b, h) + aoff + m * 2048 + k * 1024); } while (0)
#define PG8_LDB(dst, b, h) do { _Pragma("unroll") for (int n = 0; n < 2; ++n) _Pragma("unroll") for (int k = 0; k < 2; ++k) dst[n][k] = *(const PG8_LAS bf16x8*)(lds + PG8_SB(b, h) + boff + n * 2048 + k * 1024); } while (0)
#define PG8_MMA(ai, bj, At, Bt) do { __builtin_amdgcn_s_setprio(1); _Pragma("unroll") for (int m = 0; m < 4; ++m) _Pragma("unroll") for (int n = 0; n < 2; ++n) _Pragma("unroll") for (int k = 0; k < 2; ++k) \
        acc[ai][bj][m][n] = __builtin_amdgcn_mfma_f32_16x16x32_bf16(Bt[n][k], At[m][k], acc[ai][bj][m][n], 0, 0, 0); __builtin_amdgcn_s_setprio(0); } while (0)
#define PG8_WAIT_V(n) asm volatile("s_waitcnt vmcnt(" #n ")" ::: "memory")
#define PG8_WAIT_L(n) asm volatile("s_waitcnt lgkmcnt(" #n ")" ::: "memory")
#define PG8_BAR __builtin_amdgcn_s_barrier()
#define PG8_SCHED __builtin_amdgcn_sched_barrier(0)
    Unit cur, nxt; int ui = 0;
    if (!S.next(0, cur)) return;
    f32x4 acc[2][2][4][2];
#pragma unroll
    for (int a = 0; a < 2; ++a)
#pragma unroll
        for (int b = 0; b < 2; ++b)
#pragma unroll
            for (int m = 0; m < 4; ++m)
#pragma unroll
                for (int n = 0; n < 2; ++n) acc[a][b][m][n] = (f32x4){0.f, 0.f, 0.f, 0.f};
    bf16x8 At[4][2], B0[2][2], B1[2][2];
    const char* cA = (const char*)g.A + (size_t)cur.pm * tstepA; const char* cB = (const char*)g.Bt + (size_t)cur.pn * tstepB;
    S.a_ready(cur);
    if constexpr (SP2) {
        PG8_STAGE(PG8_SB(0, 0), cB, voffB); PG8_STAGE(PG8_SB(0, 1), cB + hstepB, voffB); PG8_STAGE(PG8_SA(0, 0), cA, voffA); PG8_STAGE(PG8_SA(0, 1), cA + hstepA, voffA);
        if (wr == 1) PG8_BAR;
        PG8_WAIT_V(2); PG8_BAR;
        PG8_STAGE(PG8_SB(1, 0), cB + kstep, voffB); PG8_STAGE(PG8_SA(1, 0), cA + kstep, voffA); PG8_STAGE(PG8_SB(1, 1), cB + hstepB + kstep, voffB);
        PG8_WAIT_V(6); PG8_BAR;
    } else {
        PG8_STAGE(PG8_SB(0, 0), cB, voffB); PG8_STAGE(PG8_SA(0, 0), cA, voffA); PG8_STAGE(PG8_SB(0, 1), cB + hstepB, voffB); PG8_STAGE(PG8_SA(0, 1), cA + hstepA, voffA);
        if (wr == 1) PG8_BAR;
        PG8_WAIT_V(4); PG8_BAR;
        PG8_STAGE(PG8_SB(1, 0), cB + kstep, voffB); PG8_STAGE(PG8_SA(1, 0), cA + kstep, voffA); PG8_STAGE(PG8_SB(1, 1), cB + hstepB + kstep, voffB);
        PG8_WAIT_V(6); PG8_BAR;
    }
    for (;;) {
        const bool has_next = S.next(ui + 1, nxt);
        const char* nA = has_next ? (const char*)g.A + (size_t)nxt.pm * tstepA : cA; const char* nB = has_next ? (const char*)g.Bt + (size_t)nxt.pn * tstepB : cB;
        for (int t = 0; t < nt; t += 2) {
            const bool last = (t == nt - 2);
            const char* a1 = cA + (size_t)(t + 1) * kstep;
            const char* a2 = last ? nA : cA + (size_t)(t + 2) * kstep; const char* b2 = last ? nB : cB + (size_t)(t + 2) * kstep;
            const char* a3 = a2 + kstep; const char* b3 = b2 + kstep;
            if (last && has_next) S.a_ready(nxt);
            if constexpr (SP2) {
            PG8_LDB(B0, 0, 0); PG8_LDB(B1, 0, 1); PG8_SCHED; PG8_LDA(At, 0, 0); PG8_STAGE(PG8_SA(1, 1), a1 + hstepA, voffA);
            PG8_WAIT_V(8); PG8_WAIT_L(0); PG8_BAR; PG8_MMA(0, 0, At, B0); PG8_MMA(0, 1, At, B1); PG8_BAR; PG8_SCHED;
            PG8_LDA(At, 0, 1); PG8_STAGE(PG8_SB(0, 0), b2, voffB); PG8_STAGE(PG8_SB(0, 1), b2 + hstepB, voffB); PG8_STAGE(PG8_SA(0, 0), a2, voffA);
            PG8_WAIT_V(8); PG8_WAIT_L(0); PG8_BAR; PG8_MMA(1, 0, At, B0); PG8_MMA(1, 1, At, B1); PG8_BAR; PG8_SCHED;
            PG8_LDB(B0, 1, 0); PG8_LDB(B1, 1, 1); PG8_SCHED; PG8_LDA(At, 1, 0); PG8_STAGE(PG8_SA(0, 1), a2 + hstepA, voffA);
            PG8_WAIT_V(8); PG8_WAIT_L(0); PG8_BAR; PG8_MMA(0, 0, At, B0); PG8_MMA(0, 1, At, B1); PG8_BAR; PG8_SCHED;
            PG8_LDA(At, 1, 1); PG8_STAGE(PG8_SB(1, 0), b3, voffB); PG8_STAGE(PG8_SB(1, 1), b3 + hstepB, voffB); PG8_STAGE(PG8_SA(1, 0), a3, voffA);
            PG8_WAIT_V(8); PG8_WAIT_L(0); PG8_BAR; PG8_MMA(1, 0, At, B0); PG8_MMA(1, 1, At, B1); PG8_BAR; PG8_SCHED;
            } else {
            PG8_LDB(B0, 0, 0); PG8_SCHED; PG8_LDA(At, 0, 0); PG8_STAGE(PG8_SA(1, 1), a1 + hstepA, voffA);
            PG8_WAIT_L(8); PG8_BAR; PG8_WAIT_L(0); PG8_MMA(0, 0, At, B0); PG8_BAR; PG8_SCHED;
            PG8_LDB(B1, 0, 1); PG8_STAGE(PG8_SB(0, 0), b2, voffB);
            PG8_BAR; PG8_WAIT_L(0); PG8_MMA(0, 1, At, B1); PG8_BAR;
            PG8_LDA(At, 0, 1); PG8_STAGE(PG8_SA(0, 0), a2, voffA);
            PG8_BAR; PG8_WAIT_L(0); PG8_MMA(1, 0, At, B0); PG8_BAR; PG8_SCHED;
            PG8_STAGE(PG8_SB(0, 1), b2 + hstepB, voffB);
            PG8_WAIT_V(6); PG8_BAR; PG8_MMA(1, 1, At, B1); PG8_BAR;
            PG8_LDB(B0, 1, 0); PG8_SCHED; PG8_LDA(At, 1, 0); PG8_STAGE(PG8_SA(0, 1), a2 + hstepA, voffA);
            PG8_WAIT_L(8); PG8_BAR; PG8_WAIT_L(0); PG8_MMA(0, 0, At, B0); PG8_BAR; PG8_SCHED;
            PG8_LDB(B1, 1, 1); PG8_STAGE(PG8_SB(1, 0), b3, voffB);
            PG8_BAR; PG8_WAIT_L(0); PG8_MMA(0, 1, At, B1); PG8_BAR;
            PG8_LDA(At, 1, 1); PG8_STAGE(PG8_SA(1, 0), a3, voffA);
            PG8_BAR; PG8_WAIT_L(0); PG8_MMA(1, 0, At, B0); PG8_BAR; PG8_SCHED;
            PG8_STAGE(PG8_SB(1, 1), b3 + hstepB, voffB);
            PG8_WAIT_V(6); PG8_BAR; PG8_MMA(1, 1, At, B1); PG8_BAR;
            }
        }
        if constexpr (ALIGN_EPI) { if (wr == 0) PG8_BAR; }
        if constexpr (!Epi::AFTER_DRAIN) { E(acc, cur, wr, wc, fr, fq); S.done(cur); }
        if (!has_next) break;
#pragma unroll
        for (int a = 0; a < 2; ++a)
#pragma unroll
            for (int b = 0; b < 2; ++b)
#pragma unroll
                for (int m = 0; m < 4; ++m)
#pragma unroll
                    for (int n = 0; n < 2; ++n) acc[a][b][m][n] = (f32x4){0.f, 0.f, 0.f, 0.f};
        cur = nxt; cA = nA; cB = nB; ++ui;
        if constexpr (ALIGN_EPI) { if (wr == 1) PG8_BAR; }
    }
    PG8_WAIT_V(0);
    if constexpr (!ALIGN_EPI) { if (wr == 0) PG8_BAR; }
    PG8_BAR;
    if constexpr (Epi::AFTER_DRAIN) { E.fused(acc, cur, wr, wc, fr, fq, lds, tid); S.done(cur); }
#undef PG8_SA
#undef PG8_SB
#undef PG8_STAGE
#undef PG8_LDA
#undef PG8_LDB
#undef PG8_MMA
#undef PG8_WAIT_V
#undef PG8_WAIT_L
#undef PG8_BAR
#undef PG8_SCHED
}
}

constexpr int NWAVES = 8;
constexpr int N_LAUNCHES = MK_N_LAUNCHES;
constexpr int NPH = 26;
constexpr int M = 16384, D = 1024, T = 4096, FF = 4096, NIN = 3072, APROJ = 3088, KD = 512;
constexpr float EPS = 1e-6f, LOG2E = 1.4426950408889634f;

constexpr size_t MiB = 1u << 20;
constexpr size_t WS_CTL = 0, CTL_ZERO_BYTES = 1 * MiB;
constexpr size_t WS_SSQ = 1 * MiB;
constexpr size_t WS_WG = 2 * MiB;
constexpr size_t WS_BEND = 2 * MiB + 65536;
constexpr size_t WS_WIN = 3 * MiB;
constexpr size_t WS_KV = 3 * MiB;
constexpr size_t WS_WAO = 15 * MiB;
constexpr size_t WS_WUP = 19 * MiB;
constexpr size_t WS_WDN = 51 * MiB;
constexpr size_t WS_WQ = 83 * MiB;
constexpr size_t WS_WQ1 = WS_WQ + (size_t)1280 * 1024 * 2;
constexpr size_t WS_WBO = 88 * MiB;
constexpr size_t WS_HB = 92 * MiB;
constexpr size_t WS_U = 124 * MiB;
constexpr size_t PANEL_B = 2 * MiB, PANEL_E = PANEL_B / 2, BCUM_OFF_E = 786432;
constexpr size_t WS_END = 252 * MiB;
constexpr int CW_BAR = 4096;
constexpr int CW_GRP = 16384;

constexpr int LDS_BYTES = 147456;
constexpr int RING_BYTES = 131072, LDSCTL_OFF = 143360, MISC_OFF = LDSCTL_OFF + 320;

#define GAS __attribute__((address_space(1)))
#define LAS __attribute__((address_space(3)))
typedef unsigned short bf16;
typedef unsigned v4u __attribute__((ext_vector_type(4)));
typedef unsigned v2u __attribute__((ext_vector_type(2)));
typedef float f32x4 __attribute__((ext_vector_type(4)));
typedef GAS unsigned gu32;
typedef short bf16x8 __attribute__((ext_vector_type(8)));
typedef short s16x4 __attribute__((ext_vector_type(4)));
__device__ __forceinline__ s16x4 tr_read(const LAS unsigned char* p) { return __builtin_bit_cast(s16x4, __builtin_amdgcn_ds_read_tr16_b64_v4i16((LAS s16x4*)p)); }
#define RLX_AGENT __ATOMIC_RELAXED, __HIP_MEMORY_SCOPE_AGENT
#define LDS_WAIT() asm volatile("s_waitcnt lgkmcnt(0)" ::: "memory")
#define VM_WAIT() asm volatile("s_waitcnt vmcnt(0)" ::: "memory")
__device__ __forceinline__ unsigned f2bf(float f) { unsigned u = __builtin_bit_cast(unsigned, f); return (u + 0x7fffu + ((u >> 16) & 1u)) >> 16; }
__device__ __forceinline__ unsigned pk2(float lo, float hi) { return f2bf(lo) | (f2bf(hi) << 16); }
__device__ __forceinline__ float bf2f(unsigned short b) { return __builtin_bit_cast(float, (unsigned)b << 16); }
__device__ __forceinline__ float bflo(unsigned w) { return __builtin_bit_cast(float, w << 16); }
__device__ __forceinline__ float bfhi(unsigned w) { return __builtin_bit_cast(float, w & 0xffff0000u); }

#define XB_TMO      128
#define XB_XCNT(j)  (256  + 64 * (j))
#define XB_XSUB(j)  (1280 + 64 * (j))
#define XB_XGEN(j)  (2304 + 64 * (j))
#define XB_TOP      3328
#define XB_TOPGEN   3392
#define XCD_BAR_WORDS 3456
#define XB_SPIN_CAP (1u << 18)
__device__ __forceinline__ unsigned xb_ld(unsigned* p)              { return __hip_atomic_load(p, __ATOMIC_RELAXED, __HIP_MEMORY_SCOPE_AGENT); }
__device__ __forceinline__ unsigned xb_add(unsigned* p, unsigned v) { return __hip_atomic_fetch_add(p, v, __ATOMIC_RELAXED, __HIP_MEMORY_SCOPE_AGENT); }
__device__ __forceinline__ unsigned xb_xcc_id() { return (unsigned)__builtin_amdgcn_s_getreg((3 << 11) | 20) & 0xFu; }
#define XB_SPIN(cond, bar) do { unsigned _sp = 0; while (cond) { __builtin_amdgcn_s_sleep(1); \
    if ((++_sp & 255u) == 0u) { if (xb_ld(&(bar)[XB_TMO])) break; if (_sp > XB_SPIN_CAP) { atomicAdd(&(bar)[XB_TMO], 1u); break; } } } } while (0)
struct XcdBarrier { unsigned* bar; unsigned x; volatile LAS unsigned* st; };
__device__ __forceinline__ XcdBarrier xcd_barrier_post(unsigned* bar, volatile LAS unsigned* st) {
    XcdBarrier b; b.bar = bar; b.x = xb_xcc_id(); b.st = st;
    if (threadIdx.x == 0) (void)xb_add(&bar[XB_XCNT(b.x)], 1u);
    return b;
}
__device__ __forceinline__ void xcd_barrier_complete(unsigned* bar, unsigned x, unsigned& nloc, unsigned& nx) {
    const unsigned G = gridDim.x * gridDim.y * gridDim.z;
    unsigned sum, cnt, mine, sp = 0u;
    for (;;) {
        sum = 0u; cnt = 0u; mine = 0u;
#pragma unroll
        for (unsigned j = 0; j < 16; ++j) { const unsigned c = xb_ld(&bar[XB_XCNT(j)]); sum += c; cnt += (c > 0u) ? 1u : 0u; mine = (j == x) ? c : mine; }
        if (sum == G) break;
        __builtin_amdgcn_s_sleep(1);
        if ((++sp & 255u) == 0u) { if (xb_ld(&bar[XB_TMO])) break; if (sp > XB_SPIN_CAP) { atomicAdd(&bar[XB_TMO], 1u); break; } }
    }
    nloc = mine > 0u ? mine : 1u; nx = cnt > 0u ? cnt : 1u;
}
__device__ __forceinline__ void xcd_barrier(const XcdBarrier& b) {
    asm volatile("s_waitcnt vmcnt(0)" ::: "memory");
    __syncthreads();
    if (threadIdx.x == 0) {
        unsigned* bar = b.bar;
        __builtin_amdgcn_s_waitcnt(0);
        unsigned nloc = b.st[0], nx = b.st[1];
        if (nloc == 0u) { xcd_barrier_complete(bar, b.x, nloc, nx); b.st[0] = nloc; b.st[1] = nx; }
        const unsigned old = xb_add(&bar[XB_XSUB(b.x)], 1u);
        const unsigned gen = old / nloc;
        if (old + 1u == (gen + 1u) * nloc) {
            __builtin_amdgcn_fence(__ATOMIC_RELEASE, "agent");
            asm volatile("s_waitcnt vmcnt(0)" ::: "memory");
            const unsigned og = xb_add(&bar[XB_TOP], 1u);
            const unsigned tg = og / nx;
            if (og + 1u == (tg + 1u) * nx) xb_add(&bar[XB_TOPGEN], 1u);
            else XB_SPIN(xb_ld(&bar[XB_TOPGEN]) == tg, bar);
            __builtin_amdgcn_fence(__ATOMIC_ACQUIRE, "agent");
            xb_add(&bar[XB_XGEN(b.x)], 1u);
            asm volatile("s_waitcnt vmcnt(0)" ::: "memory");
        } else {
            XB_SPIN(xb_ld(&bar[XB_XGEN(b.x)]) == gen, bar);
            __builtin_amdgcn_fence(__ATOMIC_ACQUIRE, "agent");
            asm volatile("s_waitcnt vmcnt(0)" ::: "memory");
        }
    }
    __syncthreads();
}

__device__ __forceinline__ void bc_unpack(v4u w, f32x4& a, f32x4& b) { const float s = 1.0f / 2048.0f;
    a[0] = (float)(short)(w.x & 0xffffu) * s; a[1] = (float)((int)w.x >> 16) * s; a[2] = (float)(short)(w.y & 0xffffu) * s; a[3] = (float)((int)w.y >> 16) * s;
    b[0] = (float)(short)(w.z & 0xffffu) * s; b[1] = (float)((int)w.z >> 16) * s; b[2] = (float)(short)(w.w & 0xffffu) * s; b[3] = (float)((int)w.w >> 16) * s; }
__device__ __forceinline__ void group_barrier(unsigned* ctr, unsigned target, unsigned* tmo) {
    asm volatile("s_waitcnt vmcnt(0)" ::: "memory");
    __syncthreads();
    if (threadIdx.x == 0) {
        __builtin_amdgcn_s_waitcnt(0);
        __builtin_amdgcn_fence(__ATOMIC_RELEASE, "agent");
        asm volatile("s_waitcnt vmcnt(0)" ::: "memory");
        xb_add(ctr, 1u);
        unsigned sp = 0;
        while (xb_ld(ctr) < target) { __builtin_amdgcn_s_sleep(1); if ((++sp & 255u) == 0u) { if (xb_ld(tmo)) break; if (sp > XB_SPIN_CAP) { atomicAdd(tmo, 1u); break; } } }
        __builtin_amdgcn_fence(__ATOMIC_ACQUIRE, "agent");
        asm volatile("s_waitcnt vmcnt(0)" ::: "memory");
    }
    __syncthreads();
}
__device__ __forceinline__ float wave_sum(float v) {
#pragma unroll
    for (int o = 1; o < 64; o <<= 1) v += __shfl_xor(v, o);
    return v;
}

struct P0Item { const float* W; int ldw, K, nblk; bf16* WT; const float* gain; float scale; int nscale, item; };
__device__ __forceinline__ void p0_load(const P0Item& d, int lane, f32x4 (&v)[8], float (&gn)[4]) {
    const GAS float* W = (const GAS float*)d.W;
    const int kb = d.item / d.nblk, nb = d.item % d.nblk, k0 = 64 * kb, n0 = 32 * nb, l15 = lane & 15, g = lane >> 4;
#pragma unroll
    for (int t = 0; t < 4; ++t) { const int k = k0 + 8 * (l15 >> 2) + 4 * (t & 1) + (l15 & 3) + 32 * (t >> 1); const GAS float* p = W + (size_t)k * d.ldw + n0 + 4 * g;
        v[2 * t] = *(const GAS f32x4*)p; v[2 * t + 1] = *(const GAS f32x4*)(p + 16); gn[t] = d.gain ? d.gain[k] : 1.0f; }
}
__device__ __forceinline__ void p0_finish(const P0Item& d, int lane, const f32x4 (&v)[8], const float (&gn)[4], bf16x8 B1, bf16x8 B2) {
    const int kb = d.item / d.nblk, nb = d.item % d.nblk, k0 = 64 * kb, n0 = 32 * nb, l15 = lane & 15, g = lane >> 4;
    const float sc = n0 < d.nscale ? d.scale : 1.0f;
    f32x4 D1[4], D2[4];
#pragma unroll
    for (int t = 0; t < 4; ++t) { const float m = gn[t] * sc; v4u a; a.x = pk2(v[2 * t][0] * m, v[2 * t][1] * m); a.y = pk2(v[2 * t][2] * m, v[2 * t][3] * m); a.z = pk2(v[2 * t + 1][0] * m, v[2 * t + 1][1] * m); a.w = pk2(v[2 * t + 1][2] * m, v[2 * t + 1][3] * m);
        const bf16x8 af = __builtin_bit_cast(bf16x8, a);
        D1[t] = __builtin_amdgcn_mfma_f32_16x16x32_bf16(af, B1, (f32x4){0.f, 0.f, 0.f, 0.f}, 0, 0, 0); D2[t] = __builtin_amdgcn_mfma_f32_16x16x32_bf16(af, B2, (f32x4){0.f, 0.f, 0.f, 0.f}, 0, 0, 0); }
    GAS bf16* o1 = (GAS bf16*)d.WT + (size_t)(n0 + l15) * d.K + k0 + 8 * g; GAS bf16* o2 = o1 + (size_t)16 * d.K;
    v4u w;
    w.x = pk2(D1[0][0], D1[0][1]); w.y = pk2(D1[0][2], D1[0][3]); w.z = pk2(D1[1][0], D1[1][1]); w.w = pk2(D1[1][2], D1[1][3]); *(GAS v4u*)o1 = w;
    w.x = pk2(D1[2][0], D1[2][1]); w.y = pk2(D1[2][2], D1[2][3]); w.z = pk2(D1[3][0], D1[3][1]); w.w = pk2(D1[3][2], D1[3][3]); *(GAS v4u*)(o1 + 32) = w;
    w.x = pk2(D2[0][0], D2[0][1]); w.y = pk2(D2[0][2], D2[0][3]); w.z = pk2(D2[1][0], D2[1][1]); w.w = pk2(D2[1][2], D2[1][3]); *(GAS v4u*)o2 = w;
    w.x = pk2(D2[2][0], D2[2][1]); w.y = pk2(D2[2][2], D2[2][3]); w.z = pk2(D2[3][0], D2[3][1]); w.w = pk2(D2[3][2], D2[3][3]); *(GAS v4u*)(o2 + 32) = w;
}

struct Args { const float* in[17]; float* out; unsigned char* ws; int ph_lo, ph_hi, li, pad; };

__device__ __forceinline__ float logsigmoidf(float z) { return fminf(z, 0.f) - log1pf(__expf(-fabsf(z))); }

__global__ void __launch_bounds__(NWAVES * 64, 2) yoco_fwd(Args args) {
    extern __shared__ __attribute__((aligned(16))) unsigned char lds[];
    LAS unsigned char* ldsl = (LAS unsigned char*)lds;
    volatile LAS unsigned* MISC = (volatile LAS unsigned*)(ldsl + MISC_OFF);
    const int tid0 = threadIdx.x, lane0 = tid0 & 63, wave0 = __builtin_amdgcn_readfirstlane(tid0 >> 6);
#define PHASE_IDS int tid = threadIdx.x; asm volatile("" : "+v"(tid)); const int lane = tid & 63, wave = __builtin_amdgcn_readfirstlane(tid >> 6); (void)lane; (void)wave;
    const int G = gridDim.x; const int bx = blockIdx.x; const int vcu = (G % 8 == 0) ? (bx % 8) * (G / 8) + bx / 8 : bx;
    unsigned char* ws = args.ws;
    gu32* ctl = (gu32*)(ws + WS_CTL);
    const float* x = args.in[0]; const float* a_w_in = args.in[1]; const float* a_w_gk2 = args.in[2]; const float* a_b_gk = args.in[3]; const float* a_onorm = args.in[4];
    const float* a_w_out = args.in[5]; const float* kv_norm = args.in[6]; const float* w_kv = args.in[7]; const float* b_w_q = args.in[8]; const float* b_sinks = args.in[9];
    const float* b_w_out = args.in[10]; const float* rel_table = args.in[11]; const float* ln_mix = args.in[12]; const float* ln_mlp = args.in[13];
    const float* w_up = args.in[14]; const float* w_down = args.in[15]; const float* ln_final = args.in[16];
    float* out = args.out;
    float* ssq = (float*)(ws + WS_SSQ);
    bf16* Wg_t = (bf16*)(ws + WS_WG); float* BendG = (float*)(ws + WS_BEND);
    bf16* Win_t = (bf16*)(ws + WS_WIN); bf16* KVb = (bf16*)(ws + WS_KV); bf16* Wao_t = (bf16*)(ws + WS_WAO); bf16* Wup_t = (bf16*)(ws + WS_WUP); bf16* Wdn_t = (bf16*)(ws + WS_WDN);
    bf16* Wq0_t = (bf16*)(ws + WS_WQ); bf16* Wq1_t = (bf16*)(ws + WS_WQ1); bf16* Wbo_t = (bf16*)(ws + WS_WBO);
    bf16* HB = (bf16*)(ws + WS_HB); bf16* Sst = (bf16*)out;
    bf16* U = (bf16*)(ws + WS_U); bf16* QKVG = (bf16*)(ws + WS_U); bf16* Qb = (bf16*)(ws + WS_U);

    for (int u = tid0; u < (LDS_BYTES - LDSCTL_OFF) / 4; u += NWAVES * 64) ((LAS unsigned*)(ldsl + LDSCTL_OFF))[u] = 0u;
    __syncthreads();
    XcdBarrier bar; bar.bar = (unsigned*)(ctl + CW_BAR) + args.li * XCD_BAR_WORDS; bar.x = 0; bar.st = nullptr;
    if (N_LAUNCHES != NPH) bar = xcd_barrier_post((unsigned*)(ctl + CW_BAR) + args.li * XCD_BAR_WORDS, MISC + 8);
    const bool grp_ok = (G == 256) && (N_LAUNCHES == 1);
    unsigned* gctr = (unsigned*)(ctl + CW_GRP) + 64 * (8 * (bx % 8) + (bx / 8) % 8); unsigned gepoch = 0;
    const int vwg = grp_ok ? 4 * (8 * (bx % 8) + (bx / 8) % 8) + (bx >> 6) : vcu;
    unsigned* gtmo = (unsigned*)(ctl + CW_BAR) + XB_TMO;
#define GROUP_BAR(cls) do { if (grp_ok) { ++gepoch; group_barrier(gctr, 4u * gepoch, gtmo); } else GRID_BAR(cls); } while (0)
#if PROBE_SEL
    unsigned long long pr_acc = 0, pr_t0 = 0, pr_tb = 0;
#define TIC() do { pr_t0 = __builtin_amdgcn_s_memrealtime(); } while (0)
#define TOC(cls) do { if ((PROBE_SEL >> (cls)) & 1) pr_acc += __builtin_amdgcn_s_memrealtime() - pr_t0; } while (0)
#define GRID_BAR(cls) do { if (N_LAUNCHES != NPH) { pr_tb = __builtin_amdgcn_s_memrealtime(); xcd_barrier(bar); if (((PROBE_SEL >> 12) & 1) || ((PROBE_SEL >> (16 + (cls))) & 1)) pr_acc += __builtin_amdgcn_s_memrealtime() - pr_tb; } } while (0)
#else
#define TIC() do { } while (0)
#define TOC(cls) do { } while (0)
#define GRID_BAR(cls) do { if (N_LAUNCHES != NPH) xcd_barrier(bar); } while (0)
#endif
    const int lo = args.ph_lo, hi = args.ph_hi;
#define IN(k) (lo <= (k) && (k) < hi)
#define BOTH(k) (IN(k) && IN((k) + 1))

    if (IN(0)) { PHASE_IDS TIC();
        const int gw = vcu * NWAVES + wave, NGW = G * NWAVES;
        constexpr int I_IN = 4 * 96, I_SQ = 4 * 32, I_UP = 4 * 128, I_DN = 16 * 32, I_KV = 4 * 8;
        constexpr int NITEMS = 2 * I_IN + 2 * I_SQ + 4 * I_UP + 4 * I_DN + 2 * I_SQ + I_KV + 2 * I_SQ;
#define P0_ITEM(r, nblk) ((4 * ((r) / (nblk))) * (nblk) + (r) % (nblk))
#define P0_DECODE(dst, itv) do { int r = (itv); \
            if (r < 2 * I_IN) { const int l = r / I_IN; r %= I_IN; dst = P0Item{a_w_in + (size_t)l * D * APROJ, APROJ, D, 96, Win_t + (size_t)l * NIN * D, ln_mix + l * D, 0.08838834764831845f, 512, P0_ITEM(r, 96)}; break; } r -= 2 * I_IN; \
            if (r < 2 * I_SQ) { const int l = r / I_SQ; r %= I_SQ; dst = P0Item{a_w_out + (size_t)l * D * D, D, D, 32, Wao_t + (size_t)l * D * D, nullptr, 1.f, 0, P0_ITEM(r, 32)}; break; } r -= 2 * I_SQ; \
            if (r < 4 * I_UP) { const int l = r / I_UP; r %= I_UP; dst = P0Item{w_up + (size_t)l * D * FF, FF, D, 128, Wup_t + (size_t)l * FF * D, ln_mlp + l * D, 1.f, 0, P0_ITEM(r, 128)}; break; } r -= 4 * I_UP; \
            if (r < 4 * I_DN) { const int l = r / I_DN; r %= I_DN; dst = P0Item{w_down + (size_t)l * FF * D, D, FF, 32, Wdn_t + (size_t)l * D * FF, nullptr, 1.f, 0, P0_ITEM(r, 32)}; break; } r -= 4 * I_DN; \
            if (r < 2 * I_SQ) { const int j = r / I_SQ; r %= I_SQ; dst = P0Item{b_w_q + (size_t)j * D * D, D, D, 32, j == 0 ? Wq0_t : Wq1_t, ln_mix + (2 + j) * D, 0.125f * LOG2E, 1024, P0_ITEM(r, 32)}; break; } r -= 2 * I_SQ; \
            if (r < I_KV) { dst = P0Item{w_kv, 256, D, 8, Wq0_t + (size_t)1024 * D, kv_norm, 1.f, 0, P0_ITEM(r, 8)}; break; } r -= I_KV; \
            { const int j = r / I_SQ; r %= I_SQ; dst = P0Item{b_w_out + (size_t)j * D * D, D, D, 32, Wbo_t + (size_t)j * D * D, nullptr, 1.f, 0, P0_ITEM(r, 32)}; } } while (0)
        bf16x8 B1, B2;
        { const int l15 = lane & 15, g = lane >> 4; const bool on = g == (l15 >> 2); const int jsel = l15 & 3;
#pragma unroll
          for (int j = 0; j < 8; ++j) { B1[j] = (on && j == jsel) ? (short)0x3F80 : (short)0; B2[j] = (on && j == 4 + jsel) ? (short)0x3F80 : (short)0; } }
        for (int it = gw; it < NITEMS; it += NGW) {
            P0Item d0; P0_DECODE(d0, it); P0Item d1 = d0, d2 = d0, d3 = d0; d1.item += d0.nblk; d2.item += 2 * d0.nblk; d3.item += 3 * d0.nblk;
            f32x4 v0[8], v1[8], v2[8], v3[8]; float g0[4], g1[4], g2[4], g3[4];
            p0_load(d0, lane, v0, g0); p0_load(d1, lane, v1, g1); p0_load(d2, lane, v2, g2); p0_load(d3, lane, v3, g3);
            p0_finish(d0, lane, v0, g0, B1, B2); p0_finish(d1, lane, v1, g1, B1, B2); p0_finish(d2, lane, v2, g2, B1, B2); p0_finish(d3, lane, v3, g3, B1, B2);
        }
#undef P0_DECODE
#undef P0_ITEM
        for (int e = vcu * 512 + tid; e < 2 * 16 * 1024; e += G * 512) { const int l = e >> 14, n = (e >> 10) & 15, k = e & 1023;
            Wg_t[e] = (bf16)f2bf(a_w_in[((size_t)l * D + k) * APROJ + NIN + n] * ln_mix[l * D + k]); }
        for (int m0 = gw * 4; m0 < M; m0 += NGW * 4) {
            f32x4 v[4][4];
#pragma unroll
            for (int r = 0; r < 4; ++r) { const GAS f32x4* xr = (const GAS f32x4*)(x + (size_t)(m0 + r) * D) + lane;
#pragma unroll
                for (int j = 0; j < 4; ++j) v[r][j] = xr[64 * j]; }
#pragma unroll
            for (int r = 0; r < 4; ++r) { float s = 0.f;
#pragma unroll
                for (int j = 0; j < 4; ++j) s += (v[r][j].x * v[r][j].x + v[r][j].y * v[r][j].y) + (v[r][j].z * v[r][j].z + v[r][j].w * v[r][j].w);
                s = wave_sum(s);
                GAS unsigned long long* o8 = (GAS unsigned long long*)(HB + (size_t)(m0 + r) * D) + lane;
#pragma unroll
                for (int j = 0; j < 4; ++j) o8[64 * j] = (unsigned long long)pk2(v[r][j].x, v[r][j].y) | ((unsigned long long)pk2(v[r][j].z, v[r][j].w) << 32);
                if (lane < 4) ssq[(size_t)lane * M + m0 + r] = lane == 0 ? s : 0.f; }
        }
        TOC(0); if (BOTH(0)) GRID_BAR(0);
    }

    for (int L = 0; L < 4; ++L) {
        const bool gla = L < 2; const int jb = L - 2;
        const int base = gla ? 1 + 7 * L : 15 + 5 * jb;
        const int pG1 = gla ? base + 4 : base + 2;
        if (IN(base)) { PHASE_IDS TIC();
            pg8::Gemm g; pg8::EpiScale E; E.ssq = ssq; E.act = 0;
            if (gla) { g = pg8::Gemm{HB, Win_t + (size_t)L * NIN * D, M, NIN, D, D, (size_t)256 * D * 2}; E.O = QKVG; E.ldc = NIN; E.tstep = PANEL_B; E.O2 = nullptr; E.ldc2 = 0; E.tstep2 = 0; E.split_col = 1 << 30; }
            else if (jb == 0) { g = pg8::Gemm{HB, Wq0_t, M, 1280, D, D, (size_t)256 * D * 2}; E.O = Qb; E.ldc = D; E.tstep = PANEL_B; E.O2 = KVb; E.ldc2 = 256; E.tstep2 = 256 * 256 * 2; E.split_col = 1024; }
            else { g = pg8::Gemm{HB, Wq1_t, M, 1024, D, D, (size_t)256 * D * 2}; E.O = Qb; E.ldc = D; E.tstep = PANEL_B; E.O2 = nullptr; E.ldc2 = 0; E.tstep2 = 0; E.split_col = 1 << 30; }
            pg8::StaticOrder S; S.init(M, g.N, G, (int)blockIdx.x);
            { pg8::Unit u0; const bool has = S.next(0, u0); LAS float* rtab = (LAS float*)(ldsl + RING_BYTES);
              if (has && tid < 256) rtab[tid] = pg8::row_rstd(ssq, u0.pm * 256 + tid);
              __syncthreads(); E.rtab = rtab; E.tab_pm = has ? u0.pm : -1; }
            pg8::gemm_phase<pg8::EpiScale, pg8::StaticOrder, true, true>(ldsl, g, S, E);
            TOC(gla ? 1 : 6); TIC();
            if (gla) {
                LAS float* part = (LAS float*)ldsl;
                LAS float* glr_s = (LAS float*)(ldsl + 8192);
                const GAS bf16* Wg = (const GAS bf16*)(Wg_t + (size_t)L * 16 * 1024);
                const int g4 = lane >> 4, l15 = lane & 15, mt = wave & 3, kh = wave >> 2;
                for (int c = vwg; c < M / 64; c += G) {
                    __syncthreads();
                    { const GAS bf16* ap = (const GAS bf16*)HB + (size_t)(c * 64 + 16 * mt + l15) * D + 512 * kh + 8 * g4; const GAS bf16* bp = Wg + (size_t)l15 * D + 512 * kh + 8 * g4;
                      f32x4 acc = (f32x4){0.f, 0.f, 0.f, 0.f};
#pragma unroll
                      for (int kb = 0; kb < 2; ++kb) { bf16x8 av[8], bv[8];
#pragma unroll
                          for (int ks = 0; ks < 8; ++ks) { av[ks] = *(const GAS bf16x8*)(ap + 256 * kb + 32 * ks); bv[ks] = *(const GAS bf16x8*)(bp + 256 * kb + 32 * ks); }
#pragma unroll
                          for (int ks = 0; ks < 8; ++ks) acc = __builtin_amdgcn_mfma_f32_16x16x32_bf16(av[ks], bv[ks], acc, 0, 0, 0); }
#pragma unroll
                      for (int r = 0; r < 4; ++r) part[(kh * 64 + 16 * mt + 4 * g4 + r) * 16 + l15] = acc[r]; }
                    __syncthreads();
                    { const int r = tid >> 3, n2 = (tid & 7) * 2; const float rs = pg8::row_rstd(ssq, c * 64 + r);
                      glr_s[r * 16 + n2] = (part[r * 16 + n2] + part[(64 + r) * 16 + n2]) * rs; glr_s[r * 16 + n2 + 1] = (part[r * 16 + n2 + 1] + part[(64 + r) * 16 + n2 + 1]) * rs; }
                    __syncthreads();
                    { const int kd = tid; float w2[16];
#pragma unroll
                      for (int r = 0; r < 16; ++r) w2[r] = a_w_gk2[((size_t)L * 16 + r) * KD + kd];
                      const float bb = a_b_gk[L * KD + kd]; float run = 0.f; GAS short* bo = (GAS short*)(U + (size_t)(c >> 2) * PANEL_E + BCUM_OFF_E) + (size_t)((c & 3) * 64) * KD + kd;
#pragma unroll 4
                      for (int t = 0; t < 64; ++t) { const LAS f32x4* gp = (const LAS f32x4*)(glr_s + t * 16); const f32x4 g0 = gp[0], g1 = gp[1], g2 = gp[2], g3 = gp[3];
                          float z = bb + ((g0[0] * w2[0] + g0[1] * w2[1]) + (g0[2] * w2[2] + g0[3] * w2[3])) + ((g1[0] * w2[4] + g1[1] * w2[5]) + (g1[2] * w2[6] + g1[3] * w2[7]))
                                       + ((g2[0] * w2[8] + g2[1] * w2[9]) + (g2[2] * w2[10] + g2[3] * w2[11])) + ((g3[0] * w2[12] + g3[1] * w2[13]) + (g3[2] * w2[14] + g3[3] * w2[15]));
                          const float ls = fminf(z, 0.f) - __logf(1.0f + __expf(-fabsf(z)));
                          run += ls * (1.0f / 16.0f); bo[(size_t)t * KD] = (short)fmaxf(rintf(run * 2048.0f), -32768.0f); } }
                }
                __syncthreads();
            }
            TOC(2); if (BOTH(base)) { if (gla || jb == 1) GROUP_BAR(gla ? 2 : 6); else GRID_BAR(6); }
        }
        if (gla) {
            if (IN(base + 1)) { PHASE_IDS
                TIC(); constexpr int KD_OFF = 0, KD_RS = 288, V_OFF = 36864, V_RS = 544;
                const int g = lane >> 4, q4 = (lane & 15) >> 2, p4 = lane & 3, wk = wave >> 2, wv = wave & 3;
                for (int it = 2 * vwg; it < 512; it += ((it & 1) ? 2 * G - 1 : 1)) {
                    const int pmw = it >> 3, h = (it >> 1) & 3, b = pmw >> 4, sc = 2 * (pmw & 15) + (it & 1), seq = b * 4 + h, un = seq * 32 + sc; const size_t t0 = (size_t)b * T + sc * 128;
                    const GAS bf16* Qp = (const GAS bf16*)QKVG + (t0 >> 8) * PANEL_E + (size_t)(t0 & 255) * NIN;
                    const GAS short* Bp = (const GAS short*)(U + (t0 >> 8) * PANEL_E + BCUM_OFF_E) + (size_t)(t0 & 255) * KD;
                    __syncthreads();
                    { const int k8 = (tid & 15) * 8; const GAS short* bcb = Bp + h * 128 + k8; const GAS bf16* kb = Qp + 512 + h * 128 + k8;
                      const GAS bf16* vb = Qp + 1024 + h * 256;
                      const v4u l0w = *(const GAS v4u*)(bcb + 63 * KD), l1w = *(const GAS v4u*)(bcb + 127 * KD);
                      v4u kv[4], bw[4]; v4u vv[8];
#pragma unroll
                      for (int i = 0; i < 4; ++i) { const int t = (tid >> 4) + 32 * i; kv[i] = *(const GAS v4u*)(kb + (size_t)t * NIN); bw[i] = *(const GAS v4u*)(bcb + (size_t)t * KD); }
#pragma unroll
                      for (int i = 0; i < 8; ++i) { const int c = tid + 512 * i, t = c >> 5, v8 = (c & 31) * 8; vv[i] = *(const GAS v4u*)(vb + (size_t)t * NIN + v8); }
                      f32x4 l0a, l0b, l1a, l1b; bc_unpack(l0w, l0a, l0b); bc_unpack(l1w, l1a, l1b);
                      float last0[8], bend[8];
#pragma unroll
                      for (int e = 0; e < 4; ++e) { last0[e] = l0a[e]; last0[4 + e] = l0b[e]; bend[e] = l0a[e] + l1a[e]; bend[4 + e] = l0b[e] + l1b[e]; }
                      if (tid < 16) {
#pragma unroll
                          for (int e = 0; e < 8; ++e) BendG[(size_t)un * 128 + k8 + e] = bend[e]; }
#pragma unroll
                      for (int i = 0; i < 4; ++i) { const int t = (tid >> 4) + 32 * i; float r[8]; f32x4 b0, b1; bc_unpack(bw[i], b0, b1);
#pragma unroll
                          for (int e = 0; e < 8; ++e) { const float kk = (e & 1) ? bfhi(kv[i][e >> 1]) : bflo(kv[i][e >> 1]); const float bc = (e < 4 ? b0[e] : b1[e - 4]) + (t >= 64 ? last0[e] : 0.f); r[e] = kk * __expf(bend[e] - bc); }
                          v4u o; o.x = pk2(r[0], r[1]); o.y = pk2(r[2], r[3]); o.z = pk2(r[4], r[5]); o.w = pk2(r[6], r[7]);
                          *(LAS v4u*)(ldsl + KD_OFF + t * KD_RS + k8 * 2) = o; }
#pragma unroll
                      for (int i = 0; i < 8; ++i) { const int c = tid + 512 * i, t = c >> 5, v8 = (c & 31) * 8; *(LAS v4u*)(ldsl + V_OFF + t * V_RS + v8 * 2) = vv[i]; } }
                    __syncthreads();
                    f32x4 acc[4][4];
#pragma unroll
                    for (int a = 0; a < 4; ++a)
#pragma unroll
                        for (int c = 0; c < 4; ++c) acc[a][c] = (f32x4){0.f, 0.f, 0.f, 0.f};
#pragma unroll
                    for (int s = 0; s < 4; ++s) { const int rowb = 32 * s + 4 * g + q4;
                        bf16x8 af[4], bfr[4];
#pragma unroll
                        for (int kt = 0; kt < 4; ++kt) { const LAS unsigned char* ap = ldsl + KD_OFF + rowb * KD_RS + (64 * wk + 16 * kt + 4 * p4) * 2; const s16x4 lo = tr_read(ap), hi = tr_read(ap + 16 * KD_RS);
                            af[kt] = (bf16x8){lo[0], lo[1], lo[2], lo[3], hi[0], hi[1], hi[2], hi[3]}; }
#pragma unroll
                        for (int vt = 0; vt < 4; ++vt) { const LAS unsigned char* bp = ldsl + V_OFF + rowb * V_RS + (64 * wv + 16 * vt + 4 * p4) * 2; const s16x4 lo = tr_read(bp), hi = tr_read(bp + 16 * V_RS);
                            bfr[vt] = (bf16x8){lo[0], lo[1], lo[2], lo[3], hi[0], hi[1], hi[2], hi[3]}; }
#pragma unroll
                        for (int kt = 0; kt < 4; ++kt)
#pragma unroll
                            for (int vt = 0; vt < 4; ++vt) acc[kt][vt] = __builtin_amdgcn_mfma_f32_16x16x32_bf16(af[kt], bfr[vt], acc[kt][vt], 0, 0, 0); }
#pragma unroll
                    for (int kt = 0; kt < 4; ++kt)
#pragma unroll
                        for (int vt = 0; vt < 4; ++vt) { const int vd = 64 * wv + 16 * vt + (lane & 15), kd = 64 * wk + 16 * kt + 4 * g;
                            v2u w; w.x = pk2(acc[kt][vt][0], acc[kt][vt][1]); w.y = pk2(acc[kt][vt][2], acc[kt][vt][3]);
                            *(v2u*)(Sst + ((size_t)un * 256 + vd) * 128 + kd) = w; }
                }
                TOC(3); if (BOTH(base + 1)) GRID_BAR(3);
            }
            if (IN(base + 2)) { PHASE_IDS TIC();
                for (int w = vcu * 512 + tid; w < 16 * 8192; w += G * 512) { const int seq = w >> 13, e4 = (w & 8191) * 4, kd = e4 & 127; float run[4] = {0.f, 0.f, 0.f, 0.f};
                    for (int sc = 0; sc < 32; ++sc) { const int un = seq * 32 + sc; bf16* p = Sst + (size_t)un * 32768 + e4; const v2u tv = *(const v2u*)p;
                        const f32x4 be = *(const f32x4*)(BendG + (size_t)un * 128 + kd);
                        v2u o; o.x = pk2(run[0], run[1]); o.y = pk2(run[2], run[3]); *(v2u*)p = o;
                        run[0] = run[0] * __expf(be[0]) + bflo(tv.x); run[1] = run[1] * __expf(be[1]) + bfhi(tv.x); run[2] = run[2] * __expf(be[2]) + bflo(tv.y); run[3] = run[3] * __expf(be[3]) + bfhi(tv.y); } }
                TOC(4); if (BOTH(base + 2)) GRID_BAR(4);
            }
            if (IN(base + 3)) { PHASE_IDS TIC();
                constexpr int A_OFF = 0, A_RS = 288, B_OFF = 73728, B_RS = 544;
                const int g = lane >> 4, l15 = lane & 15, q4 = l15 >> 2, p4 = lane & 3;
                const int grp = wave < 4 ? wave : 11 - wave;
                for (int it = 2 * vwg; it < 512; it += ((it & 1) ? 2 * G - 1 : 1)) {
                    const int pmw = it >> 3, h = (it >> 1) & 3, b = pmw >> 4, sc = 2 * (pmw & 15) + (it & 1), seq = b * 4 + h, un = seq * 32 + sc; const size_t t0 = (size_t)b * T + sc * 128;
                    const GAS bf16* Qp = (const GAS bf16*)QKVG + (t0 >> 8) * PANEL_E + (size_t)(t0 & 255) * NIN;
                    const GAS short* Bp = (const GAS short*)(U + (t0 >> 8) * PANEL_E + BCUM_OFF_E) + (size_t)(t0 & 255) * KD;
                    const int k8 = (tid & 15) * 8, q = 16 * grp + l15;
                    v4u sv[8], vv[8], kv[4], qv[4], kbw[4], qbw[4], qcw[4];
                    { const GAS bf16* sb = (const GAS bf16*)Sst + (size_t)un * 32768; const GAS bf16* vb = Qp + 1024 + h * 256;
#pragma unroll
                      for (int i = 0; i < 8; ++i) { const int c = tid + 512 * i; sv[i] = *(const GAS v4u*)(sb + (size_t)c * 8); vv[i] = *(const GAS v4u*)(vb + (size_t)(c >> 5) * NIN + (c & 31) * 8); } }
                    const GAS short* bcb = Bp + h * 128 + k8;
                    const v4u l0w = *(const GAS v4u*)(bcb + 63 * KD);
                    { const GAS bf16* kb = Qp + 512 + h * 128 + k8;
#pragma unroll
                      for (int i = 0; i < 4; ++i) { const int t = (tid >> 4) + 32 * i; kv[i] = *(const GAS v4u*)(kb + (size_t)t * NIN); kbw[i] = *(const GAS v4u*)(bcb + (size_t)t * KD); } }
                    __syncthreads();
#pragma unroll
                    for (int i = 0; i < 8; ++i) { const int c = tid + 512 * i; *(LAS v4u*)(ldsl + A_OFF + (c >> 4) * A_RS + (c & 15) * 16) = sv[i]; *(LAS v4u*)(ldsl + B_OFF + (c >> 5) * B_RS + (c & 31) * 16) = vv[i]; }
                    asm volatile("" ::: "memory");
                    { const GAS bf16* qb = Qp + (size_t)q * NIN + h * 128 + 8 * g; const GAS short* bq = Bp + (size_t)q * KD + h * 128 + 8 * g; const GAS short* lq = Bp + 63 * KD + h * 128 + 8 * g;
#pragma unroll
                      for (int ks = 0; ks < 4; ++ks) { qv[ks] = *(const GAS v4u*)(qb + 32 * ks); qbw[ks] = *(const GAS v4u*)(bq + 32 * ks); qcw[ks] = *(const GAS v4u*)(lq + 32 * ks); } }
                    v4u kreg[4];
                    f32x4 l0a, l0b; bc_unpack(l0w, l0a, l0b);
#pragma unroll
                    for (int i = 0; i < 4; ++i) { const int t = (tid >> 4) + 32 * i; float r[8]; f32x4 kb0, kb1; bc_unpack(kbw[i], kb0, kb1);
#pragma unroll
                        for (int e = 0; e < 8; ++e) { const float kk = (e & 1) ? bfhi(kv[i][e >> 1]) : bflo(kv[i][e >> 1]); const float bc = (e < 4 ? kb0[e] : kb1[e - 4]) + (t >= 64 ? (e < 4 ? l0a[e] : l0b[e - 4]) : 0.f); r[e] = kk * __expf(-bc); }
                        kreg[i].x = pk2(r[0], r[1]); kreg[i].y = pk2(r[2], r[3]); kreg[i].z = pk2(r[4], r[5]); kreg[i].w = pk2(r[6], r[7]); }
                    bf16x8 qf[4];
                    { const float lm = q >= 64 ? 1.0f : 0.0f;
#pragma unroll
                      for (int ks = 0; ks < 4; ++ks) { float r[8]; f32x4 qb0, qb1, qc0, qc1; bc_unpack(qbw[ks], qb0, qb1); bc_unpack(qcw[ks], qc0, qc1);
#pragma unroll
                          for (int e = 0; e < 8; ++e) { const float qq = (e & 1) ? bfhi(qv[ks][e >> 1]) : bflo(qv[ks][e >> 1]); r[e] = qq * __expf(e < 4 ? qb0[e] + lm * qc0[e] : qb1[e - 4] + lm * qc1[e - 4]); }
                          v4u o; o.x = pk2(r[0], r[1]); o.y = pk2(r[2], r[3]); o.z = pk2(r[4], r[5]); o.w = pk2(r[6], r[7]);
                          qf[ks] = __builtin_bit_cast(bf16x8, o); } }
                    GAS bf16* gp = (GAS bf16*)Qp + (size_t)q * NIN + 2048 + h * 256 + 4 * g;
                    v2u gv[16];
#pragma unroll
                    for (int vt = 0; vt < 16; ++vt) gv[vt] = *(const GAS v2u*)(gp + 16 * vt);
                    __syncthreads();
                    f32x4 acc[16];
#pragma unroll
                    for (int vt = 0; vt < 16; ++vt) acc[vt] = (f32x4){0.f, 0.f, 0.f, 0.f};
#pragma unroll
                    for (int vt = 0; vt < 16; ++vt)
#pragma unroll
                        for (int ks = 0; ks < 4; ++ks) { const bf16x8 a = *(const LAS bf16x8*)(ldsl + A_OFF + (16 * vt + l15) * A_RS + (32 * ks + 8 * g) * 2);
                            acc[vt] = __builtin_amdgcn_mfma_f32_16x16x32_bf16(a, qf[ks], acc[vt], 0, 0, 0); }
                    __syncthreads();
#pragma unroll
                    for (int i = 0; i < 4; ++i) { const int t = (tid >> 4) + 32 * i; *(LAS v4u*)(ldsl + A_OFF + t * A_RS + k8 * 2) = kreg[i]; }
                    __syncthreads();
                    const int nsteps = (grp >> 1) + 1;
                    for (int s = 0; s < nsteps; ++s) {
                        f32x4 pt[2];
#pragma unroll
                        for (int tt = 0; tt < 2; ++tt) { pt[tt] = (f32x4){0.f, 0.f, 0.f, 0.f};
#pragma unroll
                            for (int ks = 0; ks < 4; ++ks) { const bf16x8 a = *(const LAS bf16x8*)(ldsl + A_OFF + (32 * s + 16 * tt + l15) * A_RS + (32 * ks + 8 * g) * 2);
                                pt[tt] = __builtin_amdgcn_mfma_f32_16x16x32_bf16(a, qf[ks], pt[tt], 0, 0, 0); }
#pragma unroll
                            for (int r = 0; r < 4; ++r) { const int j = 32 * s + 16 * tt + 4 * g + r; if (j > q) pt[tt][r] = 0.f; } }
                        v4u pw; pw.x = pk2(pt[0][0], pt[0][1]); pw.y = pk2(pt[0][2], pt[0][3]); pw.z = pk2(pt[1][0], pt[1][1]); pw.w = pk2(pt[1][2], pt[1][3]);
                        const bf16x8 pf = __builtin_bit_cast(bf16x8, pw);
#pragma unroll
                        for (int vt = 0; vt < 16; ++vt) { const LAS unsigned char* vp = ldsl + B_OFF + (32 * s + 4 * g + q4) * B_RS + (16 * vt + 4 * p4) * 2; const s16x4 lo = tr_read(vp), hi = tr_read(vp + 16 * B_RS);
                            const bf16x8 a = (bf16x8){lo[0], lo[1], lo[2], lo[3], hi[0], hi[1], hi[2], hi[3]};
                            acc[vt] = __builtin_amdgcn_mfma_f32_16x16x32_bf16(a, pf, acc[vt], 0, 0, 0); }
                    }
                    { float ss = 0.f;
#pragma unroll
                      for (int vt = 0; vt < 16; ++vt) ss += (acc[vt][0] * acc[vt][0] + acc[vt][1] * acc[vt][1]) + (acc[vt][2] * acc[vt][2] + acc[vt][3] * acc[vt][3]);
                      ss += __shfl_xor(ss, 16); ss += __shfl_xor(ss, 32);
                      const float rs = 1.0f / sqrtf(ss * (1.0f / 256.0f) + EPS);
                      const GAS float* gonp = (const GAS float*)a_onorm + L * 256 + 4 * g;
#pragma unroll
                      for (int vt = 0; vt < 16; ++vt) { const f32x4 gon = *(const GAS f32x4*)(gonp + 16 * vt);
                          const float g0 = bflo(gv[vt].x), g1 = bfhi(gv[vt].x), g2 = bflo(gv[vt].y), g3 = bfhi(gv[vt].y);
                          const float r0 = acc[vt][0] * rs * gon[0] * (g0 / (1.0f + __expf(-g0))), r1 = acc[vt][1] * rs * gon[1] * (g1 / (1.0f + __expf(-g1)));
                          const float r2 = acc[vt][2] * rs * gon[2] * (g2 / (1.0f + __expf(-g2))), r3 = acc[vt][3] * rs * gon[3] * (g3 / (1.0f + __expf(-g3)));
                          v2u w; w.x = pk2(r0, r1); w.y = pk2(r2, r3); *(GAS v2u*)(gp + 16 * vt) = w; } }
                }
                TOC(5); if (BOTH(base + 3)) GROUP_BAR(5);
            }
        } else {
            if (IN(base + 1)) { PHASE_IDS
                TIC(); constexpr int K_OFF = 0, V_OFF = 40960, RS = 160, BIAS_OFF = 81920;
                const int g = lane >> 4, l15 = lane & 15, q4 = l15 >> 2, p4 = lane & 3;
                LAS float* bias_s = (LAS float*)(ldsl + BIAS_OFF);
                for (int w = vwg; w < 256; w += G) {
                    const int pmw = w >> 2, b = pmw >> 4, nb = 2 * (pmw & 15) + ((w >> 1) & 1), kvh = w & 1; const size_t tq0 = (size_t)b * T + nb * 128;
                    __syncthreads();
                    { v4u kv[4], vv[4]; const GAS bf16* kvb = (const GAS bf16*)KVb + (tq0 - (nb == 0 ? 0 : 128)) * 256 + kvh * 64;
#pragma unroll
                      for (int i = 0; i < 4; ++i) { const int c = tid + 512 * i, j = c >> 3, d8 = (c & 7) * 8; const int jj = nb == 0 ? (j & 127) : j;
                          kv[i] = *(const GAS v4u*)(kvb + (size_t)jj * 256 + d8); vv[i] = *(const GAS v4u*)(kvb + (size_t)jj * 256 + 128 + d8); }
#pragma unroll
                      for (int i = 0; i < 4; ++i) { const int c = tid + 512 * i, j = c >> 3, d8 = (c & 7) * 8; const bool pad = nb == 0 && j < 128;
                          *(LAS v4u*)(ldsl + K_OFF + j * RS + d8 * 2) = pad ? (v4u){0u, 0u, 0u, 0u} : kv[i]; *(LAS v4u*)(ldsl + V_OFF + j * RS + d8 * 2) = pad ? (v4u){0u, 0u, 0u, 0u} : vv[i]; } }
                    for (int e = tid; e < 1024; e += 512) { const int hg = e >> 7, dist = e & 127;
                        int bk = dist; if (dist >= 16) { bk = 16 + (dist >= 19) + (dist >= 21) + (dist >= 24) + (dist >= 27) + (dist >= 31) + (dist >= 35) + (dist >= 40) + (dist >= 46) + (dist >= 52) + (dist >= 59) + (dist >= 67) + (dist >= 77) + (dist >= 87) + (dist >= 99) + (dist >= 113); }
                        bias_s[e] = rel_table[bk * 16 + kvh * 8 + hg] * LOG2E; }
                    __syncthreads();
                    const int head = kvh * 8 + wave; const float sink2 = b_sinks[jb * 16 + head] * LOG2E;
                    GAS bf16* qbase = (GAS bf16*)Qb + (tq0 >> 8) * PANEL_E + ((tq0 & 255) + l15) * D + head * 64;
                    bf16x8 qn0 = *(const GAS bf16x8*)(qbase + 8 * g), qn1 = *(const GAS bf16x8*)(qbase + 32 + 8 * g);
#pragma unroll 1
                    for (int qg = 0; qg < 8; ++qg) {
                        const int qi = 16 * qg + l15; GAS bf16* qp = qbase + (size_t)(16 * qg) * D;
                        const bf16x8 qf0 = qn0, qf1 = qn1;
                        if (qg < 7) { qn0 = *(const GAS bf16x8*)(qp + 16 * D + 8 * g); qn1 = *(const GAS bf16x8*)(qp + 16 * D + 32 + 8 * g); }
                        const int ts0 = qg & ~1;
                        f32x4 sc[10];
#pragma unroll
                        for (int tt = 0; tt < 10; ++tt) { const LAS unsigned char* kp = ldsl + K_OFF + (16 * (ts0 + tt) + l15) * RS + (8 * g) * 2;
                            const bf16x8 a0 = *(const LAS bf16x8*)kp, a1 = *(const LAS bf16x8*)(kp + 64);
                            sc[tt] = __builtin_amdgcn_mfma_f32_16x16x32_bf16(a0, qf0, (f32x4){0.f, 0.f, 0.f, 0.f}, 0, 0, 0);
                            sc[tt] = __builtin_amdgcn_mfma_f32_16x16x32_bf16(a1, qf1, sc[tt], 0, 0, 0); }
                        float m = sink2;
#pragma unroll
                        for (int tt = 0; tt < 10; ++tt)
#pragma unroll
                            for (int r = 0; r < 4; ++r) { const int j = 16 * (ts0 + tt) + 4 * g + r, dist = qi + 128 - j; const bool valid = (dist >= 0) && (dist < 128) && !(nb == 0 && j < 128);
                                const float s = valid ? sc[tt][r] + bias_s[wave * 128 + (dist & 127)] : -1e30f; sc[tt][r] = s; m = fmaxf(m, s); }
                        m = fmaxf(m, __shfl_xor(m, 16)); m = fmaxf(m, __shfl_xor(m, 32));
                        float l = 0.f;
#pragma unroll
                        for (int tt = 0; tt < 10; ++tt)
#pragma unroll
                            for (int r = 0; r < 4; ++r) { const float pe = __builtin_amdgcn_exp2f(sc[tt][r] - m); sc[tt][r] = pe; l += pe; }
                        l += __shfl_xor(l, 16); l += __shfl_xor(l, 32); l += __builtin_amdgcn_exp2f(sink2 - m);
                        f32x4 o[4];
#pragma unroll
                        for (int dt = 0; dt < 4; ++dt) o[dt] = (f32x4){0.f, 0.f, 0.f, 0.f};
#pragma unroll
                        for (int s5 = 0; s5 < 5; ++s5) { v4u pw; pw.x = pk2(sc[2 * s5][0], sc[2 * s5][1]); pw.y = pk2(sc[2 * s5][2], sc[2 * s5][3]); pw.z = pk2(sc[2 * s5 + 1][0], sc[2 * s5 + 1][1]); pw.w = pk2(sc[2 * s5 + 1][2], sc[2 * s5 + 1][3]);
                            const bf16x8 pf = __builtin_bit_cast(bf16x8, pw);
#pragma unroll
                            for (int dt = 0; dt < 4; ++dt) { const LAS unsigned char* vp = ldsl + V_OFF + (16 * (ts0 + 2 * s5) + 4 * g + q4) * RS + (16 * dt + 4 * p4) * 2; const s16x4 lo = tr_read(vp), hi = tr_read(vp + 16 * RS);
                                const bf16x8 a = (bf16x8){lo[0], lo[1], lo[2], lo[3], hi[0], hi[1], hi[2], hi[3]};
                                o[dt] = __builtin_amdgcn_mfma_f32_16x16x32_bf16(a, pf, o[dt], 0, 0, 0); } }
                        const float il = 1.0f / l;
#pragma unroll
                        for (int dt = 0; dt < 4; ++dt) { v2u w; w.x = pk2(o[dt][0] * il, o[dt][1] * il); w.y = pk2(o[dt][2] * il, o[dt][3] * il); *(GAS v2u*)(qp + 16 * dt + 4 * g) = w; }
                    }
                }
                TOC(7); if (BOTH(base + 1)) GROUP_BAR(7);
            }
        }
        if (IN(pG1)) { TIC();
            pg8::Gemm g; pg8::EpiResid E; E.hb = HB; E.ssq = ssq;
            if (gla) g = pg8::Gemm{QKVG + 2048, Wao_t + (size_t)L * D * D, M, D, D, NIN, PANEL_B};
            else g = pg8::Gemm{Qb, Wbo_t + (size_t)jb * D * D, M, D, D, D, PANEL_B};
            pg8::StaticOrder S; S.init(M, D, G, (int)blockIdx.x);
            pg8::gemm_phase<pg8::EpiResid, pg8::StaticOrder, false, true>(ldsl, g, S, E);
            TOC(8); if (BOTH(pG1)) GROUP_BAR(8);
        }
        if (IN(pG1 + 1)) { PHASE_IDS TIC();
            pg8::Gemm g{HB, Wup_t + (size_t)L * FF * D, M, FF, D, D, (size_t)256 * D * 2};
            pg8::EpiScale E; E.O = U; E.ldc = FF; E.tstep = PANEL_B; E.O2 = nullptr; E.ldc2 = 0; E.tstep2 = 0; E.split_col = 1 << 30; E.ssq = ssq; E.act = 1;
            pg8::StaticOrder S; S.init(M, FF, G, (int)blockIdx.x);
            { pg8::Unit u0; const bool has = S.next(0, u0); LAS float* rtab = (LAS float*)(ldsl + RING_BYTES);
              if (has && tid < 256) rtab[tid] = pg8::row_rstd(ssq, u0.pm * 256 + tid);
              __syncthreads(); E.rtab = rtab; E.tab_pm = has ? u0.pm : -1; }
            pg8::gemm_phase<pg8::EpiScale, pg8::StaticOrder, true, true>(ldsl, g, S, E);
            TOC(9); if (BOTH(pG1 + 1)) GROUP_BAR(9);
        }
        if (IN(pG1 + 2)) { TIC();
            pg8::Gemm g{U, Wdn_t + (size_t)L * D * FF, M, D, FF, FF, PANEL_B};
            pg8::EpiResid E; E.hb = HB; E.ssq = ssq;
            pg8::StaticOrder S; S.init(M, D, G, (int)blockIdx.x);
            pg8::gemm_phase<pg8::EpiResid, pg8::StaticOrder, false, true>(ldsl, g, S, E);
            TOC(10); if (BOTH(pG1 + 2)) GROUP_BAR(10);
        }
    }
    if (IN(25)) { PHASE_IDS TIC();
        const int gw = vcu * NWAVES + wave, NGW = G * NWAVES;
        for (int m = 64 * vwg + wave; m < M; m += ((m & 63) >= 56 ? 64 * G - 56 : 8)) {
            const float rs = pg8::row_rstd(ssq, m);
            const GAS v2u* hr = (const GAS v2u*)(HB + (size_t)m * D) + lane; GAS f32x4* orow = (GAS f32x4*)(out + (size_t)m * D) + lane; const f32x4* gr = (const f32x4*)ln_final + lane;
            v2u hvv[4];
#pragma unroll
            for (int j = 0; j < 4; ++j) hvv[j] = hr[64 * j];
#pragma unroll
            for (int j = 0; j < 4; ++j) { const f32x4 gg = gr[64 * j]; orow[64 * j] = (f32x4){bflo(hvv[j].x) * rs * gg[0], bfhi(hvv[j].x) * rs * gg[1], bflo(hvv[j].y) * rs * gg[2], bfhi(hvv[j].y) * rs * gg[3]}; }
        }
    TOC(11); }
#if PROBE_SEL
    if (blockIdx.x == 0) { const unsigned long long te = __builtin_amdgcn_s_memrealtime(); while (__builtin_amdgcn_s_memrealtime() - te < pr_acc * PROBE_MUL) __builtin_amdgcn_s_sleep(8); }
#endif
#undef IN
#undef BOTH
#undef GRID_BAR
}

extern "C" void kernel_launch(void* const* d_in, const int* in_sizes, int n_in, void* d_out, int out_size, void* d_ws, size_t ws_size, hipStream_t stream) {
    static int grid = 0;
    if (grid == 0) {
        if (n_in != 17 || in_sizes[0] != M * D || out_size != M * D || ws_size < WS_END) { fprintf(stderr, "kernel_launch: unexpected shapes (n_in %d, in0 %d, out %d, ws %zu)\n", n_in, n_in > 0 ? in_sizes[0] : -1, out_size, ws_size); grid = -1; return; }
        int dev = 0, cus = 0;
        if (hipGetDevice(&dev) != hipSuccess || hipDeviceGetAttribute(&cus, hipDeviceAttributeMultiprocessorCount, dev) != hipSuccess) { grid = -1; return; }
        if (hipFuncSetAttribute((const void*)yoco_fwd, hipFuncAttributeMaxDynamicSharedMemorySize, LDS_BYTES) != hipSuccess) { fprintf(stderr, "kernel_launch: hipFuncSetAttribute failed\n"); grid = -1; return; }
        (void)hipGetLastError();
        grid = cus;
    }
    if (grid < 0) return;
    if (hipMemsetAsync((char*)d_ws + WS_CTL, 0, CTL_ZERO_BYTES, stream) != hipSuccess) return;
    Args a{};
    for (int i = 0; i < 17; ++i) a.in[i] = (const float*)d_in[i];
    a.out = (float*)d_out; a.ws = (unsigned char*)d_ws;
    if (N_LAUNCHES == 1) {
        a.ph_lo = 0; a.ph_hi = NPH; a.li = 0;
        hipLaunchKernelGGL(yoco_fwd, dim3(grid), dim3(NWAVES * 64), LDS_BYTES, stream, a);
    } else {
        for (int p = 0; p < NPH; ++p) { a.ph_lo = p; a.ph_hi = p + 1; a.li = 0;
            hipLaunchKernelGGL(yoco_fwd, dim3(grid), dim3(NWAVES * 64), LDS_BYTES, stream, a); }
    }
}
```

```cpp
#include <hip/hip_runtime.h>
#include <cstdio>
#include <cstdint>

#ifndef PROBE_SEL
#define PROBE_SEL 0
#endif
#ifndef PROBE_MUL
#define PROBE_MUL 1
#endif
#ifndef MK_N_LAUNCHES
#define MK_N_LAUNCHES 1
#endif

namespace pg8 {
#define PG8_LAS __attribute__((address_space(3)))
typedef unsigned short bf16_t;
typedef short bf16x8 __attribute__((ext_vector_type(8)));
typedef float f32x4 __attribute__((ext_vector_type(4)));
typedef unsigned u32x4 __attribute__((ext_vector_type(4)));
typedef unsigned u32x2 __attribute__((ext_vector_type(2)));
constexpr int BM = 256, BK = 64, HALF = 128, HTB = HALF * BK * 2, STAGE_BYTES = 8 * HTB, NXCD = 8, WGM = 8;

__host__ __device__ __forceinline__ int lds_byte(int r, int c) { const int st = (r >> 4) * 2 + (c >> 5), rr = r & 15, cc = c & 31, ob = rr * 64 + cc * 2; return st * 1024 + (ob ^ (((ob >> 9) & 1) << 5)); }
__host__ __device__ __forceinline__ void stage_rc(int b, int& R, int& C) { const int st = b / 1024, sb = b % 1024, swz = sb ^ (((sb >> 9) & 1) << 5); R = (st >> 1) * 16 + swz / 64; C = (st & 1) * 32 + (swz % 64) / 2; }
__host__ __device__ __forceinline__ int perm32(int rho) { const int n = rho >> 4, i = rho & 15; return 8 * (i >> 2) + 4 * n + (i & 3); }

struct Unit { int pm, pn; };
struct Gemm { const bf16_t* A; const bf16_t* Bt; int M, N, K, lda; size_t a_tstep; };

struct StaticOrder {
    int nM, nN, nwg, G, c;
    __host__ __device__ void init(int M, int N, int G_, int c_) { nM = M / BM; nN = N / BM; nwg = nM * nN; G = G_; c = c_; }
    __host__ __device__ bool next(int i, Unit& u) const {
        const long L = (long)i * G + c; if (L >= nwg) return false;
        int wgid = (int)L; { const int q = nwg / NXCD, r = nwg % NXCD, xcd = wgid % NXCD, off = wgid / NXCD; wgid = (xcd < r ? xcd * (q + 1) : r * (q + 1) + (xcd - r) * q) + off; }
        const int nig = WGM * nN, gid = wgid / nig, fm = gid * WGM, gsz = (nM - fm) < WGM ? (nM - fm) : WGM;
        u.pm = fm + ((wgid % nig) % gsz); u.pn = (wgid % nig) / gsz; return true;
    }
    __device__ __forceinline__ void a_ready(const Unit&) const {}
    __device__ __forceinline__ void done(const Unit&) const {}
};

__device__ __forceinline__ unsigned cvt_pk_bf16(float lo, float hi) { unsigned r; asm volatile("v_cvt_pk_bf16_f32 %0, %1, %2" : "=v"(r) : "v"(lo), "v"(hi)); return r; }

constexpr int MROWS = 16384;
__device__ __forceinline__ float row_rstd(const float* ssq, int row) { const float s = (ssq[row] + ssq[MROWS + row]) + (ssq[2 * MROWS + row] + ssq[3 * MROWS + row]); return 1.0f / sqrtf(s * (1.0f / 1024.0f) + 1e-6f); }

__device__ __forceinline__ unsigned dpp_ror8(unsigned v) { return (unsigned)__builtin_amdgcn_mov_dpp((int)v, 0x128, 0xf, 0xf, false); }
__device__ __forceinline__ float dpp_ror8f(float v) { return __builtin_bit_cast(float, __builtin_amdgcn_mov_dpp(__builtin_bit_cast(int, v), 0x128, 0xf, 0xf, false)); }

struct EpiScale {
    static constexpr bool PERM = true, AFTER_DRAIN = false;
    bf16_t* O; int ldc; unsigned tstep; bf16_t* O2; int ldc2; unsigned tstep2; int split_col; const float* ssq; int act; const PG8_LAS float* rtab; int tab_pm;
    __device__ __forceinline__ void operator()(const f32x4 (&acc)[2][2][4][2], const Unit& u, int wr, int wc, int fr, int fq) const {
        int colt = u.pn * BM; bf16_t* base = O; int ld = ldc; unsigned ts = tstep;
        if (colt >= split_col) { base = O2; colt -= split_col; ld = ldc2; ts = tstep2; }
        const bool lo = fr < 8;
        const int col0 = colt + wc * 64 + (fr >> 3) * 32 + 8 * fq;
        const __amdgpu_buffer_rsrc_t rsrc = __builtin_amdgcn_make_buffer_rsrc((void*)base, 0, 0x7fffffff, 0x00020000);
        float rs[2][4];
        if (u.pm == tab_pm) {
#pragma unroll
            for (int ai = 0; ai < 2; ++ai)
#pragma unroll
                for (int m = 0; m < 4; ++m) rs[ai][m] = rtab[wr * 64 + ai * HALF + m * 16 + fr];
        } else {
#pragma unroll
            for (int ai = 0; ai < 2; ++ai)
#pragma unroll
                for (int m = 0; m < 4; ++m) rs[ai][m] = row_rstd(ssq, u.pm * BM + wr * 64 + ai * HALF + m * 16 + fr);
        }
#pragma unroll
        for (int ai = 0; ai < 2; ++ai)
#pragma unroll
            for (int m = 0; m < 4; ++m) { const float r = rs[ai][m]; u32x4 Y[2];
#pragma unroll
                for (int bj = 0; bj < 2; ++bj) { f32x4 v0 = acc[ai][bj][m][0] * r, v1 = acc[ai][bj][m][1] * r;
                    if (act == 1) {
#pragma unroll
                        for (int e = 0; e < 4; ++e) { float a = fmaxf(v0[e], 0.f); v0[e] = a * a; float b = fmaxf(v1[e], 0.f); v1[e] = b * b; } }
                    Y[bj].x = cvt_pk_bf16(v0[0], v0[1]); Y[bj].y = cvt_pk_bf16(v0[2], v0[3]); Y[bj].z = cvt_pk_bf16(v1[0], v1[1]); Y[bj].w = cvt_pk_bf16(v1[2], v1[3]); }
                u32x4 keep, send, recv;
#pragma unroll
                for (int e = 0; e < 4; ++e) { keep[e] = lo ? Y[0][e] : Y[1][e]; send[e] = lo ? Y[1][e] : Y[0][e]; }
#pragma unroll
                for (int e = 0; e < 4; ++e) recv[e] = dpp_ror8(send[e]);
                u32x4 d1, d2;
#pragma unroll
                for (int e = 0; e < 4; ++e) { d1[e] = lo ? keep[e] : recv[e]; d2[e] = lo ? recv[e] : keep[e]; }
                const int rl1 = wr * 64 + ai * HALF + m * 16 + (fr & 7);
                const unsigned b1 = (unsigned)u.pm * ts + (unsigned)(rl1 * ld + col0) * 2u, b2 = b1 + (unsigned)(8 * ld) * 2u;
                __builtin_amdgcn_raw_buffer_store_b128(d1, rsrc, b1, 0, 16);
                __builtin_amdgcn_raw_buffer_store_b128(d2, rsrc, b2, 0, 16); }
    }
};

struct EpiResid {
    static constexpr bool PERM = true, AFTER_DRAIN = true;
    bf16_t* hb; float* ssq;
    __device__ __forceinline__ void fused(const f32x4 (&acc)[2][2][4][2], const Unit& u, int wr, int wc, int fr, int fq, PG8_LAS unsigned char* lds, int tid) const {
        PG8_LAS float* P = (PG8_LAS float*)lds;
        const bool lo = fr < 8;
        const int col0 = u.pn * BM + wc * 64 + (fr >> 3) * 32 + 8 * fq, rloc = wr * 64 + (fr & 7);
        const __amdgpu_buffer_rsrc_t rsrc = __builtin_amdgcn_make_buffer_rsrc((void*)hb, 0, 0x7fffffff, 0x00020000);
        u32x4 h1[2][4], h2[2][4];
#pragma unroll
        for (int ai = 0; ai < 2; ++ai)
#pragma unroll
            for (int m = 0; m < 4; ++m) { const size_t o1 = (size_t)(u.pm * BM + rloc + ai * HALF + m * 16) * 1024 + col0; h1[ai][m] = *(const u32x4*)(hb + o1); h2[ai][m] = *(const u32x4*)(hb + o1 + 8 * 1024); }
        asm volatile("" ::: "memory");
#pragma unroll
        for (int ai = 0; ai < 2; ++ai)
#pragma unroll
            for (int m = 0; m < 4; ++m) {
                float keep[8], send[8], recv[8];
#pragma unroll
                for (int e = 0; e < 4; ++e) { keep[e] = lo ? acc[ai][0][m][0][e] : acc[ai][1][m][0][e]; keep[4 + e] = lo ? acc[ai][0][m][1][e] : acc[ai][1][m][1][e];
                                              send[e] = lo ? acc[ai][1][m][0][e] : acc[ai][0][m][0][e]; send[4 + e] = lo ? acc[ai][1][m][1][e] : acc[ai][0][m][1][e]; }
#pragma unroll
                for (int e = 0; e < 8; ++e) recv[e] = dpp_ror8f(send[e]);
                float ss1 = 0.f, ss2 = 0.f; u32x4 w1, w2;
#pragma unroll
                for (int e = 0; e < 4; ++e) { const float a0 = lo ? keep[2 * e] : recv[2 * e], a1 = lo ? keep[2 * e + 1] : recv[2 * e + 1], c0 = lo ? recv[2 * e] : keep[2 * e], c1 = lo ? recv[2 * e + 1] : keep[2 * e + 1];
                    const unsigned x = h1[ai][m][e], y = h2[ai][m][e];
                    w1[e] = cvt_pk_bf16(__builtin_bit_cast(float, x << 16) + a0, __builtin_bit_cast(float, x & 0xffff0000u) + a1);
                    w2[e] = cvt_pk_bf16(__builtin_bit_cast(float, y << 16) + c0, __builtin_bit_cast(float, y & 0xffff0000u) + c1);
                    const float p0 = __builtin_bit_cast(float, w1[e] << 16), p1 = __builtin_bit_cast(float, w1[e] & 0xffff0000u), q0 = __builtin_bit_cast(float, w2[e] << 16), q1 = __builtin_bit_cast(float, w2[e] & 0xffff0000u);
                    ss1 += p0 * p0 + p1 * p1; ss2 += q0 * q0 + q1 * q1; }
                const int rl = rloc + ai * HALF + m * 16; const unsigned b1 = (unsigned)((u.pm * BM + rl) * 1024 + col0) * 2u;
                __builtin_amdgcn_raw_buffer_store_b128(w1, rsrc, b1, 0, 16);
                __builtin_amdgcn_raw_buffer_store_b128(w2, rsrc, b1 + 8 * 1024 * 2, 0, 16);
                ss1 += __shfl_xor(ss1, 8); ss1 += __shfl_xor(ss1, 16); ss1 += __shfl_xor(ss1, 32);
                ss2 += __shfl_xor(ss2, 8); ss2 += __shfl_xor(ss2, 16); ss2 += __shfl_xor(ss2, 32);
                if (lo && fq == 0) { P[rl * 4 + wc] = ss1; P[(rl + 8) * 4 + wc] = ss2; } }
        asm volatile("s_waitcnt lgkmcnt(0)" ::: "memory"); __builtin_amdgcn_s_barrier(); asm volatile("" ::: "memory");
        if (tid < 256) { const PG8_LAS f32x4* p4 = (const PG8_LAS f32x4*)P + tid; const f32x4 v = *p4;
            __hip_atomic_store((unsigned*)(ssq + (size_t)u.pn * MROWS + u.pm * BM + tid), __builtin_bit_cast(unsigned, (v[0] + v[1]) + (v[2] + v[3])), __ATOMIC_RELAXED, __HIP_MEMORY_SCOPE_AGENT); }
    }
};

template <class Epi, class Sched, bool ALIGN_EPI = false, bool SP2 = false>
__device__ __forceinline__ void gemm_phase(PG8_LAS unsigned char* lds, const Gemm g, const Sched& S, const Epi& E) {
    int tid_ = threadIdx.x; asm volatile("" : "+v"(tid_)); const int tid = tid_, wid = __builtin_amdgcn_readfirstlane(tid >> 6), lane = tid & 63, wr = wid >> 2, wc = wid & 3, fr = lane & 15, fq = lane >> 4;
    const int K = g.K, nt = K / BK, lda = g.lda;
    unsigned voffA[2], voffB[2];
#pragma unroll
    for (int i = 0; i < 2; ++i) { int R, C; stage_rc(tid * 16 + i * 8192, R, C); const int Rb = Epi::PERM ? (64 * (R >> 5) + perm32(R & 31)) : R;
        voffA[i] = (unsigned)(R * lda + C) * 2u; voffB[i] = (unsigned)(Rb * K + C) * 2u; }
    const size_t kstep = (size_t)(BK * 2);
    const size_t hstepA = (size_t)HALF * lda * 2, hstepB = (size_t)(Epi::PERM ? 32 : HALF) * K * 2;
    const size_t tstepA = g.a_tstep, tstepB = (size_t)BM * K * 2;
    const unsigned ldsw = (unsigned)wid * 1024u;
    const int aoff = lds_byte(wr * 64 + fr, fq * 8), boff = lds_byte(wc * 32 + fr, fq * 8);
#define PG8_SA(b, h) (((b) * 2 + (h)) * HTB)
#define PG8_SB(b, h) ((4 + (b) * 2 + (h)) * HTB)
#define PG8_STAGE(bufoff, gbase, voff) do { _Pragma("unroll") for (int _i = 0; _i < 2; ++_i) \
        __builtin_amdgcn_global_load_lds((const unsigned*)((const char*)(gbase) + (voff)[_i]), (PG8_LAS unsigned*)(lds + (bufoff) + ldsw + _i * 8192), 16, 0, 0); } while (0)
#define PG8_LDA(dst, b, h) do { _Pragma("unroll") for (int m = 0; m < 4; ++m) _Pragma("unroll") for (int k = 0; k < 2; ++k) dst[m][k] = *(const PG8_LAS bf16x8*)(lds + PG8_SA(b, h) + aoff + m * 2048 + k * 1024); } while (0)
#define PG8_LDB(dst, b, h) do { _Pragma("unroll") for (int n = 0; n < 2; ++n) _Pragma("unroll") for (int k = 0; k < 2; ++k) dst[n][k] = *(const PG8_LAS bf16x8*)(lds + PG8_SB(b, h) + boff + n * 2048 + k * 1024); } while (0)
#define PG8_MMA(ai, bj, At, Bt) do { __builtin_amdgcn_s_setprio(1); _Pragma("unroll") for (int m = 0; m < 4; ++m) _Pragma("unroll") for (int n = 0; n < 2; ++n) _Pragma("unroll") for (int k = 0; k < 2; ++k) \
        acc[ai][bj][m][n] = __builtin_amdgcn_mfma_f32_16x16x32_bf16(Bt[n][k], At[m][k], acc[ai][bj][m][n], 0, 0, 0); __builtin_amdgcn_s_setprio(0); } while (0)
#define PG8_WAIT_V(n) asm volatile("s_waitcnt vmcnt(" #n ")" ::: "memory")
#define PG8_WAIT_L(n) asm volatile("s_waitcnt lgkmcnt(" #n ")" ::: "memory")
#define PG8_BAR __builtin_amdgcn_s_barrier()
#define PG8_SCHED __builtin_amdgcn_sched_barrier(0)
    Unit cur, nxt; int ui = 0;
    if (!S.next(0, cur)) return;
    f32x4 acc[2][2][4][2];
#pragma unroll
    for (int a = 0; a < 2; ++a)
#pragma unroll
        for (int b = 0; b < 2; ++b)
#pragma unroll
            for (int m = 0; m < 4; ++m)
#pragma unroll
                for (int n = 0; n < 2; ++n) acc[a][b][m][n] = (f32x4){0.f, 0.f, 0.f, 0.f};
    bf16x8 At[4][2], B0[2][2], B1[2][2];
    const char* cA = (const char*)g.A + (size_t)cur.pm * tstepA; const char* cB = (const char*)g.Bt + (size_t)cur.pn * tstepB;
    S.a_ready(cur);
    if constexpr (SP2) {
        PG8_STAGE(PG8_SB(0, 0), cB, voffB); PG8_STAGE(PG8_SB(0, 1), cB + hstepB, voffB); PG8_STAGE(PG8_SA(0, 0), cA, voffA); PG8_STAGE(PG8_SA(0, 1), cA + hstepA, voffA);
        if (wr == 1) PG8_BAR;
        PG8_WAIT_V(2); PG8_BAR;
        PG8_STAGE(PG8_SB(1, 0), cB + kstep, voffB); PG8_STAGE(PG8_SA(1, 0), cA + kstep, voffA); PG8_STAGE(PG8_SB(1, 1), cB + hstepB + kstep, voffB);
        PG8_WAIT_V(6); PG8_BAR;
    } else {
        PG8_STAGE(PG8_SB(0, 0), cB, voffB); PG8_STAGE(PG8_SA(0, 0), cA, voffA); PG8_STAGE(PG8_SB(0, 1), cB + hstepB, voffB); PG8_STAGE(PG8_SA(0, 1), cA + hstepA, voffA);
        if (wr == 1) PG8_BAR;
        PG8_WAIT_V(4); PG8_BAR;
        PG8_STAGE(PG8_SB(1, 0), cB + kstep, voffB); PG8_STAGE(PG8_SA(1, 0), cA + kstep, voffA); PG8_STAGE(PG8_SB(1, 1), cB + hstepB + kstep, voffB);
        PG8_WAIT_V(6); PG8_BAR;
    }
    for (;;) {
        const bool has_next = S.next(ui + 1, nxt);
        const char* nA = has_next ? (const char*)g.A + (size_t)nxt.pm * tstepA : cA; const char* nB = has_next ? (const char*)g.Bt + (size_t)nxt.pn * tstepB : cB;
        for (int t = 0; t < nt; t += 2) {
            const bool last = (t == nt - 2);
            const char* a1 = cA + (size_t)(t + 1) * kstep;
            const char* a2 = last ? nA : cA + (size_t)(t + 2) * kstep; const char* b2 = last ? nB : cB + (size_t)(t + 2) * kstep;
            const char* a3 = a2 + kstep; const char* b3 = b2 + kstep;
            if (last && has_next) S.a_ready(nxt);
            if constexpr (SP2) {
            PG8_LDB(B0, 0, 0); PG8_LDB(B1, 0, 1); PG8_SCHED; PG8_LDA(At, 0, 0); PG8_STAGE(PG8_SA(1, 1), a1 + hstepA, voffA);
            PG8_WAIT_V(8); PG8_WAIT_L(0); PG8_BAR; PG8_MMA(0, 0, At, B0); PG8_MMA(0, 1, At, B1); PG8_BAR; PG8_SCHED;
            PG8_LDA(At, 0, 1); PG8_STAGE(PG8_SB(0, 0), b2, voffB); PG8_STAGE(PG8_SB(0, 1), b2 + hstepB, voffB); PG8_STAGE(PG8_SA(0, 0), a2, voffA);
            PG8_WAIT_V(8); PG8_WAIT_L(0); PG8_BAR; PG8_MMA(1, 0, At, B0); PG8_MMA(1, 1, At, B1); PG8_BAR; PG8_SCHED;
            PG8_LDB(B0, 1, 0); PG8_LDB(B1, 1, 1); PG8_SCHED; PG8_LDA(At, 1, 0); PG8_STAGE(PG8_SA(0, 1), a2 + hstepA, voffA);
            PG8_WAIT_V(8); PG8_WAIT_L(0); PG8_BAR; PG8_MMA(0, 0, At, B0); PG8_MMA(0, 1, At, B1); PG8_BAR; PG8_SCHED;
            PG8_LDA(At, 1, 1); PG8_STAGE(PG8_SB(1, 0), b3, voffB); PG8_STAGE(PG8_SB(1, 1), b3 + hstepB, voffB); PG8_STAGE(PG8_SA(1, 0), a3, voffA);
            PG8_WAIT_V(8); PG8_WAIT_L(0); PG8_BAR; PG8_MMA(1, 0, At, B0); PG8_MMA(1, 1, At, B1); PG8_BAR; PG8_SCHED;
            } else {
            PG8_LDB(B0, 0, 0); PG8_SCHED; PG8_LDA(At, 0, 0); PG8_STAGE(PG8_SA(1, 1), a1 + hstepA, voffA);
            PG8_WAIT_L(8); PG8_BAR; PG8_WAIT_L(0); PG8_MMA(0, 0, At, B0); PG8_BAR; PG8_SCHED;
            PG8_LDB(B1, 0, 1); PG8_STAGE(PG8_SB(0, 0), b2, voffB);
            PG8_BAR; PG8_WAIT_L(0); PG8_MMA(0, 1, At, B1); PG8_BAR;
            PG8_LDA(At, 0, 1); PG8_STAGE(PG8_SA(0, 0), a2, voffA);
            PG8_BAR; PG8_WAIT_L(0); PG8_MMA(1, 0, At, B0); PG8_BAR; PG8_SCHED;
            PG8_STAGE(PG8_SB(0, 1), b2 + hstepB, voffB);
            PG8_WAIT_V(6); PG8_BAR; PG8_MMA(1, 1, At, B1); PG8_BAR;
            PG8_LDB(B0, 1, 0); PG8_SCHED; PG8_LDA(At, 1, 0); PG8_STAGE(PG8_SA(0, 1), a2 + hstepA, voffA);
            PG8_WAIT_L(8); PG8_BAR; PG8_WAIT_L(0); PG8_MMA(0, 0, At, B0); PG8_BAR; PG8_SCHED;
            PG8_LDB(B1, 1, 1); PG8_STAGE(PG8_SB(1, 0), b3, voffB);
            PG8_BAR; PG8_WAIT_L(0); PG8_MMA(0, 1, At, B1); PG8_BAR;
            PG8_LDA(At, 1, 1); PG8_STAGE(PG8_SA(1, 0), a3, voffA);
            PG8_BAR; PG8_WAIT_L(0); PG8_MMA(1, 0, At, B0); PG8_BAR; PG8_SCHED;
            PG8_STAGE(PG8_SB(1, 1), b3 + hstepB, voffB);
            PG8_WAIT_V(6); PG8_BAR; PG8_MMA(1, 1, At, B1); PG8_BAR;
            }
        }
        if constexpr (ALIGN_EPI) { if (wr == 0) PG8_BAR; }
        if constexpr (!Epi::AFTER_DRAIN) { E(acc, cur, wr, wc, fr, fq); S.done(cur); }
        if (!has_next) break;
#pragma unroll
        for (int a = 0; a < 2; ++a)
#pragma unroll
            for (int b = 0; b < 2; ++b)
#pragma unroll
                for (int m = 0; m < 4; ++m)
#pragma unroll
                    for (int n = 0; n < 2; ++n) acc[a][b][m][n] = (f32x4){0.f, 0.f, 0.f, 0.f};
        cur = nxt; cA = nA; cB = nB; ++ui;
        if constexpr (ALIGN_EPI) { if (wr == 1) PG8_BAR; }
    }
    PG8_WAIT_V(0);
    if constexpr (!ALIGN_EPI) { if (wr == 0) PG8_BAR; }
    PG8_BAR;
    if constexpr (Epi::AFTER_DRAIN) { E.fused(acc, cur, wr, wc, fr, fq, lds, tid); S.done(cur); }
#undef PG8_SA
#undef PG8_SB
#undef PG8_STAGE
#undef PG8_LDA
#undef PG8_LDB
#undef PG8_MMA
#undef PG8_WAIT_V
#undef PG8_WAIT_L
#undef PG8_BAR
#undef PG8_SCHED
}
}

constexpr int NWAVES = 8;
constexpr int N_LAUNCHES = MK_N_LAUNCHES;
constexpr int NPH = 26;
constexpr int M = 16384, D = 1024, T = 4096, FF = 4096, NIN = 3072, APROJ = 3088, KD = 512;
constexpr float EPS = 1e-6f, LOG2E = 1.4426950408889634f;

constexpr size_t MiB = 1u << 20;
constexpr size_t WS_CTL = 0, CTL_ZERO_BYTES = 1 * MiB;
constexpr size_t WS_SSQ = 1 * MiB;
constexpr size_t WS_WG = 2 * MiB;
constexpr size_t WS_BEND = 2 * MiB + 65536;
constexpr size_t WS_WIN = 3 * MiB;
constexpr size_t WS_KV = 3 * MiB;
constexpr size_t WS_WAO = 15 * MiB;
constexpr size_t WS_WUP = 19 * MiB;
constexpr size_t WS_WDN = 51 * MiB;
constexpr size_t WS_WQ = 83 * MiB;
constexpr size_t WS_WQ1 = WS_WQ + (size_t)1280 * 1024 * 2;
constexpr size_t WS_WBO = 88 * MiB;
constexpr size_t WS_HB = 92 * MiB;
constexpr size_t WS_U = 124 * MiB;
constexpr size_t PANEL_B = 2 * MiB, PANEL_E = PANEL_B / 2, BCUM_OFF_E = 786432;
constexpr size_t WS_END = 252 * MiB;
constexpr int CW_BAR = 4096;
constexpr int CW_GRP = 16384;

constexpr int LDS_BYTES = 147456;
constexpr int RING_BYTES = 131072, LDSCTL_OFF = 143360, MISC_OFF = LDSCTL_OFF + 320;

#define GAS __attribute__((address_space(1)))
#define LAS __attribute__((address_space(3)))
typedef unsigned short bf16;
typedef unsigned v4u __attribute__((ext_vector_type(4)));
typedef unsigned v2u __attribute__((ext_vector_type(2)));
typedef float f32x4 __attribute__((ext_vector_type(4)));
typedef GAS unsigned gu32;
typedef short bf16x8 __attribute__((ext_vector_type(8)));
typedef short s16x4 __attribute__((ext_vector_type(4)));
__device__ __forceinline__ s16x4 tr_read(const LAS unsigned char* p) { return __builtin_bit_cast(s16x4, __builtin_amdgcn_ds_read_tr16_b64_v4i16((LAS s16x4*)p)); }
#define RLX_AGENT __ATOMIC_RELAXED, __HIP_MEMORY_SCOPE_AGENT
#define LDS_WAIT() asm volatile("s_waitcnt lgkmcnt(0)" ::: "memory")
#define VM_WAIT() asm volatile("s_waitcnt vmcnt(0)" ::: "memory")
__device__ __forceinline__ unsigned f2bf(float f) { unsigned u = __builtin_bit_cast(unsigned, f); return (u + 0x7fffu + ((u >> 16) & 1u)) >> 16; }
__device__ __forceinline__ unsigned pk2(float lo, float hi) { return f2bf(lo) | (f2bf(hi) << 16); }
__device__ __forceinline__ float bf2f(unsigned short b) { return __builtin_bit_cast(float, (unsigned)b << 16); }
__device__ __forceinline__ float bflo(unsigned w) { return __builtin_bit_cast(float, w << 16); }
__device__ __forceinline__ float bfhi(unsigned w) { return __builtin_bit_cast(float, w & 0xffff0000u); }

#define XB_TMO      128
#define XB_XCNT(j)  (256  + 64 * (j))
#define XB_XSUB(j)  (1280 + 64 * (j))
#define XB_XGEN(j)  (2304 + 64 * (j))
#define XB_TOP      3328
#define XB_TOPGEN   3392
#define XCD_BAR_WORDS 3456
#define XB_SPIN_CAP (1u << 18)
__device__ __forceinline__ unsigned xb_ld(unsigned* p)              { return __hip_atomic_load(p, __ATOMIC_RELAXED, __HIP_MEMORY_SCOPE_AGENT); }
__device__ __forceinline__ unsigned xb_add(unsigned* p, unsigned v) { return __hip_atomic_fetch_add(p, v, __ATOMIC_RELAXED, __HIP_MEMORY_SCOPE_AGENT); }
__device__ __forceinline__ unsigned xb_xcc_id() { return (unsigned)__builtin_amdgcn_s_getreg((3 << 11) | 20) & 0xFu; }
#define XB_SPIN(cond, bar) do { unsigned _sp = 0; while (cond) { __builtin_amdgcn_s_sleep(1); \
    if ((++_sp & 255u) == 0u) { if (xb_ld(&(bar)[XB_TMO])) break; if (_sp > XB_SPIN_CAP) { atomicAdd(&(bar)[XB_TMO], 1u); break; } } } } while (0)
struct XcdBarrier { unsigned* bar; unsigned x; volatile LAS unsigned* st; };
__device__ __forceinline__ XcdBarrier xcd_barrier_post(unsigned* bar, volatile LAS unsigned* st) {
    XcdBarrier b; b.bar = bar; b.x = xb_xcc_id(); b.st = st;
    if (threadIdx.x == 0) (void)xb_add(&bar[XB_XCNT(b.x)], 1u);
    return b;
}
__device__ __forceinline__ void xcd_barrier_complete(unsigned* bar, unsigned x, unsigned& nloc, unsigned& nx) {
    const unsigned G = gridDim.x * gridDim.y * gridDim.z;
    unsigned sum, cnt, mine, sp = 0u;
    for (;;) {
        sum = 0u; cnt = 0u; mine = 0u;
#pragma unroll
        for (unsigned j = 0; j < 16; ++j) { const unsigned c = xb_ld(&bar[XB_XCNT(j)]); sum += c; cnt += (c > 0u) ? 1u : 0u; mine = (j == x) ? c : mine; }
        if (sum == G) break;
        __builtin_amdgcn_s_sleep(1);
        if ((++sp & 255u) == 0u) { if (xb_ld(&bar[XB_TMO])) break; if (sp > XB_SPIN_CAP) { atomicAdd(&bar[XB_TMO], 1u); break; } }
    }
    nloc = mine > 0u ? mine : 1u; nx = cnt > 0u ? cnt : 1u;
}
__device__ __forceinline__ void xcd_barrier(const XcdBarrier& b) {
    asm volatile("s_waitcnt vmcnt(0)" ::: "memory");
    __syncthreads();
    if (threadIdx.x == 0) {
        unsigned* bar = b.bar;
        __builtin_amdgcn_s_waitcnt(0);
        unsigned nloc = b.st[0], nx = b.st[1];
        if (nloc == 0u) { xcd_barrier_complete(bar, b.x, nloc, nx); b.st[0] = nloc; b.st[1] = nx; }
        const unsigned old = xb_add(&bar[XB_XSUB(b.x)], 1u);
        const unsigned gen = old / nloc;
        if (old + 1u == (gen + 1u) * nloc) {
            __builtin_amdgcn_fence(__ATOMIC_RELEASE, "agent");
            asm volatile("s_waitcnt vmcnt(0)" ::: "memory");
            const unsigned og = xb_add(&bar[XB_TOP], 1u);
            const unsigned tg = og / nx;
            if (og + 1u == (tg + 1u) * nx) xb_add(&bar[XB_TOPGEN], 1u);
            else XB_SPIN(xb_ld(&bar[XB_TOPGEN]) == tg, bar);
            __builtin_amdgcn_fence(__ATOMIC_ACQUIRE, "agent");
            xb_add(&bar[XB_XGEN(b.x)], 1u);
            asm volatile("s_waitcnt vmcnt(0)" ::: "memory");
        } else {
            XB_SPIN(xb_ld(&bar[XB_XGEN(b.x)]) == gen, bar);
            __builtin_amdgcn_fence(__ATOMIC_ACQUIRE, "agent");
            asm volatile("s_waitcnt vmcnt(0)" ::: "memory");
        }
    }
    __syncthreads();
}

__device__ __forceinline__ void bc_unpack(v4u w, f32x4& a, f32x4& b) { const float s = 1.0f / 2048.0f;
    a[0] = (float)(short)(w.x & 0xffffu) * s; a[1] = (float)((int)w.x >> 16) * s; a[2] = (float)(short)(w.y & 0xffffu) * s; a[3] = (float)((int)w.y >> 16) * s;
    b[0] = (float)(short)(w.z & 0xffffu) * s; b[1] = (float)((int)w.z >> 16) * s; b[2] = (float)(short)(w.w & 0xffffu) * s; b[3] = (float)((int)w.w >> 16) * s; }
__device__ __forceinline__ void group_barrier(unsigned* ctr, unsigned target, unsigned* tmo, bool release) {
    asm volatile("s_waitcnt vmcnt(0)" ::: "memory");
    __syncthreads();
    if (threadIdx.x == 0) {
        __builtin_amdgcn_s_waitcnt(0);
        if (release) { __builtin_amdgcn_fence(__ATOMIC_RELEASE, "agent"); asm volatile("s_waitcnt vmcnt(0)" ::: "memory"); }
        xb_add(ctr, 1u);
        unsigned sp = 0;
        while (xb_ld(ctr) < target) { __builtin_amdgcn_s_sleep(1); if ((++sp & 255u) == 0u) { if (xb_ld(tmo)) break; if (sp > XB_SPIN_CAP) { atomicAdd(tmo, 1u); break; } } }
        __builtin_amdgcn_fence(__ATOMIC_ACQUIRE, "agent");
        asm volatile("s_waitcnt vmcnt(0)" ::: "memory");
    }
    __syncthreads();
}
__device__ __forceinline__ float wave_sum(float v) {
#pragma unroll
    for (int o = 1; o < 64; o <<= 1) v += __shfl_xor(v, o);
    return v;
}

struct P0Item { const float* W; int ldw, K, nblk; bf16* WT; const float* gain; float scale; int nscale, item; };
__device__ __forceinline__ void p0_load(const P0Item& d, int lane, f32x4 (&v)[8], float (&gn)[4]) {
    const GAS float* W = (const GAS float*)d.W;
    const int kb = d.item / d.nblk, nb = d.item % d.nblk, k0 = 64 * kb, n0 = 32 * nb, l15 = lane & 15, g = lane >> 4;
#pragma unroll
    for (int t = 0; t < 4; ++t) { const int k = k0 + 8 * (l15 >> 2) + 4 * (t & 1) + (l15 & 3) + 32 * (t >> 1); const GAS float* p = W + (size_t)k * d.ldw + n0 + 4 * g;
        v[2 * t] = *(const GAS f32x4*)p; v[2 * t + 1] = *(const GAS f32x4*)(p + 16); gn[t] = d.gain ? d.gain[k] : 1.0f; }
}
__device__ __forceinline__ void p0_finish(const P0Item& d, int lane, const f32x4 (&v)[8], const float (&gn)[4], bf16x8 B1, bf16x8 B2) {
    const int kb = d.item / d.nblk, nb = d.item % d.nblk, k0 = 64 * kb, n0 = 32 * nb, l15 = lane & 15, g = lane >> 4;
    const float sc = n0 < d.nscale ? d.scale : 1.0f;
    f32x4 D1[4], D2[4];
#pragma unroll
    for (int t = 0; t < 4; ++t) { const float m = gn[t] * sc; v4u a; a.x = pk2(v[2 * t][0] * m, v[2 * t][1] * m); a.y = pk2(v[2 * t][2] * m, v[2 * t][3] * m); a.z = pk2(v[2 * t + 1][0] * m, v[2 * t + 1][1] * m); a.w = pk2(v[2 * t + 1][2] * m, v[2 * t + 1][3] * m);
        const bf16x8 af = __builtin_bit_cast(bf16x8, a);
        D1[t] = __builtin_amdgcn_mfma_f32_16x16x32_bf16(af, B1, (f32x4){0.f, 0.f, 0.f, 0.f}, 0, 0, 0); D2[t] = __builtin_amdgcn_mfma_f32_16x16x32_bf16(af, B2, (f32x4){0.f, 0.f, 0.f, 0.f}, 0, 0, 0); }
    GAS bf16* o1 = (GAS bf16*)d.WT + (size_t)(n0 + l15) * d.K + k0 + 8 * g; GAS bf16* o2 = o1 + (size_t)16 * d.K;
    v4u w;
    w.x = pk2(D1[0][0], D1[0][1]); w.y = pk2(D1[0][2], D1[0][3]); w.z = pk2(D1[1][0], D1[1][1]); w.w = pk2(D1[1][2], D1[1][3]); *(GAS v4u*)o1 = w;
    w.x = pk2(D1[2][0], D1[2][1]); w.y = pk2(D1[2][2], D1[2][3]); w.z = pk2(D1[3][0], D1[3][1]); w.w = pk2(D1[3][2], D1[3][3]); *(GAS v4u*)(o1 + 32) = w;
    w.x = pk2(D2[0][0], D2[0][1]); w.y = pk2(D2[0][2], D2[0][3]); w.z = pk2(D2[1][0], D2[1][1]); w.w = pk2(D2[1][2], D2[1][3]); *(GAS v4u*)o2 = w;
    w.x = pk2(D2[2][0], D2[2][1]); w.y = pk2(D2[2][2], D2[2][3]); w.z = pk2(D2[3][0], D2[3][1]); w.w = pk2(D2[3][2], D2[3][3]); *(GAS v4u*)(o2 + 32) = w;
}

struct Args { const float* in[17]; float* out; unsigned char* ws; int ph_lo, ph_hi, li, pad; };

__device__ __forceinline__ float logsigmoidf(float z) { return fminf(z, 0.f) - log1pf(__expf(-fabsf(z))); }

__global__ void __launch_bounds__(NWAVES * 64, 2) yoco_fwd(Args args) {
    extern __shared__ __attribute__((aligned(16))) unsigned char lds[];
    LAS unsigned char* ldsl = (LAS unsigned char*)lds;
    volatile LAS unsigned* MISC = (volatile LAS unsigned*)(ldsl + MISC_OFF);
    const int tid0 = threadIdx.x, lane0 = tid0 & 63, wave0 = __builtin_amdgcn_readfirstlane(tid0 >> 6);
#define PHASE_IDS int tid = threadIdx.x; asm volatile("" : "+v"(tid)); const int lane = tid & 63, wave = __builtin_amdgcn_readfirstlane(tid >> 6); (void)lane; (void)wave;
    const int G = gridDim.x; const int bx = blockIdx.x; const int vcu = (G % 8 == 0) ? (bx % 8) * (G / 8) + bx / 8 : bx;
    unsigned char* ws = args.ws;
    gu32* ctl = (gu32*)(ws + WS_CTL);
    const float* x = args.in[0]; const float* a_w_in = args.in[1]; const float* a_w_gk2 = args.in[2]; const float* a_b_gk = args.in[3]; const float* a_onorm = args.in[4];
    const float* a_w_out = args.in[5]; const float* kv_norm = args.in[6]; const float* w_kv = args.in[7]; const float* b_w_q = args.in[8]; const float* b_sinks = args.in[9];
    const float* b_w_out = args.in[10]; const float* rel_table = args.in[11]; const float* ln_mix = args.in[12]; const float* ln_mlp = args.in[13];
    const float* w_up = args.in[14]; const float* w_down = args.in[15]; const float* ln_final = args.in[16];
    float* out = args.out;
    float* ssq = (float*)(ws + WS_SSQ);
    bf16* Wg_t = (bf16*)(ws + WS_WG); float* BendG = (float*)(ws + WS_BEND);
    bf16* Win_t = (bf16*)(ws + WS_WIN); bf16* KVb = (bf16*)(ws + WS_KV); bf16* Wao_t = (bf16*)(ws + WS_WAO); bf16* Wup_t = (bf16*)(ws + WS_WUP); bf16* Wdn_t = (bf16*)(ws + WS_WDN);
    bf16* Wq0_t = (bf16*)(ws + WS_WQ); bf16* Wq1_t = (bf16*)(ws + WS_WQ1); bf16* Wbo_t = (bf16*)(ws + WS_WBO);
    bf16* HB = (bf16*)(ws + WS_HB); bf16* Sst = (bf16*)out;
    bf16* U = (bf16*)(ws + WS_U); bf16* QKVG = (bf16*)(ws + WS_U); bf16* Qb = (bf16*)(ws + WS_U);

    for (int u = tid0; u < (LDS_BYTES - LDSCTL_OFF) / 4; u += NWAVES * 64) ((LAS unsigned*)(ldsl + LDSCTL_OFF))[u] = 0u;
    __syncthreads();
    XcdBarrier bar; bar.bar = (unsigned*)(ctl + CW_BAR) + args.li * XCD_BAR_WORDS; bar.x = 0; bar.st = nullptr;
    if (N_LAUNCHES != NPH) bar = xcd_barrier_post((unsigned*)(ctl + CW_BAR) + args.li * XCD_BAR_WORDS, MISC + 8);
    const bool grp_ok = (G == 256) && (N_LAUNCHES == 1);
    unsigned* gctr = (unsigned*)(ctl + CW_GRP) + 64 * (8 * (bx % 8) + (bx / 8) % 8); unsigned gepoch = 0;
    const int vwg = grp_ok ? 4 * (8 * (bx % 8) + (bx / 8) % 8) + (bx >> 6) : vcu;
    unsigned* gtmo = (unsigned*)(ctl + CW_BAR) + XB_TMO;
#define GROUP_BAR(cls, rel) do { if (grp_ok) { ++gepoch; group_barrier(gctr, 4u * gepoch, gtmo, rel); } else GRID_BAR(cls); } while (0)
#if PROBE_SEL
    unsigned long long pr_acc = 0, pr_t0 = 0, pr_tb = 0;
#define TIC() do { pr_t0 = __builtin_amdgcn_s_memrealtime(); } while (0)
#define TOC(cls) do { if ((PROBE_SEL >> (cls)) & 1) pr_acc += __builtin_amdgcn_s_memrealtime() - pr_t0; } while (0)
#define GRID_BAR(cls) do { if (N_LAUNCHES != NPH) { pr_tb = __builtin_amdgcn_s_memrealtime(); xcd_barrier(bar); if (((PROBE_SEL >> 12) & 1) || ((PROBE_SEL >> (16 + (cls))) & 1)) pr_acc += __builtin_amdgcn_s_memrealtime() - pr_tb; } } while (0)
#else
#define TIC() do { } while (0)
#define TOC(cls) do { } while (0)
#define GRID_BAR(cls) do { if (N_LAUNCHES != NPH) xcd_barrier(bar); } while (0)
#endif
    const int lo = args.ph_lo, hi = args.ph_hi;
#define IN(k) (lo <= (k) && (k) < hi)
#define BOTH(k) (IN(k) && IN((k) + 1))

    if (IN(0)) { PHASE_IDS TIC();
        const int gw = vcu * NWAVES + wave, NGW = G * NWAVES;
        constexpr int I_IN = 4 * 96, I_SQ = 4 * 32, I_UP = 4 * 128, I_DN = 16 * 32, I_KV = 4 * 8;
        constexpr int NITEMS = 2 * I_IN + 2 * I_SQ + 4 * I_UP + 4 * I_DN + 2 * I_SQ + I_KV + 2 * I_SQ;
#define P0_ITEM(r, nblk) ((4 * ((r) / (nblk))) * (nblk) + (r) % (nblk))
#define P0_DECODE(dst, itv) do { int r = (itv); \
            if (r < 2 * I_IN) { const int l = r / I_IN; r %= I_IN; dst = P0Item{a_w_in + (size_t)l * D * APROJ, APROJ, D, 96, Win_t + (size_t)l * NIN * D, ln_mix + l * D, 0.08838834764831845f, 512, P0_ITEM(r, 96)}; break; } r -= 2 * I_IN; \
            if (r < 2 * I_SQ) { const int l = r / I_SQ; r %= I_SQ; dst = P0Item{a_w_out + (size_t)l * D * D, D, D, 32, Wao_t + (size_t)l * D * D, nullptr, 1.f, 0, P0_ITEM(r, 32)}; break; } r -= 2 * I_SQ; \
            if (r < 4 * I_UP) { const int l = r / I_UP; r %= I_UP; dst = P0Item{w_up + (size_t)l * D * FF, FF, D, 128, Wup_t + (size_t)l * FF * D, ln_mlp + l * D, 1.f, 0, P0_ITEM(r, 128)}; break; } r -= 4 * I_UP; \
            if (r < 4 * I_DN) { const int l = r / I_DN; r %= I_DN; dst = P0Item{w_down + (size_t)l * FF * D, D, FF, 32, Wdn_t + (size_t)l * D * FF, nullptr, 1.f, 0, P0_ITEM(r, 32)}; break; } r -= 4 * I_DN; \
            if (r < 2 * I_SQ) { const int j = r / I_SQ; r %= I_SQ; dst = P0Item{b_w_q + (size_t)j * D * D, D, D, 32, j == 0 ? Wq0_t : Wq1_t, ln_mix + (2 + j) * D, 0.125f * LOG2E, 1024, P0_ITEM(r, 32)}; break; } r -= 2 * I_SQ; \
            if (r < I_KV) { dst = P0Item{w_kv, 256, D, 8, Wq0_t + (size_t)1024 * D, kv_norm, 1.f, 0, P0_ITEM(r, 8)}; break; } r -= I_KV; \
            { const int j = r / I_SQ; r %= I_SQ; dst = P0Item{b_w_out + (size_t)j * D * D, D, D, 32, Wbo_t + (size_t)j * D * D, nullptr, 1.f, 0, P0_ITEM(r, 32)}; } } while (0)
        bf16x8 B1, B2;
        { const int l15 = lane & 15, g = lane >> 4; const bool on = g == (l15 >> 2); const int jsel = l15 & 3;
#pragma unroll
          for (int j = 0; j < 8; ++j) { B1[j] = (on && j == jsel) ? (short)0x3F80 : (short)0; B2[j] = (on && j == 4 + jsel) ? (short)0x3F80 : (short)0; } }
        for (int it = gw; it < NITEMS; it += NGW) {
            P0Item d0; P0_DECODE(d0, it); P0Item d1 = d0, d2 = d0, d3 = d0; d1.item += d0.nblk; d2.item += 2 * d0.nblk; d3.item += 3 * d0.nblk;
            f32x4 v0[8], v1[8], v2[8], v3[8]; float g0[4], g1[4], g2[4], g3[4];
            p0_load(d0, lane, v0, g0); p0_load(d1, lane, v1, g1); p0_load(d2, lane, v2, g2); p0_load(d3, lane, v3, g3);
            p0_finish(d0, lane, v0, g0, B1, B2); p0_finish(d1, lane, v1, g1, B1, B2); p0_finish(d2, lane, v2, g2, B1, B2); p0_finish(d3, lane, v3, g3, B1, B2);
        }
#undef P0_DECODE
#undef P0_ITEM
        for (int e = vcu * 512 + tid; e < 2 * 16 * 1024; e += G * 512) { const int l = e >> 14, n = (e >> 10) & 15, k = e & 1023;
            Wg_t[e] = (bf16)f2bf(a_w_in[((size_t)l * D + k) * APROJ + NIN + n] * ln_mix[l * D + k]); }
        for (int m0 = gw * 4; m0 < M; m0 += NGW * 4) {
            f32x4 v[4][4];
#pragma unroll
            for (int r = 0; r < 4; ++r) { const GAS f32x4* xr = (const GAS f32x4*)(x + (size_t)(m0 + r) * D) + lane;
#pragma unroll
                for (int j = 0; j < 4; ++j) v[r][j] = xr[64 * j]; }
#pragma unroll
            for (int r = 0; r < 4; ++r) { float s = 0.f;
#pragma unroll
                for (int j = 0; j < 4; ++j) s += (v[r][j].x * v[r][j].x + v[r][j].y * v[r][j].y) + (v[r][j].z * v[r][j].z + v[r][j].w * v[r][j].w);
                s = wave_sum(s);
                GAS unsigned long long* o8 = (GAS unsigned long long*)(HB + (size_t)(m0 + r) * D) + lane;
#pragma unroll
                for (int j = 0; j < 4; ++j) o8[64 * j] = (unsigned long long)pk2(v[r][j].x, v[r][j].y) | ((unsigned long long)pk2(v[r][j].z, v[r][j].w) << 32);
                if (lane < 4) ssq[(size_t)lane * M + m0 + r] = lane == 0 ? s : 0.f; }
        }
        TOC(0); if (BOTH(0)) GRID_BAR(0);
    }

    for (int L = 0; L < 4; ++L) {
        const bool gla = L < 2; const int jb = L - 2;
        const int base = gla ? 1 + 7 * L : 15 + 5 * jb;
        const int pG1 = gla ? base + 4 : base + 2;
        if (IN(base)) { PHASE_IDS TIC();
            pg8::Gemm g; pg8::EpiScale E; E.ssq = ssq; E.act = 0;
            if (gla) { g = pg8::Gemm{HB, Win_t + (size_t)L * NIN * D, M, NIN, D, D, (size_t)256 * D * 2}; E.O = QKVG; E.ldc = NIN; E.tstep = PANEL_B; E.O2 = nullptr; E.ldc2 = 0; E.tstep2 = 0; E.split_col = 1 << 30; }
            else if (jb == 0) { g = pg8::Gemm{HB, Wq0_t, M, 1280, D, D, (size_t)256 * D * 2}; E.O = Qb; E.ldc = D; E.tstep = PANEL_B; E.O2 = KVb; E.ldc2 = 256; E.tstep2 = 256 * 256 * 2; E.split_col = 1024; }
            else { g = pg8::Gemm{HB, Wq1_t, M, 1024, D, D, (size_t)256 * D * 2}; E.O = Qb; E.ldc = D; E.tstep = PANEL_B; E.O2 = nullptr; E.ldc2 = 0; E.tstep2 = 0; E.split_col = 1 << 30; }
            pg8::StaticOrder S; S.init(M, g.N, G, (int)blockIdx.x);
            { pg8::Unit u0; const bool has = S.next(0, u0); LAS float* rtab = (LAS float*)(ldsl + RING_BYTES);
              if (has && tid < 256) rtab[tid] = pg8::row_rstd(ssq, u0.pm * 256 + tid);
              __syncthreads(); E.rtab = rtab; E.tab_pm = has ? u0.pm : -1; }
            pg8::gemm_phase<pg8::EpiScale, pg8::StaticOrder, true, true>(ldsl, g, S, E);
            TOC(gla ? 1 : 6); TIC();
            if (gla) {
                LAS float* part = (LAS float*)ldsl;
                LAS float* glr_s = (LAS float*)(ldsl + 8192);
                const GAS bf16* Wg = (const GAS bf16*)(Wg_t + (size_t)L * 16 * 1024);
                const int g4 = lane >> 4, l15 = lane & 15, mt = wave & 3, kh = wave >> 2;
                for (int c = vwg; c < M / 64; c += G) {
                    __syncthreads();
                    { const GAS bf16* ap = (const GAS bf16*)HB + (size_t)(c * 64 + 16 * mt + l15) * D + 512 * kh + 8 * g4; const GAS bf16* bp = Wg + (size_t)l15 * D + 512 * kh + 8 * g4;
                      f32x4 acc = (f32x4){0.f, 0.f, 0.f, 0.f};
#pragma unroll
                      for (int kb = 0; kb < 2; ++kb) { bf16x8 av[8], bv[8];
#pragma unroll
                          for (int ks = 0; ks < 8; ++ks) { av[ks] = *(const GAS bf16x8*)(ap + 256 * kb + 32 * ks); bv[ks] = *(const GAS bf16x8*)(bp + 256 * kb + 32 * ks); }
#pragma unroll
                          for (int ks = 0; ks < 8; ++ks) acc = __builtin_amdgcn_mfma_f32_16x16x32_bf16(av[ks], bv[ks], acc, 0, 0, 0); }
#pragma unroll
                      for (int r = 0; r < 4; ++r) part[(kh * 64 + 16 * mt + 4 * g4 + r) * 16 + l15] = acc[r]; }
                    __syncthreads();
                    { const int r = tid >> 3, n2 = (tid & 7) * 2; const float rs = pg8::row_rstd(ssq, c * 64 + r);
                      glr_s[r * 16 + n2] = (part[r * 16 + n2] + part[(64 + r) * 16 + n2]) * rs; glr_s[r * 16 + n2 + 1] = (part[r * 16 + n2 + 1] + part[(64 + r) * 16 + n2 + 1]) * rs; }
                    __syncthreads();
                    { const int kd = tid; float w2[16];
#pragma unroll
                      for (int r = 0; r < 16; ++r) w2[r] = a_w_gk2[((size_t)L * 16 + r) * KD + kd];
                      const float bb = a_b_gk[L * KD + kd]; float run = 0.f; GAS short* bo = (GAS short*)(U + (size_t)(c >> 2) * PANEL_E + BCUM_OFF_E) + (size_t)((c & 3) * 64) * KD + kd;
#pragma unroll 4
                      for (int t = 0; t < 64; ++t) { const LAS f32x4* gp = (const LAS f32x4*)(glr_s + t * 16); const f32x4 g0 = gp[0], g1 = gp[1], g2 = gp[2], g3 = gp[3];
                          float z = bb + ((g0[0] * w2[0] + g0[1] * w2[1]) + (g0[2] * w2[2] + g0[3] * w2[3])) + ((g1[0] * w2[4] + g1[1] * w2[5]) + (g1[2] * w2[6] + g1[3] * w2[7]))
                                       + ((g2[0] * w2[8] + g2[1] * w2[9]) + (g2[2] * w2[10] + g2[3] * w2[11])) + ((g3[0] * w2[12] + g3[1] * w2[13]) + (g3[2] * w2[14] + g3[3] * w2[15]));
                          const float ls = fminf(z, 0.f) - __logf(1.0f + __expf(-fabsf(z)));
                          run += ls * (1.0f / 16.0f); bo[(size_t)t * KD] = (short)fmaxf(rintf(run * 2048.0f), -32768.0f); } }
                }
                __syncthreads();
            }
            TOC(2); if (BOTH(base)) { if (gla) GROUP_BAR(2, true); else if (jb == 1) GROUP_BAR(6, false); else GRID_BAR(6); }
        }
        if (gla) {
            if (IN(base + 1)) { PHASE_IDS
                TIC(); constexpr int KD_OFF = 0, KD_RS = 288, V_OFF = 36864, V_RS = 544;
                const int g = lane >> 4, q4 = (lane & 15) >> 2, p4 = lane & 3, wk = wave >> 2, wv = wave & 3;
                for (int it = 2 * vwg; it < 512; it += ((it & 1) ? 2 * G - 1 : 1)) {
                    const int pmw = it >> 3, h = (it >> 1) & 3, b = pmw >> 4, sc = 2 * (pmw & 15) + (it & 1), seq = b * 4 + h, un = seq * 32 + sc; const size_t t0 = (size_t)b * T + sc * 128;
                    const GAS bf16* Qp = (const GAS bf16*)QKVG + (t0 >> 8) * PANEL_E + (size_t)(t0 & 255) * NIN;
                    const GAS short* Bp = (const GAS short*)(U + (t0 >> 8) * PANEL_E + BCUM_OFF_E) + (size_t)(t0 & 255) * KD;
                    __syncthreads();
                    { const int k8 = (tid & 15) * 8; const GAS short* bcb = Bp + h * 128 + k8; const GAS bf16* kb = Qp + 512 + h * 128 + k8;
                      const GAS bf16* vb = Qp + 1024 + h * 256;
                      const v4u l0w = *(const GAS v4u*)(bcb + 63 * KD), l1w = *(const GAS v4u*)(bcb + 127 * KD);
                      v4u kv[4], bw[4]; v4u vv[8];
#pragma unroll
                      for (int i = 0; i < 4; ++i) { const int t = (tid >> 4) + 32 * i; kv[i] = *(const GAS v4u*)(kb + (size_t)t * NIN); bw[i] = *(const GAS v4u*)(bcb + (size_t)t * KD); }
#pragma unroll
                      for (int i = 0; i < 8; ++i) { const int c = tid + 512 * i, t = c >> 5, v8 = (c & 31) * 8; vv[i] = *(const GAS v4u*)(vb + (size_t)t * NIN + v8); }
                      f32x4 l0a, l0b, l1a, l1b; bc_unpack(l0w, l0a, l0b); bc_unpack(l1w, l1a, l1b);
                      float last0[8], bend[8];
#pragma unroll
                      for (int e = 0; e < 4; ++e) { last0[e] = l0a[e]; last0[4 + e] = l0b[e]; bend[e] = l0a[e] + l1a[e]; bend[4 + e] = l0b[e] + l1b[e]; }
                      if (tid < 16) {
#pragma unroll
                          for (int e = 0; e < 8; ++e) BendG[(size_t)un * 128 + k8 + e] = bend[e]; }
#pragma unroll
                      for (int i = 0; i < 4; ++i) { const int t = (tid >> 4) + 32 * i; float r[8]; f32x4 b0, b1; bc_unpack(bw[i], b0, b1);
#pragma unroll
                          for (int e = 0; e < 8; ++e) { const float kk = (e & 1) ? bfhi(kv[i][e >> 1]) : bflo(kv[i][e >> 1]); const float bc = (e < 4 ? b0[e] : b1[e - 4]) + (t >= 64 ? last0[e] : 0.f); r[e] = kk * __expf(bend[e] - bc); }
                          v4u o; o.x = pk2(r[0], r[1]); o.y = pk2(r[2], r[3]); o.z = pk2(r[4], r[5]); o.w = pk2(r[6], r[7]);
                          *(LAS v4u*)(ldsl + KD_OFF + t * KD_RS + k8 * 2) = o; }
#pragma unroll
                      for (int i = 0; i < 8; ++i) { const int c = tid + 512 * i, t = c >> 5, v8 = (c & 31) * 8; *(LAS v4u*)(ldsl + V_OFF + t * V_RS + v8 * 2) = vv[i]; } }
                    __syncthreads();
                    f32x4 acc[4][4];
#pragma unroll
                    for (int a = 0; a < 4; ++a)
#pragma unroll
                        for (int c = 0; c < 4; ++c) acc[a][c] = (f32x4){0.f, 0.f, 0.f, 0.f};
#pragma unroll
                    for (int s = 0; s < 4; ++s) { const int rowb = 32 * s + 4 * g + q4;
                        bf16x8 af[4], bfr[4];
#pragma unroll
                        for (int kt = 0; kt < 4; ++kt) { const LAS unsigned char* ap = ldsl + KD_OFF + rowb * KD_RS + (64 * wk + 16 * kt + 4 * p4) * 2; const s16x4 lo = tr_read(ap), hi = tr_read(ap + 16 * KD_RS);
                            af[kt] = (bf16x8){lo[0], lo[1], lo[2], lo[3], hi[0], hi[1], hi[2], hi[3]}; }
#pragma unroll
                        for (int vt = 0; vt < 4; ++vt) { const LAS unsigned char* bp = ldsl + V_OFF + rowb * V_RS + (64 * wv + 16 * vt + 4 * p4) * 2; const s16x4 lo = tr_read(bp), hi = tr_read(bp + 16 * V_RS);
                            bfr[vt] = (bf16x8){lo[0], lo[1], lo[2], lo[3], hi[0], hi[1], hi[2], hi[3]}; }
#pragma unroll
                        for (int kt = 0; kt < 4; ++kt)
#pragma unroll
                            for (int vt = 0; vt < 4; ++vt) acc[kt][vt] = __builtin_amdgcn_mfma_f32_16x16x32_bf16(af[kt], bfr[vt], acc[kt][vt], 0, 0, 0); }
#pragma unroll
                    for (int kt = 0; kt < 4; ++kt)
#pragma unroll
                        for (int vt = 0; vt < 4; ++vt) { const int vd = 64 * wv + 16 * vt + (lane & 15), kd = 64 * wk + 16 * kt + 4 * g;
                            v2u w; w.x = pk2(acc[kt][vt][0], acc[kt][vt][1]); w.y = pk2(acc[kt][vt][2], acc[kt][vt][3]);
                            *(v2u*)(Sst + ((size_t)un * 256 + vd) * 128 + kd) = w; }
                }
                TOC(3); if (BOTH(base + 1)) GRID_BAR(3);
            }
            if (IN(base + 2)) { PHASE_IDS TIC();
                for (int w = vcu * 512 + tid; w < 16 * 8192; w += G * 512) { const int seq = w >> 13, e4 = (w & 8191) * 4, kd = e4 & 127; float run[4] = {0.f, 0.f, 0.f, 0.f};
                    for (int sc = 0; sc < 32; ++sc) { const int un = seq * 32 + sc; bf16* p = Sst + (size_t)un * 32768 + e4; const v2u tv = *(const v2u*)p;
                        const f32x4 be = *(const f32x4*)(BendG + (size_t)un * 128 + kd);
                        v2u o; o.x = pk2(run[0], run[1]); o.y = pk2(run[2], run[3]); *(v2u*)p = o;
                        run[0] = run[0] * __expf(be[0]) + bflo(tv.x); run[1] = run[1] * __expf(be[1]) + bfhi(tv.x); run[2] = run[2] * __expf(be[2]) + bflo(tv.y); run[3] = run[3] * __expf(be[3]) + bfhi(tv.y); } }
                TOC(4); if (BOTH(base + 2)) GRID_BAR(4);
            }
            if (IN(base + 3)) { PHASE_IDS TIC();
                constexpr int A_OFF = 0, A_RS = 288, B_OFF = 73728, B_RS = 544;
                const int g = lane >> 4, l15 = lane & 15, q4 = l15 >> 2, p4 = lane & 3;
                const int grp = wave < 4 ? wave : 11 - wave;
                for (int it = 2 * vwg; it < 512; it += ((it & 1) ? 2 * G - 1 : 1)) {
                    const int pmw = it >> 3, h = (it >> 1) & 3, b = pmw >> 4, sc = 2 * (pmw & 15) + (it & 1), seq = b * 4 + h, un = seq * 32 + sc; const size_t t0 = (size_t)b * T + sc * 128;
                    const GAS bf16* Qp = (const GAS bf16*)QKVG + (t0 >> 8) * PANEL_E + (size_t)(t0 & 255) * NIN;
                    const GAS short* Bp = (const GAS short*)(U + (t0 >> 8) * PANEL_E + BCUM_OFF_E) + (size_t)(t0 & 255) * KD;
                    const int k8 = (tid & 15) * 8, q = 16 * grp + l15;
                    v4u sv[8], vv[8], kv[4], qv[4], kbw[4], qbw[4], qcw[4];
                    { const GAS bf16* sb = (const GAS bf16*)Sst + (size_t)un * 32768; const GAS bf16* vb = Qp + 1024 + h * 256;
#pragma unroll
                      for (int i = 0; i < 8; ++i) { const int c = tid + 512 * i; sv[i] = *(const GAS v4u*)(sb + (size_t)c * 8); vv[i] = *(const GAS v4u*)(vb + (size_t)(c >> 5) * NIN + (c & 31) * 8); } }
                    const GAS short* bcb = Bp + h * 128 + k8;
                    const v4u l0w = *(const GAS v4u*)(bcb + 63 * KD);
                    { const GAS bf16* kb = Qp + 512 + h * 128 + k8;
#pragma unroll
                      for (int i = 0; i < 4; ++i) { const int t = (tid >> 4) + 32 * i; kv[i] = *(const GAS v4u*)(kb + (size_t)t * NIN); kbw[i] = *(const GAS v4u*)(bcb + (size_t)t * KD); } }
                    __syncthreads();
#pragma unroll
                    for (int i = 0; i < 8; ++i) { const int c = tid + 512 * i; *(LAS v4u*)(ldsl + A_OFF + (c >> 4) * A_RS + (c & 15) * 16) = sv[i]; *(LAS v4u*)(ldsl + B_OFF + (c >> 5) * B_RS + (c & 31) * 16) = vv[i]; }
                    asm volatile("" ::: "memory");
                    { const GAS bf16* qb = Qp + (size_t)q * NIN + h * 128 + 8 * g; const GAS short* bq = Bp + (size_t)q * KD + h * 128 + 8 * g; const GAS short* lq = Bp + 63 * KD + h * 128 + 8 * g;
#pragma unroll
                      for (int ks = 0; ks < 4; ++ks) { qv[ks] = *(const GAS v4u*)(qb + 32 * ks); qbw[ks] = *(const GAS v4u*)(bq + 32 * ks); qcw[ks] = *(const GAS v4u*)(lq + 32 * ks); } }
                    v4u kreg[4];
                    f32x4 l0a, l0b; bc_unpack(l0w, l0a, l0b);
#pragma unroll
                    for (int i = 0; i < 4; ++i) { const int t = (tid >> 4) + 32 * i; float r[8]; f32x4 kb0, kb1; bc_unpack(kbw[i], kb0, kb1);
#pragma unroll
                        for (int e = 0; e < 8; ++e) { const float kk = (e & 1) ? bfhi(kv[i][e >> 1]) : bflo(kv[i][e >> 1]); const float bc = (e < 4 ? kb0[e] : kb1[e - 4]) + (t >= 64 ? (e < 4 ? l0a[e] : l0b[e - 4]) : 0.f); r[e] = kk * __expf(-bc); }
                        kreg[i].x = pk2(r[0], r[1]); kreg[i].y = pk2(r[2], r[3]); kreg[i].z = pk2(r[4], r[5]); kreg[i].w = pk2(r[6], r[7]); }
                    bf16x8 qf[4];
                    { const float lm = q >= 64 ? 1.0f : 0.0f;
#pragma unroll
                      for (int ks = 0; ks < 4; ++ks) { float r[8]; f32x4 qb0, qb1, qc0, qc1; bc_unpack(qbw[ks], qb0, qb1); bc_unpack(qcw[ks], qc0, qc1);
#pragma unroll
                          for (int e = 0; e < 8; ++e) { const float qq = (e & 1) ? bfhi(qv[ks][e >> 1]) : bflo(qv[ks][e >> 1]); r[e] = qq * __expf(e < 4 ? qb0[e] + lm * qc0[e] : qb1[e - 4] + lm * qc1[e - 4]); }
                          v4u o; o.x = pk2(r[0], r[1]); o.y = pk2(r[2], r[3]); o.z = pk2(r[4], r[5]); o.w = pk2(r[6], r[7]);
                          qf[ks] = __builtin_bit_cast(bf16x8, o); } }
                    GAS bf16* gp = (GAS bf16*)Qp + (size_t)q * NIN + 2048 + h * 256 + 4 * g;
                    v2u gv[16];
#pragma unroll
                    for (int vt = 0; vt < 16; ++vt) gv[vt] = *(const GAS v2u*)(gp + 16 * vt);
                    __syncthreads();
                    f32x4 acc[16];
#pragma unroll
                    for (int vt = 0; vt < 16; ++vt) acc[vt] = (f32x4){0.f, 0.f, 0.f, 0.f};
#pragma unroll
                    for (int vt = 0; vt < 16; ++vt)
#pragma unroll
                        for (int ks = 0; ks < 4; ++ks) { const bf16x8 a = *(const LAS bf16x8*)(ldsl + A_OFF + (16 * vt + l15) * A_RS + (32 * ks + 8 * g) * 2);
                            acc[vt] = __builtin_amdgcn_mfma_f32_16x16x32_bf16(a, qf[ks], acc[vt], 0, 0, 0); }
                    __syncthreads();
#pragma unroll
                    for (int i = 0; i < 4; ++i) { const int t = (tid >> 4) + 32 * i; *(LAS v4u*)(ldsl + A_OFF + t * A_RS + k8 * 2) = kreg[i]; }
                    __syncthreads();
                    const int nsteps = (grp >> 1) + 1;
                    for (int s = 0; s < nsteps; ++s) {
                        f32x4 pt[2];
#pragma unroll
                        for (int tt = 0; tt < 2; ++tt) { pt[tt] = (f32x4){0.f, 0.f, 0.f, 0.f};
#pragma unroll
                            for (int ks = 0; ks < 4; ++ks) { const bf16x8 a = *(const LAS bf16x8*)(ldsl + A_OFF + (32 * s + 16 * tt + l15) * A_RS + (32 * ks + 8 * g) * 2);
                                pt[tt] = __builtin_amdgcn_mfma_f32_16x16x32_bf16(a, qf[ks], pt[tt], 0, 0, 0); }
#pragma unroll
                            for (int r = 0; r < 4; ++r) { const int j = 32 * s + 16 * tt + 4 * g + r; if (j > q) pt[tt][r] = 0.f; } }
                        v4u pw; pw.x = pk2(pt[0][0], pt[0][1]); pw.y = pk2(pt[0][2], pt[0][3]); pw.z = pk2(pt[1][0], pt[1][1]); pw.w = pk2(pt[1][2], pt[1][3]);
                        const bf16x8 pf = __builtin_bit_cast(bf16x8, pw);
#pragma unroll
                        for (int vt = 0; vt < 16; ++vt) { const LAS unsigned char* vp = ldsl + B_OFF + (32 * s + 4 * g + q4) * B_RS + (16 * vt + 4 * p4) * 2; const s16x4 lo = tr_read(vp), hi = tr_read(vp + 16 * B_RS);
                            const bf16x8 a = (bf16x8){lo[0], lo[1], lo[2], lo[3], hi[0], hi[1], hi[2], hi[3]};
                            acc[vt] = __builtin_amdgcn_mfma_f32_16x16x32_bf16(a, pf, acc[vt], 0, 0, 0); }
                    }
                    { float ss = 0.f;
#pragma unroll
                      for (int vt = 0; vt < 16; ++vt) ss += (acc[vt][0] * acc[vt][0] + acc[vt][1] * acc[vt][1]) + (acc[vt][2] * acc[vt][2] + acc[vt][3] * acc[vt][3]);
                      ss += __shfl_xor(ss, 16); ss += __shfl_xor(ss, 32);
                      const float rs = 1.0f / sqrtf(ss * (1.0f / 256.0f) + EPS);
                      const GAS float* gonp = (const GAS float*)a_onorm + L * 256 + 4 * g;
#pragma unroll
                      for (int vt = 0; vt < 16; ++vt) { const f32x4 gon = *(const GAS f32x4*)(gonp + 16 * vt);
                          const float g0 = bflo(gv[vt].x), g1 = bfhi(gv[vt].x), g2 = bflo(gv[vt].y), g3 = bfhi(gv[vt].y);
                          const float r0 = acc[vt][0] * rs * gon[0] * (g0 / (1.0f + __expf(-g0))), r1 = acc[vt][1] * rs * gon[1] * (g1 / (1.0f + __expf(-g1)));
                          const float r2 = acc[vt][2] * rs * gon[2] * (g2 / (1.0f + __expf(-g2))), r3 = acc[vt][3] * rs * gon[3] * (g3 / (1.0f + __expf(-g3)));
                          v2u w; w.x = pk2(r0, r1); w.y = pk2(r2, r3); *(GAS v2u*)(gp + 16 * vt) = w; } }
                }
                TOC(5); if (BOTH(base + 3)) GROUP_BAR(5, true);
            }
        } else {
            if (IN(base + 1)) { PHASE_IDS
                TIC(); constexpr int K_OFF = 0, V_OFF = 40960, RS = 160, BIAS_OFF = 81920;
                const int g = lane >> 4, l15 = lane & 15, q4 = l15 >> 2, p4 = lane & 3;
                LAS float* bias_s = (LAS float*)(ldsl + BIAS_OFF);
                for (int w = vwg; w < 256; w += G) {
                    const int pmw = w >> 2, b = pmw >> 4, nb = 2 * (pmw & 15) + ((w >> 1) & 1), kvh = w & 1; const size_t tq0 = (size_t)b * T + nb * 128;
                    __syncthreads();
                    { v4u kv[4], vv[4]; const GAS bf16* kvb = (const GAS bf16*)KVb + (tq0 - (nb == 0 ? 0 : 128)) * 256 + kvh * 64;
#pragma unroll
                      for (int i = 0; i < 4; ++i) { const int c = tid + 512 * i, j = c >> 3, d8 = (c & 7) * 8; const int jj = nb == 0 ? (j & 127) : j;
                          kv[i] = *(const GAS v4u*)(kvb + (size_t)jj * 256 + d8); vv[i] = *(const GAS v4u*)(kvb + (size_t)jj * 256 + 128 + d8); }
#pragma unroll
                      for (int i = 0; i < 4; ++i) { const int c = tid + 512 * i, j = c >> 3, d8 = (c & 7) * 8; const bool pad = nb == 0 && j < 128;
                          *(LAS v4u*)(ldsl + K_OFF + j * RS + d8 * 2) = pad ? (v4u){0u, 0u, 0u, 0u} : kv[i]; *(LAS v4u*)(ldsl + V_OFF + j * RS + d8 * 2) = pad ? (v4u){0u, 0u, 0u, 0u} : vv[i]; } }
                    for (int e = tid; e < 8 * 4 * 196; e += 512) { const int hg = e / 784, rem = e % 784, cp = rem / 196, y = rem % 196, dist0 = y + cp - 32, dist = dist0 < 0 ? 0 : (dist0 > 127 ? 127 : dist0);
                        int bk = dist; if (dist >= 16) { bk = 16 + (dist >= 19) + (dist >= 21) + (dist >= 24) + (dist >= 27) + (dist >= 31) + (dist >= 35) + (dist >= 40) + (dist >= 46) + (dist >= 52) + (dist >= 59) + (dist >= 67) + (dist >= 77) + (dist >= 87) + (dist >= 99) + (dist >= 113); }
                        bias_s[e] = (dist0 >= 0 && dist0 < 128) ? rel_table[bk * 16 + kvh * 8 + hg] * LOG2E : -1e30f; }
                    __syncthreads();
                    const int head = kvh * 8 + wave; const float sink2 = b_sinks[jb * 16 + head] * LOG2E;
                    GAS bf16* qbase = (GAS bf16*)Qb + (tq0 >> 8) * PANEL_E + ((tq0 & 255) + l15) * D + head * 64;
                    bf16x8 qn0 = *(const GAS bf16x8*)(qbase + 8 * g), qn1 = *(const GAS bf16x8*)(qbase + 32 + 8 * g);
#pragma unroll 1
                    for (int qg = 0; qg < 8; ++qg) {
                        const int qi = 16 * qg + l15; GAS bf16* qp = qbase + (size_t)(16 * qg) * D;
                        const bf16x8 qf0 = qn0, qf1 = qn1;
                        if (qg < 7) { qn0 = *(const GAS bf16x8*)(qp + 16 * D + 8 * g); qn1 = *(const GAS bf16x8*)(qp + 16 * D + 32 + 8 * g); }
                        const int ts0 = qg & ~1;
                        f32x4 sc[10];
#pragma unroll
                        for (int tt = 0; tt < 10; ++tt) { const LAS unsigned char* kp = ldsl + K_OFF + (16 * (ts0 + tt) + l15) * RS + (8 * g) * 2;
                            const bf16x8 a0 = *(const LAS bf16x8*)kp, a1 = *(const LAS bf16x8*)(kp + 64);
                            sc[tt] = __builtin_amdgcn_mfma_f32_16x16x32_bf16(a0, qf0, (f32x4){0.f, 0.f, 0.f, 0.f}, 0, 0, 0);
                            sc[tt] = __builtin_amdgcn_mfma_f32_16x16x32_bf16(a1, qf1, sc[tt], 0, 0, 0); }
                        float m = sink2;
                        {
                          const int i3_9 = qi + 128 - 16 * ts0 - 4 * g + 29 - 144, cp = i3_9 & 3;
                          const LAS f32x4* tp = (const LAS f32x4*)(bias_s + wave * 784 + cp * 196 + (i3_9 - cp));
#pragma unroll
                          for (int tt = 0; tt < 10; ++tt) { const f32x4 bv = tp[4 * (9 - tt)];
                              float s0 = sc[tt][0] + bv[3], s1 = sc[tt][1] + bv[2], s2 = sc[tt][2] + bv[1], s3 = sc[tt][3] + bv[0];
                              if (nb == 0 && ts0 + tt < 8) { s0 = -1e30f; s1 = -1e30f; s2 = -1e30f; s3 = -1e30f; }
                              sc[tt][0] = s0; sc[tt][1] = s1; sc[tt][2] = s2; sc[tt][3] = s3; m = fmaxf(fmaxf(m, fmaxf(s0, s1)), fmaxf(s2, s3)); } }
                        m = fmaxf(m, __shfl_xor(m, 16)); m = fmaxf(m, __shfl_xor(m, 32));
                        float l = 0.f;
#pragma unroll
                        for (int tt = 0; tt < 10; ++tt)
#pragma unroll
                            for (int r = 0; r < 4; ++r) { const float pe = __builtin_amdgcn_exp2f(sc[tt][r] - m); sc[tt][r] = pe; l += pe; }
                        l += __shfl_xor(l, 16); l += __shfl_xor(l, 32); l += __builtin_amdgcn_exp2f(sink2 - m);
                        f32x4 o[4];
#pragma unroll
                        for (int dt = 0; dt < 4; ++dt) o[dt] = (f32x4){0.f, 0.f, 0.f, 0.f};
#pragma unroll
                        for (int s5 = 0; s5 < 5; ++s5) { v4u pw; pw.x = pk2(sc[2 * s5][0], sc[2 * s5][1]); pw.y = pk2(sc[2 * s5][2], sc[2 * s5][3]); pw.z = pk2(sc[2 * s5 + 1][0], sc[2 * s5 + 1][1]); pw.w = pk2(sc[2 * s5 + 1][2], sc[2 * s5 + 1][3]);
                            const bf16x8 pf = __builtin_bit_cast(bf16x8, pw);
#pragma unroll
                            for (int dt = 0; dt < 4; ++dt) { const LAS unsigned char* vp = ldsl + V_OFF + (16 * (ts0 + 2 * s5) + 4 * g + q4) * RS + (16 * dt + 4 * p4) * 2; const s16x4 lo = tr_read(vp), hi = tr_read(vp + 16 * RS);
                                const bf16x8 a = (bf16x8){lo[0], lo[1], lo[2], lo[3], hi[0], hi[1], hi[2], hi[3]};
                                o[dt] = __builtin_amdgcn_mfma_f32_16x16x32_bf16(a, pf, o[dt], 0, 0, 0); } }
                        const float il = 1.0f / l;
#pragma unroll
                        for (int dt = 0; dt < 4; ++dt) { v2u w; w.x = pk2(o[dt][0] * il, o[dt][1] * il); w.y = pk2(o[dt][2] * il, o[dt][3] * il); *(GAS v2u*)(qp + 16 * dt + 4 * g) = w; }
                    }
                }
                TOC(7); if (BOTH(base + 1)) GROUP_BAR(7, true);
            }
        }
        if (IN(pG1)) { TIC();
            pg8::Gemm g; pg8::EpiResid E; E.hb = HB; E.ssq = ssq;
            if (gla) g = pg8::Gemm{QKVG + 2048, Wao_t + (size_t)L * D * D, M, D, D, NIN, PANEL_B};
            else g = pg8::Gemm{Qb, Wbo_t + (size_t)jb * D * D, M, D, D, D, PANEL_B};
            pg8::StaticOrder S; S.init(M, D, G, (int)blockIdx.x);
            pg8::gemm_phase<pg8::EpiResid, pg8::StaticOrder, false, true>(ldsl, g, S, E);
            TOC(8); if (BOTH(pG1)) GROUP_BAR(8, false);
        }
        if (IN(pG1 + 1)) { PHASE_IDS TIC();
            pg8::Gemm g{HB, Wup_t + (size_t)L * FF * D, M, FF, D, D, (size_t)256 * D * 2};
            pg8::EpiScale E; E.O = U; E.ldc = FF; E.tstep = PANEL_B; E.O2 = nullptr; E.ldc2 = 0; E.tstep2 = 0; E.split_col = 1 << 30; E.ssq = ssq; E.act = 1;
            pg8::StaticOrder S; S.init(M, FF, G, (int)blockIdx.x);
            { pg8::Unit u0; const bool has = S.next(0, u0); LAS float* rtab = (LAS float*)(ldsl + RING_BYTES);
              if (has && tid < 256) rtab[tid] = pg8::row_rstd(ssq, u0.pm * 256 + tid);
              __syncthreads(); E.rtab = rtab; E.tab_pm = has ? u0.pm : -1; }
            pg8::gemm_phase<pg8::EpiScale, pg8::StaticOrder, true, true>(ldsl, g, S, E);
            TOC(9); if (BOTH(pG1 + 1)) GROUP_BAR(9, false);
        }
        if (IN(pG1 + 2)) { TIC();
            pg8::Gemm g{U, Wdn_t + (size_t)L * D * FF, M, D, FF, FF, PANEL_B};
            pg8::EpiResid E; E.hb = HB; E.ssq = ssq;
            pg8::StaticOrder S; S.init(M, D, G, (int)blockIdx.x);
            pg8::gemm_phase<pg8::EpiResid, pg8::StaticOrder, false, true>(ldsl, g, S, E);
            TOC(10); if (BOTH(pG1 + 2)) GROUP_BAR(10, false);
        }
    }
    if (IN(25)) { PHASE_IDS TIC();
        const int gw = vcu * NWAVES + wave, NGW = G * NWAVES;
        for (int m = 64 * vwg + wave; m < M; m += ((m & 63) >= 56 ? 64 * G - 56 : 8)) {
            const float rs = pg8::row_rstd(ssq, m);
            const GAS v2u* hr = (const GAS v2u*)(HB + (size_t)m * D) + lane; GAS f32x4* orow = (GAS f32x4*)(out + (size_t)m * D) + lane; const f32x4* gr = (const f32x4*)ln_final + lane;
            v2u hvv[4];
#pragma unroll
            for (int j = 0; j < 4; ++j) hvv[j] = hr[64 * j];
#pragma unroll
            for (int j = 0; j < 4; ++j) { const f32x4 gg = gr[64 * j]; orow[64 * j] = (f32x4){bflo(hvv[j].x) * rs * gg[0], bfhi(hvv[j].x) * rs * gg[1], bflo(hvv[j].y) * rs * gg[2], bfhi(hvv[j].y) * rs * gg[3]}; }
        }
    TOC(11); }
#if PROBE_SEL
    if (blockIdx.x == 0) { const unsigned long long te = __builtin_amdgcn_s_memrealtime(); while (__builtin_amdgcn_s_memrealtime() - te < pr_acc * PROBE_MUL) __builtin_amdgcn_s_sleep(8); }
#endif
#undef IN
#undef BOTH
#undef GRID_BAR
}

extern "C" void kernel_launch(void* const* d_in, const int* in_sizes, int n_in, void* d_out, int out_size, void* d_ws, size_t ws_size, hipStream_t stream) {
    static int grid = 0;
    if (grid == 0) {
        if (n_in != 17 || in_sizes[0] != M * D || out_size != M * D || ws_size < WS_END) { fprintf(stderr, "kernel_launch: unexpected shapes (n_in %d, in0 %d, out %d, ws %zu)\n", n_in, n_in > 0 ? in_sizes[0] : -1, out_size, ws_size); grid = -1; return; }
        int dev = 0, cus = 0;
        if (hipGetDevice(&dev) != hipSuccess || hipDeviceGetAttribute(&cus, hipDeviceAttributeMultiprocessorCount, dev) != hipSuccess) { grid = -1; return; }
        if (hipFuncSetAttribute((const void*)yoco_fwd, hipFuncAttributeMaxDynamicSharedMemorySize, LDS_BYTES) != hipSuccess) { fprintf(stderr, "kernel_launch: hipFuncSetAttribute failed\n"); grid = -1; return; }
        (void)hipGetLastError();
        grid = cus;
    }
    if (grid < 0) return;
    if (hipMemsetAsync((char*)d_ws + WS_CTL, 0, CTL_ZERO_BYTES, stream) != hipSuccess) return;
    Args a{};
    for (int i = 0; i < 17; ++i) a.in[i] = (const float*)d_in[i];
    a.out = (float*)d_out; a.ws = (unsigned char*)d_ws;
    if (N_LAUNCHES == 1) {
        a.ph_lo = 0; a.ph_hi = NPH; a.li = 0;
        hipLaunchKernelGGL(yoco_fwd, dim3(grid), dim3(NWAVES * 64), LDS_BYTES, stream, a);
    } else {
        for (int p = 0; p < NPH; ++p) { a.ph_lo = p; a.ph_hi = p + 1; a.li = 0;
            hipLaunchKernelGGL(yoco_fwd, dim3(grid), dim3(NWAVES * 64), LDS_BYTES, stream, a); }
    }
}
```
